# Optimizing an MI355X kernel written in HIP

```python
import jax, jax.numpy as jnp
from jax import lax
import numpy as np

D_MODEL = 1024
BATCH = 8
SEQ = 4096
DEPTH = 4

N_META = 16
GRID_W = 64
GLA_HEADS = 4
GLA_DK = 64
GLA_DV = 128
GLA_KEY = GLA_HEADS * GLA_DK
GLA_VAL = GLA_HEADS * GLA_DV
GLA_RANK = 16
GLA_TAU = 16.0
CHUNK = 64
ATT_HEADS = 8
ATT_KV_HEADS = 2
HEAD_DIM = 64
ATT_Q = ATT_HEADS * HEAD_DIM
ATT_KV = ATT_KV_HEADS * HEAD_DIM
Q_BLOCK = 128
ROPE_THETA = 10000.0
D_FF = 2816
EPS = 1e-6

IN_SIZES = (GLA_KEY, GLA_KEY, GLA_VAL, GLA_VAL, GLA_RANK, GLA_RANK,
            ATT_Q, ATT_KV, ATT_KV, D_MODEL, D_MODEL)
D_IN = sum(IN_SIZES)
SPLIT_POINTS = tuple(int(s) for s in np.cumsum(IN_SIZES)[:-1])

kernel_name = "hybrid_gla_gqa_macaron_encoder"


def rmsnorm(x, g):
    xf = x.astype(jnp.float32)
    y = xf * lax.rsqrt(jnp.mean(xf * xf, axis=-1, keepdims=True) + EPS)
    return (y * g.astype(jnp.float32)).astype(x.dtype)


def swiglu(x, w_gate, w_up, w_down):
    return (jax.nn.silu(x @ w_gate) * (x @ w_up)) @ w_down


def gla_causal_chunked(q, k, v, log_a):
    f32 = jnp.float32
    B, H, T, dk = q.shape
    dv = v.shape[-1]
    n = T // CHUNK
    qc = q.astype(f32).reshape(B, H, n, CHUNK, dk)
    kc = k.astype(f32).reshape(B, H, n, CHUNK, dk)
    vc = v.astype(f32).reshape(B, H, n, CHUNK, dv)
    bcum = jnp.cumsum(log_a.astype(f32).reshape(B, H, n, CHUNK, dk), axis=3)
    btot = bcum[:, :, :, -1:, :]
    q_dec = qc * jnp.exp(bcum)
    k_inv = kc * jnp.exp(-bcum)
    k_end = kc * jnp.exp(btot - bcum)
    mask = jnp.tril(jnp.ones((CHUNK, CHUNK), dtype=bool))
    att = jnp.where(mask, jnp.einsum('bhnid,bhnjd->bhnij', q_dec, k_inv), 0.0)
    o_intra = jnp.einsum('bhnij,bhnjv->bhniv', att, vc)
    kv_chunk = jnp.einsum('bhnjd,bhnjv->bhndv', k_end, vc)
    decay = jnp.exp(btot[:, :, :, 0, :])

    def step(S, inp):
        d, kv = inp
        return d[..., None] * S + kv, S

    S0 = jnp.zeros((B, H, dk, dv), f32)
    _, S_prev = lax.scan(step, S0, (jnp.moveaxis(decay, 2, 0), jnp.moveaxis(kv_chunk, 2, 0)))
    S_prev = jnp.moveaxis(S_prev, 0, 2)
    o_inter = jnp.einsum('bhnid,bhndv->bhniv', q_dec, S_prev)
    return (o_intra + o_inter).reshape(B, H, T, dv)


def gla_branch(q, k, v, r, lr_f, lr_b, w2, b2, gn_gain):
    B, L, _ = q.shape
    pad = CHUNK - N_META

    def heads(t, d):
        return t.reshape(B, L, GLA_HEADS, d).transpose(0, 2, 1, 3)

    def log_gate(lr, w, b):
        return jax.nn.log_sigmoid((lr @ w + b).astype(jnp.float32)) / GLA_TAU

    def padseq(t):
        return jnp.pad(t, ((0, 0), (0, 0), (pad, 0), (0, 0)))

    def flip(t):
        return jnp.flip(t, axis=2)

    qh = padseq(heads(q * GLA_DK ** -0.5, GLA_DK))
    kh = padseq(heads(k, GLA_DK))
    vh = padseq(heads(v, GLA_DV))
    gf = padseq(heads(log_gate(lr_f, w2[0], b2[0]), GLA_DK))
    gb = padseq(heads(log_gate(lr_b, w2[1], b2[1]), GLA_DK))
    o_f = gla_causal_chunked(qh, kh, vh, gf)
    o_b = flip(gla_causal_chunked(flip(qh), flip(kh), flip(vh), flip(gb)))
    o = (o_f + o_b)[:, :, pad:, :].transpose(0, 2, 1, 3)
    o = o * lax.rsqrt(jnp.mean(o * o, axis=-1, keepdims=True) + EPS)
    o = o.reshape(B, L, GLA_VAL) * gn_gain.astype(jnp.float32)
    return o.astype(r.dtype) * jax.nn.silu(r)


def axial_rope_tables(n_tok):
    f32 = jnp.float32
    rows = n_tok // GRID_W
    row = jnp.repeat(jnp.arange(rows), GRID_W).astype(f32)
    col = jnp.tile(jnp.arange(GRID_W), rows).astype(f32)
    axis_dim = HEAD_DIM // 2
    inv = ROPE_THETA ** (-jnp.arange(0, axis_dim, 2, dtype=f32) / axis_dim)
    ang = jnp.concatenate([row[:, None] * inv, col[:, None] * inv], axis=-1)
    ang = jnp.concatenate([jnp.zeros((N_META, axis_dim), f32), ang], axis=0)
    return jnp.cos(ang), jnp.sin(ang)


def apply_axial_rope(x, cos, sin):
    L = x.shape[-2]
    q4 = HEAD_DIM // 4
    xs = x.astype(jnp.float32).reshape(*x.shape[:-1], 2, 2, q4)
    x1, x2 = xs[..., 0, :], xs[..., 1, :]
    c = cos.reshape(L, 2, q4)
    s = sin.reshape(L, 2, q4)
    return jnp.stack([x1 * c - x2 * s, x2 * c + x1 * s], axis=-2).reshape(x.shape)


def attention_branch(q, k, v, gq, gk, cos, sin):
    B, L, _ = q.shape
    G = ATT_HEADS // ATT_KV_HEADS
    qh = q.reshape(B, L, ATT_KV_HEADS, G, HEAD_DIM).transpose(0, 2, 3, 1, 4)
    kh = k.reshape(B, L, ATT_KV_HEADS, HEAD_DIM).transpose(0, 2, 1, 3)
    vh = v.reshape(B, L, ATT_KV_HEADS, HEAD_DIM).transpose(0, 2, 1, 3)
    qh = apply_axial_rope(rmsnorm(qh, gq), cos, sin) * HEAD_DIM ** -0.5
    kh = apply_axial_rope(rmsnorm(kh, gk), cos, sin)
    pad = Q_BLOCK - N_META
    qp = jnp.pad(qh, ((0, 0), (0, 0), (0, 0), (pad, 0), (0, 0)))
    nblk = qp.shape[3] // Q_BLOCK
    qb = jnp.moveaxis(qp.reshape(B, ATT_KV_HEADS, G, nblk, Q_BLOCK, HEAD_DIM), 3, 0)

    def block(qblk):
        s = jnp.einsum('bkgqd,bksd->bkgqs', qblk, kh)
        p = jax.nn.softmax(s, axis=-1)
        return jnp.einsum('bkgqs,bksd->bkgqd', p.astype(vh.dtype), vh)

    o = lax.map(block, qb)
    o = jnp.moveaxis(o, 0, 3).reshape(B, ATT_KV_HEADS, G, nblk * Q_BLOCK, HEAD_DIM)[:, :, :, pad:]
    return o.transpose(0, 3, 1, 2, 4).reshape(B, L, ATT_Q).astype(q.dtype)


def mixer(z, w_in, gla_w2, gla_b2, gla_gn, q_norm, k_norm, w_pa, w_pb, b_merge, w_out, cos, sin):
    h = z @ w_in
    (q_a, k_a, v_a, r_a, lr_f, lr_b, q_b, k_b, v_b, g_a, g_b) = jnp.split(h, SPLIT_POINTS, axis=-1)
    a = gla_branch(q_a, k_a, v_a, r_a, lr_f, lr_b, gla_w2, gla_b2, gla_gn)
    b = attention_branch(q_b, k_b, v_b, q_norm, k_norm, cos, sin)
    y = (jax.nn.sigmoid(g_a + b_merge[0]) * (a @ w_pa)
         + jax.nn.sigmoid(g_b + b_merge[1]) * (b @ w_pb))
    return y @ w_out


def setup_inputs(seed: int = 0) -> dict:
    key = jax.random.key(seed)
    ks = jax.random.split(key, 18)

    def nrm(k, shape, scale):
        return jax.random.normal(k, shape, jnp.float32) * scale

    return {
        "x": nrm(ks[0], (BATCH, SEQ, D_MODEL), 1.0),
        "meta_tokens": nrm(ks[1], (N_META, D_MODEL), 1.0),
        "norm_gains": 1.0 + nrm(ks[2], (DEPTH, 3, D_MODEL), 0.02),
        "ffn_w_gate": nrm(ks[3], (DEPTH, 2, D_MODEL, D_FF), D_MODEL ** -0.5),
        "ffn_w_up": nrm(ks[4], (DEPTH, 2, D_MODEL, D_FF), D_MODEL ** -0.5),
        "ffn_w_down": nrm(ks[5], (DEPTH, 2, D_FF, D_MODEL), D_FF ** -0.5),
        "w_in": nrm(ks[6], (DEPTH, D_MODEL, D_IN), D_MODEL ** -0.5),
        "gla_w2": nrm(ks[7], (DEPTH, 2, GLA_RANK, GLA_KEY), GLA_RANK ** -0.5),
        "gla_b2": nrm(ks[8], (DEPTH, 2, GLA_KEY), 0.1),
        "gla_gn": 1.0 + nrm(ks[9], (DEPTH, GLA_VAL), 0.02),
        "q_norm": 1.0 + nrm(ks[10], (DEPTH, HEAD_DIM), 0.02),
        "k_norm": 1.0 + nrm(ks[11], (DEPTH, HEAD_DIM), 0.02),
        "w_pa": nrm(ks[12], (DEPTH, GLA_VAL, D_MODEL), GLA_VAL ** -0.5),
        "w_pb": nrm(ks[13], (DEPTH, ATT_Q, D_MODEL), ATT_Q ** -0.5),
        "b_merge": nrm(ks[14], (DEPTH, 2, D_MODEL), 0.02),
        "w_out": nrm(ks[15], (DEPTH, D_MODEL, D_MODEL), D_MODEL ** -0.5),
        "final_norm": 1.0 + nrm(ks[16], (D_MODEL,), 0.02),
    }


def reference(x, meta_tokens, norm_gains, ffn_w_gate, ffn_w_up, ffn_w_down, w_in, gla_w2, gla_b2,
              gla_gn, q_norm, k_norm, w_pa, w_pb, b_merge, w_out, final_norm):
    B, N, D = x.shape
    meta = jnp.broadcast_to(meta_tokens[None].astype(x.dtype), (B, N_META, D))
    h = jnp.concatenate([meta, x], axis=1)
    cos, sin = axial_rope_tables(N)
    for l in range(DEPTH):
        h = h + 0.5 * swiglu(rmsnorm(h, norm_gains[l, 0]),
                             ffn_w_gate[l, 0], ffn_w_up[l, 0], ffn_w_down[l, 0])
        h = h + mixer(rmsnorm(h, norm_gains[l, 1]), w_in[l], gla_w2[l], gla_b2[l], gla_gn[l],
                      q_norm[l], k_norm[l], w_pa[l], w_pb[l], b_merge[l], w_out[l], cos, sin)
        h = h + 0.5 * swiglu(rmsnorm(h, norm_gains[l, 2]),
                             ffn_w_gate[l, 1], ffn_w_up[l, 1], ffn_w_down[l, 1])
    return rmsnorm(h, final_norm)[:, N_META:]
```

```cpp
#include <hip/hip_runtime.h>
#include <hip/hip_cooperative_groups.h>
#include <cstdio>
#include <cstdint>
namespace cg = cooperative_groups;
__device__ __forceinline__ int mk_tid() { int t = threadIdx.x; asm volatile("" : "+v"(t)); return t; }
namespace pg8 {
#define PG8_LAS __attribute__((address_space(3)))
typedef unsigned short bf16_t;
typedef short bf16x8 __attribute__((ext_vector_type(8)));
typedef float f32x4 __attribute__((ext_vector_type(4)));
typedef unsigned u32x4 __attribute__((ext_vector_type(4)));
constexpr int BM = 256, BK = 64, HALF = 128, HTB = HALF * BK * 2  , STAGE_BYTES = 8 * HTB, NXCD = 8, WGM = 8;

__host__ __device__ __forceinline__ int lds_byte(int r, int c) { const int st = (r >> 4) * 2 + (c >> 5), rr = r & 15, cc = c & 31, ob = rr * 64 + cc * 2; return st * 1024 + (ob ^ (((ob >> 9) & 1) << 5)); }
__host__ __device__ __forceinline__ void stage_rc(int b, int& R, int& C) { const int st = b / 1024, sb = b % 1024, swz = sb ^ (((sb >> 9) & 1) << 5); R = (st >> 1) * 16 + swz / 64; C = (st & 1) * 32 + (swz % 64) / 2; }
__host__ __device__ __forceinline__ int perm32(int rho) { const int n = rho >> 4, i = rho & 15; return 8 * (i >> 2) + 4 * n + (i & 3); }

struct Unit { int pm, pn; };
struct Gemm { const bf16_t* A; const bf16_t* Bt; int M, N, K; };

struct StaticOrder {
    int nM, nN, nwg, G, c;
    __host__ __device__ void init(int M, int N, int G_, int c_) { nM = M / BM; nN = N / BM; nwg = nM * nN; G = G_; c = c_; }
    __host__ __device__ bool next(int i, Unit& u) const {
        const long L = (long)i * G + c; if (L >= nwg) return false;
        int wgid = (int)L; { const int q = nwg / NXCD, r = nwg % NXCD, xcd = wgid % NXCD, off = wgid / NXCD; wgid = (xcd < r ? xcd * (q + 1) : r * (q + 1) + (xcd - r) * q) + off; }
        const int nig = WGM * nN, gid = wgid / nig, fm = gid * WGM, gsz = (nM - fm) < WGM ? (nM - fm) : WGM;
        u.pm = fm + ((wgid % nig) % gsz); u.pn = (wgid % nig) / gsz; return true;
    }
    __device__ __forceinline__ void a_ready(const Unit&) const {}
    __device__ __forceinline__ void done(const Unit&) const {}
};

__device__ __forceinline__ unsigned cvt_pk_bf16(float lo, float hi) { unsigned r; asm volatile("v_cvt_pk_bf16_f32 %0, %1, %2" : "=v"(r) : "v"(lo), "v"(hi)); return r; }
typedef float f32x2 __attribute__((ext_vector_type(2)));
template <class Epi, class Sched, bool ALIGN_EPI = false, bool SP2 = false>
__device__ __forceinline__ void gemm_phase(PG8_LAS unsigned char* lds, const Gemm g, const Sched& S, const Epi& E) {
    const int tid = mk_tid(), wid = __builtin_amdgcn_readfirstlane(tid >> 6), lane = tid & 63, wr = wid >> 2, wc = wid & 3, fr = lane & 15, fq = lane >> 4;
    const int K = g.K, nt = K / BK;
    unsigned voffA[2], voffB[2];
#pragma unroll
    for (int i = 0; i < 2; ++i) { int R, C; stage_rc(tid * 16 + i * 8192, R, C); const int Rb = Epi::PERM ? ((R & ~31) + perm32(R & 31)) : R;
        voffA[i] = (unsigned)(R * K + C) * 2u; voffB[i] = (unsigned)(Rb * K + C) * 2u; }
    const size_t kstep = (size_t)(BK * 2);
    const size_t hstep = (size_t)HALF * K * 2;
    const size_t tstep = 2 * hstep;
    const unsigned ldsw = (unsigned)wid * 1024u;
    const int aoff = lds_byte(wr * 64 + fr, fq * 8), boff = lds_byte(wc * 32 + fr, fq * 8);
#define PG8_SA(b, h) (((b) * 2 + (h)) * HTB)
#define PG8_SB(b, h) ((4 + (b) * 2 + (h)) * HTB)
#define PG8_STAGE(bufoff, gbase, voff) do { _Pragma("unroll") for (int _i = 0; _i < 2; ++_i) \
        __builtin_amdgcn_global_load_lds((const unsigned*)((const char*)(gbase) + (voff)[_i]), (PG8_LAS unsigned*)(lds + (bufoff) + ldsw + _i * 8192), 16, 0, 0); } while (0)
#define PG8_LDA(dst, b, h) do { _Pragma("unroll") for (int m = 0; m < 4; ++m) _Pragma("unroll") for (int k = 0; k < 2; ++k) dst[m][k] = *(const PG8_LAS bf16x8*)(lds + PG8_SA(b, h) + aoff + m * 2048 + k * 1024); } while (0)
#define PG8_LDB(dst, b, h) do { _Pragma("unroll") for (int n = 0; n < 2; ++n) _Pragma("unroll") for (int k = 0; k < 2; ++k) dst[n][k] = *(const PG8_LAS bf16x8*)(lds + PG8_SB(b, h) + boff + n * 2048 + k * 1024); } while (0)
#define PG8_MMA(ai, bj, At, Bt) do { __builtin_amdgcn_s_setprio(1); _Pragma("unroll") for (int m = 0; m < 4; ++m) _Pragma("unroll") for (int n = 0; n < 2; ++n) _Pragma("unroll") for (int k = 0; k < 2; ++k) \
        acc[ai][bj][m][n] = __builtin_amdgcn_mfma_f32_16x16x32_bf16(Bt[n][k], At[m][k], acc[ai][bj][m][n], 0, 0, 0); __builtin_amdgcn_s_setprio(0); } while (0)
#define PG8_WAIT_V(n) asm volatile("s_waitcnt vmcnt(" #n ")" ::: "memory")
#define PG8_WAIT_L(n) asm volatile("s_waitcnt lgkmcnt(" #n ")" ::: "memory")
#define PG8_BAR __builtin_amdgcn_s_barrier()
#define PG8_SCHED __builtin_amdgcn_sched_barrier(0)
    Unit cur, nxt; int ui = 0;
    if (!S.next(0, cur)) return;
    f32x4 acc[2][2][4][2];
#pragma unroll
    for (int a = 0; a < 2; ++a)
#pragma unroll
        for (int b = 0; b < 2; ++b)
#pragma unroll
            for (int m = 0; m < 4; ++m)
#pragma unroll
                for (int n = 0; n < 2; ++n) acc[a][b][m][n] = (f32x4){0.f, 0.f, 0.f, 0.f};
    bf16x8 At[4][2], B0[2][2], B1[2][2];
    const char* cA = (const char*)g.A + (size_t)cur.pm * tstep; const char* cB = (const char*)g.Bt + (size_t)cur.pn * tstep;
    S.a_ready(cur);
    if constexpr (SP2) {
        PG8_STAGE(PG8_SB(0, 0), cB, voffB); PG8_STAGE(PG8_SB(0, 1), cB + hstep, voffB); PG8_STAGE(PG8_SA(0, 0), cA, voffA); PG8_STAGE(PG8_SA(0, 1), cA + hstep, voffA);
        if (wr == 1) PG8_BAR;
        PG8_WAIT_V(2); PG8_BAR;
        PG8_STAGE(PG8_SB(1, 0), cB + kstep, voffB); PG8_STAGE(PG8_SA(1, 0), cA + kstep, voffA); PG8_STAGE(PG8_SB(1, 1), cB + hstep + kstep, voffB);
        PG8_WAIT_V(6); PG8_BAR;
    } else {
        PG8_STAGE(PG8_SB(0, 0), cB, voffB); PG8_STAGE(PG8_SA(0, 0), cA, voffA); PG8_STAGE(PG8_SB(0, 1), cB + hstep, voffB); PG8_STAGE(PG8_SA(0, 1), cA + hstep, voffA);
        if (wr == 1) PG8_BAR;
        PG8_WAIT_V(4); PG8_BAR;
        PG8_STAGE(PG8_SB(1, 0), cB + kstep, voffB); PG8_STAGE(PG8_SA(1, 0), cA + kstep, voffA); PG8_STAGE(PG8_SB(1, 1), cB + hstep + kstep, voffB);
        PG8_WAIT_V(6); PG8_BAR;
    }
    for (;;) {
        const bool has_next = S.next(ui + 1, nxt);
        const char* nA = has_next ? (const char*)g.A + (size_t)nxt.pm * tstep : cA; const char* nB = has_next ? (const char*)g.Bt + (size_t)nxt.pn * tstep : cB;
        for (int t = 0; t < nt; t += 2) {
            const bool last = (t == nt - 2);
            const char* a1 = cA + (size_t)(t + 1) * kstep;
            const char* a2 = last ? nA : cA + (size_t)(t + 2) * kstep; const char* b2 = last ? nB : cB + (size_t)(t + 2) * kstep;
            const char* a3 = a2 + kstep; const char* b3 = b2 + kstep;
            if (last && has_next) S.a_ready(nxt);
            if constexpr (SP2) {
            PG8_LDB(B0, 0, 0); PG8_LDB(B1, 0, 1); PG8_SCHED; PG8_LDA(At, 0, 0); PG8_STAGE(PG8_SA(1, 1), a1 + hstep, voffA);
            PG8_WAIT_V(8); PG8_WAIT_L(0); PG8_BAR; PG8_MMA(0, 0, At, B0); PG8_MMA(0, 1, At, B1); PG8_BAR; PG8_SCHED;
            PG8_LDA(At, 0, 1); PG8_STAGE(PG8_SB(0, 0), b2, voffB); PG8_STAGE(PG8_SB(0, 1), b2 + hstep, voffB); PG8_STAGE(PG8_SA(0, 0), a2, voffA);
            PG8_WAIT_V(8); PG8_WAIT_L(0); PG8_BAR; PG8_MMA(1, 0, At, B0); PG8_MMA(1, 1, At, B1); PG8_BAR; PG8_SCHED;
            PG8_LDB(B0, 1, 0); PG8_LDB(B1, 1, 1); PG8_SCHED; PG8_LDA(At, 1, 0); PG8_STAGE(PG8_SA(0, 1), a2 + hstep, voffA);
            PG8_WAIT_V(8); PG8_WAIT_L(0); PG8_BAR; PG8_MMA(0, 0, At, B0); PG8_MMA(0, 1, At, B1); PG8_BAR; PG8_SCHED;
            PG8_LDA(At, 1, 1); PG8_STAGE(PG8_SB(1, 0), b3, voffB); PG8_STAGE(PG8_SB(1, 1), b3 + hstep, voffB); PG8_STAGE(PG8_SA(1, 0), a3, voffA);
            PG8_WAIT_V(8); PG8_WAIT_L(0); PG8_BAR; PG8_MMA(1, 0, At, B0); PG8_MMA(1, 1, At, B1); PG8_BAR; PG8_SCHED;
            } else {
            PG8_LDB(B0, 0, 0); PG8_SCHED; PG8_LDA(At, 0, 0); PG8_STAGE(PG8_SA(1, 1), a1 + hstep, voffA);
            PG8_WAIT_L(8); PG8_BAR; PG8_WAIT_L(0); PG8_MMA(0, 0, At, B0); PG8_BAR; PG8_SCHED;
            PG8_LDB(B1, 0, 1); PG8_STAGE(PG8_SB(0, 0), b2, voffB);
            PG8_BAR; PG8_WAIT_L(0); PG8_MMA(0, 1, At, B1); PG8_BAR;
            PG8_LDA(At, 0, 1); PG8_STAGE(PG8_SA(0, 0), a2, voffA);
            PG8_BAR; PG8_WAIT_L(0); PG8_MMA(1, 0, At, B0); PG8_BAR; PG8_SCHED;
            PG8_STAGE(PG8_SB(0, 1), b2 + hstep, voffB);
            PG8_WAIT_V(6); PG8_BAR; PG8_MMA(1, 1, At, B1); PG8_BAR;
            PG8_LDB(B0, 1, 0); PG8_SCHED; PG8_LDA(At, 1, 0); PG8_STAGE(PG8_SA(0, 1), a2 + hstep, voffA);
            PG8_WAIT_L(8); PG8_BAR; PG8_WAIT_L(0); PG8_MMA(0, 0, At, B0); PG8_BAR; PG8_SCHED;
            PG8_LDB(B1, 1, 1); PG8_STAGE(PG8_SB(1, 0), b3, voffB);
            PG8_BAR; PG8_WAIT_L(0); PG8_MMA(0, 1, At, B1); PG8_BAR;
            PG8_LDA(At, 1, 1); PG8_STAGE(PG8_SA(1, 0), a3, voffA);
            PG8_BAR; PG8_WAIT_L(0); PG8_MMA(1, 0, At, B0); PG8_BAR; PG8_SCHED;
            PG8_STAGE(PG8_SB(1, 1), b3 + hstep, voffB);
            PG8_WAIT_V(6); PG8_BAR; PG8_MMA(1, 1, At, B1); PG8_BAR;
            }
        }
        if constexpr (ALIGN_EPI) { if (wr == 0) PG8_BAR; }
        if constexpr (!Epi::AFTER_DRAIN) { E(acc, cur, wr, wc, fr, fq); S.done(cur); }
        if (!has_next) break;
#pragma unroll
        for (int a = 0; a < 2; ++a)
#pragma unroll
            for (int b = 0; b < 2; ++b)
#pragma unroll
                for (int m = 0; m < 4; ++m)
#pragma unroll
                    for (int n = 0; n < 2; ++n) acc[a][b][m][n] = (f32x4){0.f, 0.f, 0.f, 0.f};
        cur = nxt; cA = nA; cB = nB; ++ui;
        if constexpr (ALIGN_EPI) { if (wr == 1) PG8_BAR; }
    }
    PG8_WAIT_V(0);
    if constexpr (!ALIGN_EPI) { if (wr == 0) PG8_BAR; }
    PG8_BAR;
    if constexpr (Epi::AFTER_DRAIN) { E.fused(acc, cur, wr, wc, fr, fq, lds, wid, lane); S.done(cur); }
#undef PG8_SA
#undef PG8_SB
#undef PG8_STAGE
#undef PG8_LDA
#undef PG8_LDB
#undef PG8_MMA
#undef PG8_WAIT_V
#undef PG8_WAIT_L
#undef PG8_BAR
#undef PG8_SCHED
}
}
#ifndef PH_MASK
#define PH_MASK 0xffff
#endif
#define PHON(k) ((PH_MASK >> (k)) & 1)
#ifndef MK_SINGLE
#define MK_SINGLE 1
#endif
#define LAS __attribute__((address_space(3)))
typedef unsigned short bf16_t;
typedef short bf16x8 __attribute__((ext_vector_type(8)));
typedef float f32x4 __attribute__((ext_vector_type(4)));
typedef float f32x16 __attribute__((ext_vector_type(16)));
typedef unsigned u32x4 __attribute__((ext_vector_type(4)));
typedef unsigned u32x2 __attribute__((ext_vector_type(2)));

constexpr int D = 1024, NB = 8, SEQ = 4096, DEPTH = 4, NMETA = 16, DFF = 2816, DIN = 4384;
constexpr int MX = NB * SEQ;
constexpr int MROWS = MX + 256;
constexpr int NVALID = MX + NB * NMETA;
constexpr int LP = 4160;
constexpr int NCH = 65;
constexpr float EPS = 1e-6f;
constexpr float LOG2E = 1.4426950408889634f;
constexpr int WIN_N = 4608;
constexpr int NPH = 45;

constexpr size_t SZ_H = (size_t)MROWS * D * 4, SZ_512 = (size_t)MROWS * 512 * 2, SZ_128 = (size_t)MROWS * 128 * 2;
constexpr size_t SZ_VT = (size_t)NB * 2 * 64 * LP * 2, SZ_LR = (size_t)MROWS * 32 * 4, SZ_GT = (size_t)MROWS * 2048 * 2;
constexpr size_t OFF_H = 0;
constexpr size_t OFF_QKA = OFF_H + SZ_H, OFF_VA = OFF_QKA + SZ_512, OFF_RA = OFF_VA + SZ_512, OFF_QB = OFF_RA + SZ_512;
constexpr size_t OFF_KB = OFF_QB + SZ_512, OFF_VT = OFF_KB + SZ_128, OFF_LR = OFF_VT + SZ_VT, OFF_GT = OFF_LR + SZ_LR, R_END = OFF_GT + SZ_GT;
constexpr size_t OFF_HID = OFF_QKA;
constexpr size_t OFF_Y = OFF_QKA;
static_assert((size_t)MROWS * DFF * 2 <= R_END - OFF_QKA, "hid overlay");
constexpr size_t SZ_S = (size_t)64 * NCH * 8192 * 2, SZ_DEC = (size_t)64 * NCH * 64 * 4, SZ_SSQ = (size_t)13 * MROWS * 16 * 4, SZ_ROPE = (size_t)SEQ * 64 * 4;
constexpr size_t OFF_S = R_END, OFF_DEC = OFF_S + SZ_S, OFF_SSQ = OFF_DEC + SZ_DEC, OFF_ROPE = OFF_SSQ + SZ_SSQ, WS_END = OFF_ROPE + SZ_ROPE;
constexpr size_t OO_HB = 0, OO_WT = (size_t)MROWS * D * 2;
constexpr size_t WT_GU0 = 0, WT_DN0 = WT_GU0 + (size_t)5632 * 1024, WT_WIN = WT_DN0 + (size_t)1024 * 2816, WT_PA = WT_WIN + (size_t)WIN_N * 1024,
                 WT_PB = WT_PA + (size_t)1024 * 512, WT_OUT = WT_PB + (size_t)1024 * 512, WT_GU1 = WT_OUT + (size_t)1024 * 1024, WT_DN1 = WT_GU1 + (size_t)5632 * 1024,
                 WT_END = WT_DN1 + (size_t)1024 * 2816;
static_assert(OO_WT + WT_END * 2 <= (size_t)MX * D * 4, "d_out scratch");

constexpr int LDS_BYTES = 147456;

struct Params {
    const float *x, *meta, *ng, *wg, *wu, *wd, *win, *w2, *b2, *gn, *qn, *kn, *wpa, *wpb, *bm, *wout, *fn;
    float* out; unsigned char* ws; int ph_lo, ph_hi;
};

typedef float f32x2_t __attribute__((ext_vector_type(2))); typedef __bf16 bf16x2_t __attribute__((ext_vector_type(2)));
__device__ __forceinline__ unsigned pk(float lo, float hi) { f32x2_t v = {lo, hi}; bf16x2_t b = __builtin_convertvector(v, bf16x2_t); return __builtin_bit_cast(unsigned, b); }
__device__ __forceinline__ float bflo(unsigned w) { return __uint_as_float(w << 16); }
__device__ __forceinline__ float bfhi(unsigned w) { return __uint_as_float(w & 0xffff0000u); }
__device__ __forceinline__ float bf1(unsigned short b) { return __uint_as_float((unsigned)b << 16); }
__device__ __forceinline__ unsigned short f2bf(float f) { return (unsigned short)(pk(f, 0.f) & 0xffffu); }
__device__ __forceinline__ float fexp(float x) { return __builtin_amdgcn_exp2f(x * LOG2E); }
__device__ __forceinline__ float sigm(float x) { return __builtin_amdgcn_rcpf(1.f + fexp(-x)); }
__device__ __forceinline__ float siluf(float x) { return x * sigm(x); }
__device__ __forceinline__ float rstd_row(const float* ssq, int row) {
    const f32x4* q = (const f32x4*)(ssq + (size_t)row * 16); const f32x4 a = q[0], b = q[1], c = q[2], d = q[3];
    const float t = ((a[0] + a[1]) + (a[2] + a[3])) + ((b[0] + b[1]) + (b[2] + b[3])) + ((c[0] + c[1]) + (c[2] + c[3])) + ((d[0] + d[1]) + (d[2] + d[3]));
    return __builtin_amdgcn_rsqf(t * (1.0f / D) + EPS); }
#define LDS_WAIT() asm volatile("s_waitcnt lgkmcnt(0)" ::: "memory")

struct EpiSwiglu {
    static constexpr bool PERM = true, AFTER_DRAIN = false;
    bf16_t* O; const float* ssq;
    __device__ __forceinline__ void operator()(const f32x4 (&acc)[2][2][4][2], const pg8::Unit& u, int wr, int wc, int fr, int fq) const {
        int row0 = u.pm * 256 + wr * 64 + fr; asm volatile("" : "+v"(row0)); const int col0 = u.pn * 128 + wc * 32 + 8 * fq;
#pragma unroll
        for (int ai = 0; ai < 2; ++ai)
#pragma unroll
            for (int m = 0; m < 4; ++m) {
                const int row = row0 + ai * 128 + m * 16; const float rs = rstd_row(ssq, row);
                float h[8];
#pragma unroll
                for (int n = 0; n < 2; ++n)
#pragma unroll
                    for (int e = 0; e < 4; ++e) { const float g = acc[ai][0][m][n][e] * rs, up = acc[ai][1][m][n][e] * rs; h[n * 4 + e] = siluf(g) * up; }
                u32x4 w; w.x = pk(h[0], h[1]); w.y = pk(h[2], h[3]); w.z = pk(h[4], h[5]); w.w = pk(h[6], h[7]);
                *(u32x4*)(O + (size_t)row * DFF + col0) = w;
                asm volatile("" ::: "memory");
            }
    }
};
struct EpiResid {
    static constexpr bool PERM = true, AFTER_DRAIN = false;
    float* H; bf16_t* HB; float* ssq_out; float scale;
    __device__ __forceinline__ void operator()(const f32x4 (&acc)[2][2][4][2], const pg8::Unit& u, int wr, int wc, int fr, int fq) const {
        int row0 = u.pm * 256 + wr * 64 + fr; asm volatile("" : "+v"(row0)); const int col0 = u.pn * 256 + wc * 32 + 8 * fq;
#pragma unroll
        for (int ai = 0; ai < 2; ++ai)
#pragma unroll
            for (int m = 0; m < 4; ++m) {
                const int row = row0 + ai * 128 + m * 16; float ss = 0.f;
#pragma unroll
                for (int bj = 0; bj < 2; ++bj) {
                    float* hp = H + (size_t)row * D + col0 + bj * 128;
                    f32x4 h0 = *(const f32x4*)hp, h1 = *(const f32x4*)(hp + 4);
                    h0 = h0 + acc[ai][bj][m][0] * scale; h1 = h1 + acc[ai][bj][m][1] * scale;
                    *(f32x4*)hp = h0; *(f32x4*)(hp + 4) = h1;
                    u32x4 w; w.x = pk(h0[0], h0[1]); w.y = pk(h0[2], h0[3]); w.z = pk(h1[0], h1[1]); w.w = pk(h1[2], h1[3]);
                    *(u32x4*)(HB + (size_t)row * D + col0 + bj * 128) = w;
                    ss += (h0[0] * h0[0] + h0[1] * h0[1]) + (h0[2] * h0[2] + h0[3] * h0[3]) + (h1[0] * h1[0] + h1[1] * h1[1]) + (h1[2] * h1[2] + h1[3] * h1[3]);
                }
                ss += __shfl_xor(ss, 16); ss += __shfl_xor(ss, 32);
                if (fq == 0) ssq_out[(size_t)row * 16 + u.pn * 4 + wc] = ss;
                asm volatile("" ::: "memory");
            }
    }
};
struct EpiWin {
    static constexpr bool PERM = true, AFTER_DRAIN = false;
    unsigned char* ws; const float* ssq;
    __device__ __forceinline__ void operator()(const f32x4 (&acc)[2][2][4][2], const pg8::Unit& u, int wr, int wc, int fr, int fq) const {
        int row0 = u.pm * 256 + wr * 64 + fr; asm volatile("" : "+v"(row0)); const int cw = wc * 32 + 8 * fq, pn = u.pn;
#pragma unroll
        for (int ai = 0; ai < 2; ++ai)
#pragma unroll
            for (int m = 0; m < 4; ++m) {
                const int row = row0 + ai * 128 + m * 16; const float rs = rstd_row(ssq, row);
                if (pn < 8) {
                    bf16_t* base = (bf16_t*)(ws + OFF_QKA + (size_t)(pn >> 1) * SZ_512) + (size_t)row * 512 + (pn & 1) * 256 + cw;
                    const float sc = (pn == 0) ? rs * 0.125f : rs;
#pragma unroll
                    for (int bj = 0; bj < 2; ++bj) { const f32x4 a = acc[ai][bj][m][0] * sc, b = acc[ai][bj][m][1] * sc;
                        u32x4 w; w.x = pk(a[0], a[1]); w.y = pk(a[2], a[3]); w.z = pk(b[0], b[1]); w.w = pk(b[2], b[3]); *(u32x4*)(base + bj * 128) = w; }
                } else if (pn == 8) {
                    { const f32x4 a = acc[ai][0][m][0] * rs, b = acc[ai][0][m][1] * rs;
                      u32x4 w; w.x = pk(a[0], a[1]); w.y = pk(a[2], a[3]); w.z = pk(b[0], b[1]); w.w = pk(b[2], b[3]); *(u32x4*)((bf16_t*)(ws + OFF_KB) + (size_t)row * 128 + cw) = w; }
                    if (row < NVALID) {
                        int bb, pos; if (row < MX) { bb = row >> 12; pos = 64 + (row & 4095); } else { bb = (row - MX) >> 4; pos = 48 + ((row - MX) & 15); }
                        const int kvh = cw >> 6, d0 = cw & 63;
                        bf16_t* vt = (bf16_t*)(ws + OFF_VT) + ((size_t)(bb * 2 + kvh) * 64 + d0) * LP + pos;
#pragma unroll
                        for (int n = 0; n < 2; ++n)
#pragma unroll
                            for (int e = 0; e < 4; ++e) vt[(size_t)(n * 4 + e) * LP] = f2bf(acc[ai][1][m][n][e] * rs);
                    }
                } else if (pn == 9) {
                    if (wc == 0) { float* lp = (float*)(ws + OFF_LR) + (size_t)row * 32 + 8 * fq; *(f32x4*)lp = acc[ai][0][m][0] * rs; *(f32x4*)(lp + 4) = acc[ai][0][m][1] * rs; }
                } else {
                    const int gc = (pn - 10) * 256 + cw; bf16_t* base = (bf16_t*)(ws + OFF_GT) + (size_t)row * 2048 + gc;
#pragma unroll
                    for (int bj = 0; bj < 2; ++bj) { const f32x4 a = acc[ai][bj][m][0] * rs, b = acc[ai][bj][m][1] * rs;
                        u32x4 w; w.x = pk(a[0], a[1]); w.y = pk(a[2], a[3]); w.z = pk(b[0], b[1]); w.w = pk(b[2], b[3]); *(u32x4*)(base + bj * 128) = w; }
                }
                asm volatile("" ::: "memory");
            }
    }
};
template <int SECOND> struct EpiMerge {
    static constexpr bool PERM = true, AFTER_DRAIN = false;
    bf16_t* Y; const bf16_t* G; const float* bm;
    __device__ __forceinline__ void operator()(const f32x4 (&acc)[2][2][4][2], const pg8::Unit& u, int wr, int wc, int fr, int fq) const {
        int row0 = u.pm * 256 + wr * 64 + fr; asm volatile("" : "+v"(row0)); const int col0 = u.pn * 256 + wc * 32 + 8 * fq;
#pragma unroll
        for (int ai = 0; ai < 2; ++ai)
#pragma unroll
            for (int m = 0; m < 4; ++m) {
                const int row = row0 + ai * 128 + m * 16;
#pragma unroll
                for (int bj = 0; bj < 2; ++bj) {
                    const int col = col0 + bj * 128;
                    const u32x4 g = *(const u32x4*)(G + (size_t)row * 2048 + SECOND * 1024 + col);
                    const f32x4 b0 = *(const f32x4*)(bm + SECOND * 1024 + col), b1 = *(const f32x4*)(bm + SECOND * 1024 + col + 4);
                    float v[8];
                    v[0] = sigm(bflo(g.x) + b0[0]) * acc[ai][bj][m][0][0]; v[1] = sigm(bfhi(g.x) + b0[1]) * acc[ai][bj][m][0][1]; v[2] = sigm(bflo(g.y) + b0[2]) * acc[ai][bj][m][0][2]; v[3] = sigm(bfhi(g.y) + b0[3]) * acc[ai][bj][m][0][3];
                    v[4] = sigm(bflo(g.z) + b1[0]) * acc[ai][bj][m][1][0]; v[5] = sigm(bfhi(g.z) + b1[1]) * acc[ai][bj][m][1][1]; v[6] = sigm(bflo(g.w) + b1[2]) * acc[ai][bj][m][1][2]; v[7] = sigm(bfhi(g.w) + b1[3]) * acc[ai][bj][m][1][3];
                    bf16_t* yp = Y + (size_t)row * D + col;
                    if (SECOND) { const u32x4 y = *(const u32x4*)yp;
                        v[0] += bflo(y.x); v[1] += bfhi(y.x); v[2] += bflo(y.y); v[3] += bfhi(y.y); v[4] += bflo(y.z); v[5] += bfhi(y.z); v[6] += bflo(y.w); v[7] += bfhi(y.w); }
                    u32x4 w; w.x = pk(v[0], v[1]); w.y = pk(v[2], v[3]); w.z = pk(v[4], v[5]); w.w = pk(v[6], v[7]); *(u32x4*)yp = w;
                    asm volatile("" ::: "memory");
                }
            }
    }
};

__device__ __forceinline__ void conv_item(const float* W, int N, int K, int src_n0, const float* gain, bf16_t* WT, int n0, int k0, LAS float* scr, int lane) {
#pragma unroll 8
    for (int i = 0; i < 32; ++i) { const int kk = 2 * i + (lane >> 5); float v = 0.f;
        if (src_n0 >= 0) { v = W[(size_t)(k0 + kk) * N + src_n0 + (lane & 31)]; if (gain) v *= gain[k0 + kk]; }
        scr[kk * 33 + (lane & 31)] = v; }
    LDS_WAIT(); __builtin_amdgcn_wave_barrier();
    const int c = lane & 7;
#pragma unroll
    for (int j = 0; j < 4; ++j) { const int n = (lane >> 3) + 8 * j; const LAS float* s = scr + (8 * c) * 33 + n;
        u32x4 o; o.x = pk(s[0 * 33], s[1 * 33]); o.y = pk(s[2 * 33], s[3 * 33]); o.z = pk(s[4 * 33], s[5 * 33]); o.w = pk(s[6 * 33], s[7 * 33]);
        *(u32x4*)(WT + (size_t)(n0 + n) * K + k0 + 8 * c) = o; }
    LDS_WAIT(); __builtin_amdgcn_wave_barrier();
}
__device__ __forceinline__ int conv_win_src(int n0) {
    if (n0 < 1536) return n0;
    if (n0 < 2304) return n0 + 32;
    if (n0 == 2304) return 1536;
    if (n0 < 2560) return -1;
    return n0 - 224;
}
__device__ __forceinline__ void conv_layer(const Params& p, int l, LAS unsigned char* lds, int gw, int ngw, int wid, int lane) {
    LAS float* scr = (LAS float*)(lds + wid * 8448);
    bf16_t* WT = (bf16_t*)((unsigned char*)p.out + OO_WT);
    constexpr int I_GU = 16 * 176, I_DN = 44 * 32, I_WIN = 16 * 144, I_P = 8 * 32, I_O = 16 * 32;
    constexpr int NIT = 2 * I_GU + 2 * I_DN + I_WIN + 2 * I_P + I_O;
    for (int it = gw; it < NIT; it += ngw) {
        int r = it;
        if (r < 2 * I_GU) { const int f = r / I_GU; r -= f * I_GU; const int kb = r / 176, nb = r % 176, n0 = nb * 32;
            const int t = n0 >> 8, half = (n0 >> 7) & 1, j0 = n0 & 127;
            const float* W = (half ? p.wu : p.wg) + (size_t)(l * 2 + f) * D * DFF;
            conv_item(W, DFF, D, 128 * t + j0, p.ng + (size_t)(l * 3 + (f ? 2 : 0)) * D, WT + (f ? WT_GU1 : WT_GU0), n0, kb * 64, scr, lane); continue; }
        r -= 2 * I_GU;
        if (r < 2 * I_DN) { const int f = r / I_DN; r -= f * I_DN; const int kb = r / 32, nb = r % 32;
            conv_item(p.wd + (size_t)(l * 2 + f) * DFF * D, D, DFF, nb * 32, nullptr, WT + (f ? WT_DN1 : WT_DN0), nb * 32, kb * 64, scr, lane); continue; }
        r -= 2 * I_DN;
        if (r < I_WIN) { const int kb = r / 144, nb = r % 144;
            conv_item(p.win + (size_t)l * D * DIN, DIN, D, conv_win_src(nb * 32), p.ng + (size_t)(l * 3 + 1) * D, WT + WT_WIN, nb * 32, kb * 64, scr, lane); continue; }
        r -= I_WIN;
        if (r < 2 * I_P) { const int f = r / I_P; r -= f * I_P; const int kb = r / 32, nb = r % 32;
            conv_item((f ? p.wpb : p.wpa) + (size_t)l * 512 * D, D, 512, nb * 32, nullptr, WT + (f ? WT_PB : WT_PA), nb * 32, kb * 64, scr, lane); continue; }
        r -= 2 * I_P;
        { const int kb = r / 32, nb = r % 32; conv_item(p.wout + (size_t)l * D * D, D, D, nb * 32, nullptr, WT + WT_OUT, nb * 32, kb * 64, scr, lane); }
    }
}

__device__ __forceinline__ float wave_sum(float v) {
#pragma unroll
    for (int o = 1; o < 64; o <<= 1) v += __shfl_xor(v, o);
    return v;
}
__device__ __forceinline__ void prologue(const Params& p, int gw, int ngw, int lane) {
    float* H = (float*)(p.ws + OFF_H); bf16_t* HB = (bf16_t*)((unsigned char*)p.out + OO_HB); float* SSQ = (float*)(p.ws + OFF_SSQ);
    for (int row = gw; row < MROWS; row += ngw) {
        f32x4 v[4]; float s = 0.f;
#pragma unroll
        for (int j = 0; j < 4; ++j) {
            if (row < MX) v[j] = *((const f32x4*)(p.x + (size_t)row * D) + lane + 64 * j);
            else if (row < NVALID) v[j] = *((const f32x4*)(p.meta + (size_t)((row - MX) & 15) * D) + lane + 64 * j);
            else v[j] = (f32x4){0.f, 0.f, 0.f, 0.f};
            s += (v[j][0] * v[j][0] + v[j][1] * v[j][1]) + (v[j][2] * v[j][2] + v[j][3] * v[j][3]);
        }
        s = wave_sum(s);
#pragma unroll
        for (int j = 0; j < 4; ++j) { *((f32x4*)(H + (size_t)row * D) + lane + 64 * j) = v[j];
            u32x2 w; w.x = pk(v[j][0], v[j][1]); w.y = pk(v[j][2], v[j][3]); *((u32x2*)(HB + (size_t)row * D) + lane + 64 * j) = w; }
        if (lane < 16) SSQ[(size_t)row * 16 + lane] = (lane == 0) ? s : 0.f;
    }
    const int gt = gw * 64 + lane, ngt = ngw * 64;
    float* ROPE = (float*)(p.ws + OFF_ROPE);
    for (int i = gt; i < SEQ * 32; i += ngt) { const int t = i >> 5, f = i & 31, fi = f & 15; const float pos = (float)((f < 16) ? (t >> 6) : (t & 63));
        const float inv = exp2f(-(float)fi * (13.287712379549449f / 16.0f)); float rev = pos * inv * 0.15915494309189535f; rev -= floorf(rev);
        ROPE[t * 64 + f] = __builtin_amdgcn_cosf(rev); ROPE[t * 64 + 32 + f] = __builtin_amdgcn_sinf(rev); }
    bf16_t* VT = (bf16_t*)(p.ws + OFF_VT);
    for (int i = gt; i < NB * 2 * 64 * 48; i += ngt) { const int r = i / 48, c = i % 48; VT[(size_t)r * LP + c] = 0; }
}
__device__ __forceinline__ void final_norm(const Params& p, int gw, int ngw, int lane) {
    const float* H = (const float*)(p.ws + OFF_H); const float* SSQ = (const float*)(p.ws + OFF_SSQ) + (size_t)12 * MROWS * 16;
    for (int row = gw; row < MX; row += ngw) { const float rs = rstd_row(SSQ, row);
#pragma unroll
        for (int j = 0; j < 4; ++j) { const f32x4 v = *((const f32x4*)(H + (size_t)row * D) + lane + 64 * j), g = *((const f32x4*)p.fn + lane + 64 * j);
            *((f32x4*)(p.out + (size_t)row * D) + lane + 64 * j) = v * rs * g; } }
}

__device__ __forceinline__ void prep_qk(const Params& p, int l, int gt, int ngt) {
    const float* ROPE = (const float*)(p.ws + OFF_ROPE);
    for (int item = gt; item < NVALID * 10; item += ngt) {
        const int row = item / 10, hd = item % 10;
        bf16_t* ptr = (hd < 8) ? (bf16_t*)(p.ws + OFF_QB) + (size_t)row * 512 + hd * 64 : (bf16_t*)(p.ws + OFF_KB) + (size_t)row * 128 + (hd - 8) * 64;
        const float* gain = ((hd < 8) ? p.qn : p.kn) + l * 64; const float osc = (hd < 8) ? 0.125f * LOG2E : 1.0f;
        float v[64]; float ss = 0.f;
#pragma unroll
        for (int j = 0; j < 8; ++j) { const u32x4 w = *((const u32x4*)ptr + j);
            v[8 * j + 0] = bflo(w.x); v[8 * j + 1] = bfhi(w.x); v[8 * j + 2] = bflo(w.y); v[8 * j + 3] = bfhi(w.y); v[8 * j + 4] = bflo(w.z); v[8 * j + 5] = bfhi(w.z); v[8 * j + 6] = bflo(w.w); v[8 * j + 7] = bfhi(w.w); }
#pragma unroll
        for (int d = 0; d < 64; ++d) ss += v[d] * v[d];
        const float rs = __builtin_amdgcn_rsqf(ss * (1.0f / 64.0f) + EPS);
#pragma unroll
        for (int d = 0; d < 64; ++d) v[d] = v[d] * rs * gain[d];
        if (row < MX) { const float* cs = ROPE + (size_t)(row & 4095) * 64;
#pragma unroll
            for (int a = 0; a < 2; ++a)
#pragma unroll
                for (int i = 0; i < 16; ++i) { const float c = cs[16 * a + i], s = cs[32 + 16 * a + i], x1 = v[32 * a + i], x2 = v[32 * a + 16 + i];
                    v[32 * a + i] = x1 * c - x2 * s; v[32 * a + 16 + i] = x2 * c + x1 * s; } }
#pragma unroll
        for (int j = 0; j < 8; ++j) { u32x4 w; w.x = pk(v[8 * j] * osc, v[8 * j + 1] * osc); w.y = pk(v[8 * j + 2] * osc, v[8 * j + 3] * osc); w.z = pk(v[8 * j + 4] * osc, v[8 * j + 5] * osc); w.w = pk(v[8 * j + 6] * osc, v[8 * j + 7] * osc);
            *((u32x4*)ptr + j) = w; }
    }
}

constexpr int AT_TILE = 64 * 144, AT_K = 0, AT_V = 2 * AT_TILE;
__device__ __forceinline__ void attn_unit(const Params& p, int b, int kvh, int jb, LAS unsigned char* lds) {
    const int tid = mk_tid(), lane = tid & 63, wid = __builtin_amdgcn_readfirstlane(tid >> 6), r32 = lane & 31, hi = lane >> 5;
    bf16_t* QB = (bf16_t*)(p.ws + OFF_QB); const bf16_t* KB = (const bf16_t*)(p.ws + OFF_KB); const bf16_t* VT = (const bf16_t*)(p.ws + OFF_VT);
    const int hq = kvh * 4 + (wid >> 1), rr = (wid & 1) * 32 + r32;
    const bool qvalid = (jb >= 0) || (rr < 16);
    const size_t qrow = (jb >= 0) ? (size_t)b * SEQ + jb * 64 + rr : (size_t)MX + b * 16 + rr;
    bf16_t* qp = QB + qrow * 512 + hq * 64;
    bf16x8 qr[4];
#pragma unroll
    for (int ds = 0; ds < 4; ++ds) qr[ds] = qvalid ? *(const bf16x8*)(qp + ds * 16 + hi * 8) : (bf16x8){0, 0, 0, 0, 0, 0, 0, 0};
    const int tk = tid >> 3, tc = tid & 7;
    const bf16_t* vsrc = VT + ((size_t)(b * 2 + kvh) * 64 + tk) * LP + tc * 8;
    const bf16_t* ksrc = KB + ((size_t)b * SEQ + tk) * 128 + kvh * 64 + tc * 8;
    const bf16_t* ksrc0 = KB + ((size_t)MX + b * 16 + (tk - 48)) * 128 + kvh * 64 + tc * 8;
    const int lst = tk * 144 + tc * 16;
    u32x4 kreg, vreg;
    kreg = (tk >= 48) ? *(const u32x4*)ksrc0 : (u32x4){0u, 0u, 0u, 0u}; vreg = *(const u32x4*)vsrc;
    *(LAS u32x4*)(lds + AT_K + lst) = kreg; *(LAS u32x4*)(lds + AT_V + lst) = vreg;
    __syncthreads();
    f32x16 o0, o1;
#pragma unroll
    for (int r = 0; r < 16; ++r) { o0[r] = 0.f; o1[r] = 0.f; }
    float mrun = -1e30f, lrun = 0.f;
    for (int t = 0; t < NCH; ++t) {
        const int buf = t & 1;
        if (t + 1 < NCH) { kreg = *(const u32x4*)(ksrc + (size_t)t * 64 * 128); vreg = *(const u32x4*)(vsrc + (t + 1) * 64); }
        const LAS unsigned char* Kl = lds + AT_K + buf * AT_TILE; const LAS unsigned char* Vl = lds + AT_V + buf * AT_TILE;
        f32x16 p0, p1;
#pragma unroll
        for (int r = 0; r < 16; ++r) { p0[r] = 0.f; p1[r] = 0.f; }
#pragma unroll
        for (int ds = 0; ds < 4; ++ds) {
            const bf16x8 k0 = *(const LAS bf16x8*)(Kl + r32 * 144 + ds * 32 + hi * 16), k1 = *(const LAS bf16x8*)(Kl + (r32 + 32) * 144 + ds * 32 + hi * 16);
            p0 = __builtin_amdgcn_mfma_f32_32x32x16_bf16(k0, qr[ds], p0, 0, 0, 0);
            p1 = __builtin_amdgcn_mfma_f32_32x32x16_bf16(k1, qr[ds], p1, 0, 0, 0);
        }
        if (t == 0) {
#pragma unroll
            for (int r = 0; r < 16; ++r) { p0[r] = -1e30f; if (r < 8) p1[r] = -1e30f; }
        }
        float mx = fmaxf(p0[0], p1[0]);
#pragma unroll
        for (int r = 1; r < 16; ++r) mx = fmaxf(mx, fmaxf(p0[r], p1[r]));
        mx = fmaxf(mx, __shfl_xor(mx, 32));
        const float mnew = fmaxf(mrun, mx), alpha = __builtin_amdgcn_exp2f(mrun - mnew);
        float ls = 0.f;
#pragma unroll
        for (int r = 0; r < 16; ++r) { p0[r] = __builtin_amdgcn_exp2f(p0[r] - mnew); p1[r] = __builtin_amdgcn_exp2f(p1[r] - mnew); ls += p0[r] + p1[r]; }
        lrun = lrun * alpha + ls; mrun = mnew;
#pragma unroll
        for (int r = 0; r < 16; ++r) { o0[r] *= alpha; o1[r] *= alpha; }
        u32x4 pw[4];
        pw[0] = (u32x4){pk(p0[0], p0[1]), pk(p0[2], p0[3]), pk(p0[4], p0[5]), pk(p0[6], p0[7])};
        pw[1] = (u32x4){pk(p0[8], p0[9]), pk(p0[10], p0[11]), pk(p0[12], p0[13]), pk(p0[14], p0[15])};
        pw[2] = (u32x4){pk(p1[0], p1[1]), pk(p1[2], p1[3]), pk(p1[4], p1[5]), pk(p1[6], p1[7])};
        pw[3] = (u32x4){pk(p1[8], p1[9]), pk(p1[10], p1[11]), pk(p1[12], p1[13]), pk(p1[14], p1[15])};
#pragma unroll
        for (int s = 0; s < 4; ++s) {
            const bf16x8 pb = __builtin_bit_cast(bf16x8, pw[s]);
            { const u32x2 a = *(const LAS u32x2*)(Vl + r32 * 144 + (16 * s + 4 * hi) * 2), c = *(const LAS u32x2*)(Vl + r32 * 144 + (16 * s + 8 + 4 * hi) * 2);
              const u32x4 vf = (u32x4){a.x, a.y, c.x, c.y}; o0 = __builtin_amdgcn_mfma_f32_32x32x16_bf16(__builtin_bit_cast(bf16x8, vf), pb, o0, 0, 0, 0); }
            { const u32x2 a = *(const LAS u32x2*)(Vl + (r32 + 32) * 144 + (16 * s + 4 * hi) * 2), c = *(const LAS u32x2*)(Vl + (r32 + 32) * 144 + (16 * s + 8 + 4 * hi) * 2);
              const u32x4 vf = (u32x4){a.x, a.y, c.x, c.y}; o1 = __builtin_amdgcn_mfma_f32_32x32x16_bf16(__builtin_bit_cast(bf16x8, vf), pb, o1, 0, 0, 0); }
        }
        if (t + 1 < NCH) { *(LAS u32x4*)(lds + AT_K + (buf ^ 1) * AT_TILE + lst) = kreg; *(LAS u32x4*)(lds + AT_V + (buf ^ 1) * AT_TILE + lst) = vreg; }
        __syncthreads();
    }
    lrun += __shfl_xor(lrun, 32);
    const float inv = 1.0f / lrun;
    if (qvalid) {
#pragma unroll
        for (int g = 0; g < 4; ++g) {
            u32x2 w0; w0.x = pk(o0[4 * g] * inv, o0[4 * g + 1] * inv); w0.y = pk(o0[4 * g + 2] * inv, o0[4 * g + 3] * inv);
            u32x2 w1; w1.x = pk(o1[4 * g] * inv, o1[4 * g + 1] * inv); w1.y = pk(o1[4 * g + 2] * inv, o1[4 * g + 3] * inv);
            *(u32x2*)(qp + 8 * g + 4 * hi) = w0; *(u32x2*)(qp + 32 + 8 * g + 4 * hi) = w1;
        }
    }
}
__device__ __forceinline__ void attn_phase(const Params& p, LAS unsigned char* lds, int vcu, int G) {
    const int nper = (1024 + G - 1) / G;
    for (int i = 0; i < nper; ++i) { const int id = vcu * nper + i; if (id < 1024) attn_unit(p, id >> 7, (id >> 6) & 1, id & 63, lds); }
    for (int m = 0; m < 16; ++m) if ((m * G) / 16 == vcu) attn_unit(p, m >> 1, m & 1, -1, lds);
}

__device__ __forceinline__ void gla_scan(const Params& p, int gt, int ngt) {
    bf16_t* S = (bf16_t*)(p.ws + OFF_S); const float* DEC = (const float*)(p.ws + OFF_DEC);
    for (int task = gt; task < 64 * 2048; task += ngt) {
        const int bhd = task >> 11, e = (task & 2047) * 4, c = e & 63, dir = bhd & 1;
        bf16_t* sp = S + (size_t)bhd * NCH * 8192 + e; const float* dp = DEC + (size_t)bhd * NCH * 64 + c;
        float s0 = 0.f, s1 = 0.f, s2 = 0.f, s3 = 0.f;
#pragma unroll 5
        for (int k = 0; k < NCH; ++k) { const int ch = dir ? (NCH - 1 - k) : k;
            const u32x2 kv = *(const u32x2*)(sp + (size_t)ch * 8192); const f32x4 d = *(const f32x4*)(dp + ch * 64);
            u32x2 w; w.x = pk(s0, s1); w.y = pk(s2, s3); *(u32x2*)(sp + (size_t)ch * 8192) = w;
            s0 = d[0] * s0 + bflo(kv.x); s1 = d[1] * s1 + bfhi(kv.x); s2 = d[2] * s2 + bflo(kv.y); s3 = d[3] * s3 + bfhi(kv.y); }
    }
}
constexpr int GL_BC = 0;
constexpr int GL_QD = 33792;
constexpr int GL_KI = GL_QD + 18432;
constexpr int GL_VT = GL_KI + 18432;
constexpr int GL_ATT = GL_VT + 18432;
constexpr int GL_END = GL_ATT + 9216;
static_assert(GL_END <= 131072, "GLA LDS");
template <bool G3> __device__ __forceinline__ void gla_unit(const Params& p, int l, int b, int h, int chunk, LAS unsigned char* lds) {
    const int tid = mk_tid(), lane = tid & 63, wid = __builtin_amdgcn_readfirstlane(tid >> 6), fr = lane & 15, fq = lane >> 4;
    LAS float* bc = (LAS float*)(lds + GL_BC);
    const bf16_t* QKA = (const bf16_t*)(p.ws + OFF_QKA); const bf16_t* VA = (const bf16_t*)(p.ws + OFF_VA); bf16_t* RA = (bf16_t*)(p.ws + OFF_RA);
    const float* LR = (const float*)(p.ws + OFF_LR); bf16_t* S = (bf16_t*)(p.ws + OFF_S); float* DEC = (float*)(p.ws + OFF_DEC);
    const int bh = b * 4 + h;
#define GL_ROW(i) ((chunk == 0) ? ((size_t)MX + b * 16 + ((i) - 48)) : ((size_t)b * SEQ + (chunk - 1) * 64 + (i)))
#define GL_NUL(i) ((chunk == 0) && ((i) < 48))
    {
        const int dir = wid >> 2, c0 = (wid & 3) * 16, i = lane; const bool nul = GL_NUL(i);
        float lrv[16];
        if (!nul) { const float* lrp = LR + GL_ROW(i) * 32 + dir * 16;
#pragma unroll
            for (int q = 0; q < 4; ++q) { const f32x4 t = *(const f32x4*)(lrp + 4 * q); lrv[4 * q] = t[0]; lrv[4 * q + 1] = t[1]; lrv[4 * q + 2] = t[2]; lrv[4 * q + 3] = t[3]; } }
        else {
#pragma unroll
            for (int q = 0; q < 16; ++q) lrv[q] = 0.f; }
        const float* w2p = p.w2 + (size_t)((l * 2 + dir) * 16) * 256 + h * 64 + c0; const float* b2p = p.b2 + (size_t)(l * 2 + dir) * 256 + h * 64 + c0;
#pragma unroll 4
        for (int cc = 0; cc < 16; ++cc) {
            float x = b2p[cc];
#pragma unroll
            for (int r = 0; r < 16; ++r) x += lrv[r] * w2p[r * 256 + cc];
            const float lg = nul ? 0.f : (fminf(x, 0.f) - __logf(1.f + fexp(-fabsf(x)))) * (1.0f / 16.0f);
            float s = lg;
#pragma unroll
            for (int off = 1; off < 64; off <<= 1) { const float t = __shfl_up(s, off); if (lane >= off) s += t; }
            if (dir == 1) { const float tot = __shfl(s, 63); s = tot - s + lg; }
            bc[(dir * 64 + i) * 65 + c0 + cc] = s;
        }
    }
    __syncthreads();
    {
        const int i = lane; const bool nul = GL_NUL(i); LAS bf16_t* vT = (LAS bf16_t*)(lds + GL_VT);
#pragma unroll
        for (int q = 0; q < 2; ++q) { const int vc = wid + 8 * q;
            const u32x4 w = nul ? (u32x4){0u, 0u, 0u, 0u} : *(const u32x4*)(VA + GL_ROW(i) * 512 + h * 128 + vc * 8);
            vT[(vc * 8 + 0) * 72 + i] = (bf16_t)(w.x & 0xffffu); vT[(vc * 8 + 1) * 72 + i] = (bf16_t)(w.x >> 16); vT[(vc * 8 + 2) * 72 + i] = (bf16_t)(w.y & 0xffffu); vT[(vc * 8 + 3) * 72 + i] = (bf16_t)(w.y >> 16);
            vT[(vc * 8 + 4) * 72 + i] = (bf16_t)(w.z & 0xffffu); vT[(vc * 8 + 5) * 72 + i] = (bf16_t)(w.z >> 16); vT[(vc * 8 + 6) * 72 + i] = (bf16_t)(w.w & 0xffffu); vT[(vc * 8 + 7) * 72 + i] = (bf16_t)(w.w >> 16); }
    }
    if (!G3) {
        LAS bf16_t* keT = (LAS bf16_t*)(lds + GL_QD);
        { const int i = lane, ch = wid; const bool nul = GL_NUL(i);
          const u32x4 w = nul ? (u32x4){0u, 0u, 0u, 0u} : *(const u32x4*)(QKA + GL_ROW(i) * 512 + 256 + h * 64 + ch * 8);
          float kf[8] = {bflo(w.x), bfhi(w.x), bflo(w.y), bfhi(w.y), bflo(w.z), bfhi(w.z), bflo(w.w), bfhi(w.w)};
#pragma unroll
          for (int e = 0; e < 8; ++e) { const int c = ch * 8 + e;
              const float eF = fexp(bc[63 * 65 + c] - bc[i * 65 + c]), eB = fexp(bc[64 * 65 + c] - bc[(64 + i) * 65 + c]);
              keT[c * 72 + i] = f2bf(kf[e] * eF); keT[(64 + c) * 72 + i] = f2bf(kf[e] * eB); } }
        if (tid < 128) { const int dir = tid >> 6, c = tid & 63; const float bt = dir ? bc[64 * 65 + c] : bc[63 * 65 + c]; DEC[((size_t)(bh * 2 + dir) * NCH + chunk) * 64 + c] = fexp(bt); }
        __syncthreads();
        { const int dir = wid >> 2; const LAS bf16_t* vT = (const LAS bf16_t*)(lds + GL_VT);
          bf16_t* sbase = S + ((size_t)(bh * 2 + dir) * NCH + chunk) * 8192;
#pragma unroll
          for (int vt = 0; vt < 2; ++vt) { const int v0 = ((wid & 3) * 2 + vt) * 16;
              const bf16x8 a0 = *(const LAS bf16x8*)(vT + (v0 + fr) * 72 + 8 * fq), a1 = *(const LAS bf16x8*)(vT + (v0 + fr) * 72 + 32 + 8 * fq);
#pragma unroll
              for (int ct = 0; ct < 4; ++ct) { const int c0 = ct * 16;
                  const bf16x8 b0 = *(const LAS bf16x8*)(keT + (dir * 64 + c0 + fr) * 72 + 8 * fq), b1 = *(const LAS bf16x8*)(keT + (dir * 64 + c0 + fr) * 72 + 32 + 8 * fq);
                  f32x4 acc = (f32x4){0.f, 0.f, 0.f, 0.f};
                  acc = __builtin_amdgcn_mfma_f32_16x16x32_bf16(b0, a0, acc, 0, 0, 0); acc = __builtin_amdgcn_mfma_f32_16x16x32_bf16(b1, a1, acc, 0, 0, 0);
                  u32x2 w; w.x = pk(acc[0], acc[1]); w.y = pk(acc[2], acc[3]);
                  *(u32x2*)(sbase + (size_t)(v0 + fr) * 64 + c0 + 4 * fq) = w; } } }
        __syncthreads();
    } else {
        LAS bf16_t* qd = (LAS bf16_t*)(lds + GL_QD); LAS bf16_t* ki = (LAS bf16_t*)(lds + GL_KI); LAS bf16_t* att = (LAS bf16_t*)(lds + GL_ATT);
        const LAS bf16_t* vT = (const LAS bf16_t*)(lds + GL_VT);
        { const int i = tid >> 3, ch = tid & 7; const bool nul = GL_NUL(i);
          const u32x4 qw = nul ? (u32x4){0u, 0u, 0u, 0u} : *(const u32x4*)(QKA + GL_ROW(i) * 512 + h * 64 + ch * 8);
          const u32x4 kw = nul ? (u32x4){0u, 0u, 0u, 0u} : *(const u32x4*)(QKA + GL_ROW(i) * 512 + 256 + h * 64 + ch * 8);
          const float qf[8] = {bflo(qw.x), bfhi(qw.x), bflo(qw.y), bfhi(qw.y), bflo(qw.z), bfhi(qw.z), bflo(qw.w), bfhi(qw.w)};
          const float kf[8] = {bflo(kw.x), bfhi(kw.x), bflo(kw.y), bfhi(kw.y), bflo(kw.z), bfhi(kw.z), bflo(kw.w), bfhi(kw.w)};
#pragma unroll
          for (int dir = 0; dir < 2; ++dir) { float qo[8], ko[8];
#pragma unroll
              for (int e = 0; e < 8; ++e) { const float bv = bc[(dir * 64 + i) * 65 + ch * 8 + e]; qo[e] = qf[e] * fexp(bv); ko[e] = kf[e] * fexp(-bv); }
              *(LAS u32x4*)(qd + (dir * 64 + i) * 72 + ch * 8) = (u32x4){pk(qo[0], qo[1]), pk(qo[2], qo[3]), pk(qo[4], qo[5]), pk(qo[6], qo[7])};
              *(LAS u32x4*)(ki + (dir * 64 + i) * 72 + ch * 8) = (u32x4){pk(ko[0], ko[1]), pk(ko[2], ko[3]), pk(ko[4], ko[5]), pk(ko[6], ko[7])}; } }
        __syncthreads();
        { const int i0 = (wid >> 1) * 16;
#pragma unroll
          for (int tt = 0; tt < 2; ++tt) { const int j0 = ((wid & 1) * 2 + tt) * 16;
              f32x4 aF = (f32x4){0.f, 0.f, 0.f, 0.f}, aB = (f32x4){0.f, 0.f, 0.f, 0.f};
#pragma unroll
              for (int ks = 0; ks < 2; ++ks) {
                  const bf16x8 qf_ = *(const LAS bf16x8*)(qd + (i0 + fr) * 72 + 32 * ks + 8 * fq), kf_ = *(const LAS bf16x8*)(ki + (j0 + fr) * 72 + 32 * ks + 8 * fq);
                  const bf16x8 qb_ = *(const LAS bf16x8*)(qd + (64 + i0 + fr) * 72 + 32 * ks + 8 * fq), kb_ = *(const LAS bf16x8*)(ki + (64 + j0 + fr) * 72 + 32 * ks + 8 * fq);
                  aF = __builtin_amdgcn_mfma_f32_16x16x32_bf16(qf_, kf_, aF, 0, 0, 0); aB = __builtin_amdgcn_mfma_f32_16x16x32_bf16(qb_, kb_, aB, 0, 0, 0); }
#pragma unroll
              for (int r = 0; r < 4; ++r) { const int i = i0 + 4 * fq + r, j = j0 + fr; const float v = ((i >= j) ? aF[r] : 0.f) + ((j >= i) ? aB[r] : 0.f); att[i * 72 + j] = f2bf(v); } } }
        __syncthreads();
        LAS float* ol = (LAS float*)(lds + GL_BC);
        { const int i0 = (wid & 3) * 16; bf16x8 aA[2], aFq[2], aBq[2];
#pragma unroll
          for (int ks = 0; ks < 2; ++ks) { aA[ks] = *(const LAS bf16x8*)(att + (i0 + fr) * 72 + 32 * ks + 8 * fq); aFq[ks] = *(const LAS bf16x8*)(qd + (i0 + fr) * 72 + 32 * ks + 8 * fq);
              aBq[ks] = *(const LAS bf16x8*)(qd + (64 + i0 + fr) * 72 + 32 * ks + 8 * fq); }
          const bf16_t* sF = S + ((size_t)(bh * 2 + 0) * NCH + chunk) * 8192; const bf16_t* sB = S + ((size_t)(bh * 2 + 1) * NCH + chunk) * 8192;
#pragma unroll
          for (int vt = 0; vt < 4; ++vt) { const int v0 = ((wid >> 2) * 4 + vt) * 16; f32x4 acc = (f32x4){0.f, 0.f, 0.f, 0.f};
#pragma unroll
              for (int ks = 0; ks < 2; ++ks) {
                  const bf16x8 bV = *(const LAS bf16x8*)(vT + (v0 + fr) * 72 + 32 * ks + 8 * fq);
                  const bf16x8 bF = *(const bf16x8*)(sF + (size_t)(v0 + fr) * 64 + 32 * ks + 8 * fq), bB = *(const bf16x8*)(sB + (size_t)(v0 + fr) * 64 + 32 * ks + 8 * fq);
                  acc = __builtin_amdgcn_mfma_f32_16x16x32_bf16(aA[ks], bV, acc, 0, 0, 0);
#ifndef GLA_NOINTER
                  acc = __builtin_amdgcn_mfma_f32_16x16x32_bf16(aFq[ks], bF, acc, 0, 0, 0);
                  acc = __builtin_amdgcn_mfma_f32_16x16x32_bf16(aBq[ks], bB, acc, 0, 0, 0);
#endif
                  }
#pragma unroll
              for (int r = 0; r < 4; ++r) ol[(i0 + 4 * fq + r) * 132 + v0 + fr] = acc[r]; } }
        __syncthreads();
        { const int i = tid >> 3, part = tid & 7; const bool nul = GL_NUL(i); float ov[16]; float ss = 0.f;
#pragma unroll
          for (int q = 0; q < 4; ++q) { const f32x4 t = *(const LAS f32x4*)(ol + i * 132 + part * 16 + 4 * q); ov[4 * q] = t[0]; ov[4 * q + 1] = t[1]; ov[4 * q + 2] = t[2]; ov[4 * q + 3] = t[3];
              ss += (t[0] * t[0] + t[1] * t[1]) + (t[2] * t[2] + t[3] * t[3]); }
          ss += __shfl_xor(ss, 1); ss += __shfl_xor(ss, 2); ss += __shfl_xor(ss, 4);
          const float rs = __builtin_amdgcn_rsqf(ss * (1.0f / 128.0f) + EPS);
          if (!nul) { bf16_t* rp = RA + GL_ROW(i) * 512 + h * 128 + part * 16; const float* gp = p.gn + (size_t)l * 512 + h * 128 + part * 16;
#pragma unroll
              for (int q = 0; q < 2; ++q) { const u32x4 rw = *(const u32x4*)(rp + 8 * q); const f32x4 g0 = *(const f32x4*)(gp + 8 * q), g1 = *(const f32x4*)(gp + 8 * q + 4);
                  const float rf[8] = {bflo(rw.x), bfhi(rw.x), bflo(rw.y), bfhi(rw.y), bflo(rw.z), bfhi(rw.z), bflo(rw.w), bfhi(rw.w)}; float y[8];
#pragma unroll
                  for (int e = 0; e < 8; ++e) y[e] = ov[8 * q + e] * rs * ((e < 4) ? g0[e] : g1[e - 4]) * siluf(rf[e]);
                  *(u32x4*)(rp + 8 * q) = (u32x4){pk(y[0], y[1]), pk(y[2], y[3]), pk(y[4], y[5]), pk(y[6], y[7])}; } } }
        __syncthreads();
    }
#undef GL_ROW
#undef GL_NUL
}

__global__ void __launch_bounds__(512) mk_fwd(Params pin) {
    extern __shared__ __attribute__((aligned(16))) unsigned char lds_raw[];
    LAS unsigned char* lds = (LAS unsigned char*)lds_raw;
    cg::grid_group grid = cg::this_grid();
    const Params p0 = pin;
    for (int ph = p0.ph_lo; ph < p0.ph_hi; ++ph) {
        if (ph > p0.ph_lo) grid.sync();
        long z = 0; asm volatile("" : "+s"(z));
        Params p = p0;
        p.x += z; p.meta += z; p.ng += z; p.wg += z; p.wu += z; p.wd += z; p.win += z; p.w2 += z; p.b2 += z; p.gn += z; p.qn += z; p.kn += z; p.wpa += z; p.wpb += z; p.bm += z; p.wout += z; p.fn += z; p.out += z; p.ws += z;
        const int tid = mk_tid();
        int G = gridDim.x, bx = blockIdx.x; asm volatile("" : "+s"(G), "+s"(bx));
        const int vcu = (G % 8 == 0) ? (bx % 8) * (G / 8) + bx / 8 : bx;
        const int lane = tid & 63, wid = __builtin_amdgcn_readfirstlane(tid >> 6);
        const int gw = bx * 8 + wid, ngw = G * 8, gt = bx * 512 + tid, ngt = G * 512;
        unsigned char* ws = p.ws;
        float* H = (float*)(ws + OFF_H); bf16_t* HB = (bf16_t*)((unsigned char*)p.out + OO_HB); bf16_t* WT = (bf16_t*)((unsigned char*)p.out + OO_WT);
        float* SSQ = (float*)(ws + OFF_SSQ); bf16_t* HID = (bf16_t*)(ws + OFF_HID); bf16_t* Y = (bf16_t*)(ws + OFF_Y);
        if (PHON(11) && ph == 0) { prologue(p, gw, ngw, lane); conv_layer(p, 0, lds, gw, ngw, wid, lane); continue; }
        const int l = (ph - 1) / 11, s = (ph - 1) % 11;
        if (PHON(0) && (s == 0 || s == 8)) {
            const int f = (s == 8);
            pg8::Gemm g{HB, WT + (f ? WT_GU1 : WT_GU0), MROWS, 5632, D}; pg8::StaticOrder S; S.init(MROWS, 5632, G, bx);
            EpiSwiglu E{HID, SSQ + (size_t)(3 * l + (f ? 2 : 0)) * MROWS * 16};
            pg8::gemm_phase<EpiSwiglu, pg8::StaticOrder, true, true>(lds, g, S, E);
        } else if (PHON(1) && (s == 1 || s == 7 || s == 9)) {
            pg8::Gemm g; float scale; int so;
            if (s == 1) { g = pg8::Gemm{HID, WT + WT_DN0, MROWS, D, DFF}; scale = 0.5f; so = 3 * l + 1; }
            else if (s == 9) { g = pg8::Gemm{HID, WT + WT_DN1, MROWS, D, DFF}; scale = 0.5f; so = 3 * l + 3; }
            else { g = pg8::Gemm{Y, WT + WT_OUT, MROWS, D, D}; scale = 1.0f; so = 3 * l + 2; }
            pg8::StaticOrder S; S.init(MROWS, D, G, bx);
            EpiResid E{H, HB, SSQ + (size_t)so * MROWS * 16, scale};
            pg8::gemm_phase<EpiResid, pg8::StaticOrder, true, true>(lds, g, S, E);
        } else if (PHON(2) && s == 2) {
            pg8::Gemm g{HB, WT + WT_WIN, MROWS, WIN_N, D}; pg8::StaticOrder S; S.init(MROWS, WIN_N, G, bx);
            EpiWin E{ws, SSQ + (size_t)(3 * l + 1) * MROWS * 16};
            pg8::gemm_phase<EpiWin, pg8::StaticOrder, true, true>(lds, g, S, E);
        } else if (PHON(3) && s == 3) {
            if (PHON(12)) prep_qk(p, l, gt, ngt);
            if (PHON(13)) for (int u = bx; u < 32 * NCH; u += G) gla_unit<false>(p, l, (u / NCH) >> 2, (u / NCH) & 3, u % NCH, lds);
        } else if (PHON(4) && s == 4) {
            if (PHON(14)) attn_phase(p, lds, vcu, G);
            if (PHON(15)) gla_scan(p, gt, ngt);
        } else if (PHON(5) && s == 5) {
            for (int u = bx; u < 32 * NCH; u += G) gla_unit<true>(p, l, (u / NCH) >> 2, (u / NCH) & 3, u % NCH, lds);
        } else if (PHON(6) && s == 6) {
            pg8::StaticOrder S; S.init(MROWS, D, G, bx);
            { pg8::Gemm g{(const bf16_t*)(ws + OFF_RA), WT + WT_PA, MROWS, D, 512}; EpiMerge<0> E{Y, (const bf16_t*)(ws + OFF_GT), p.bm + (size_t)l * 2048};
              pg8::gemm_phase<EpiMerge<0>, pg8::StaticOrder, true, true>(lds, g, S, E); }
            if (PHON(7)) { pg8::Gemm g{(const bf16_t*)(ws + OFF_QB), WT + WT_PB, MROWS, D, 512}; EpiMerge<1> E{Y, (const bf16_t*)(ws + OFF_GT), p.bm + (size_t)l * 2048};
              pg8::gemm_phase<EpiMerge<1>, pg8::StaticOrder, true, true>(lds, g, S, E); }
        } else if (PHON(10) && s == 10) {
            if (l + 1 < DEPTH) conv_layer(p, l + 1, lds, gw, ngw, wid, lane); else final_norm(p, gw, ngw, lane);
        }
    }
}

extern "C" void kernel_launch(void* const* d_in, const int* in_sizes, int n_in, void* d_out, int out_size, void* d_ws, size_t ws_size, hipStream_t stream) {
    static int grid = 0;
    if (grid == 0) {
        if (n_in != 17 || in_sizes[0] != MX * D || out_size != MX * D || ws_size < WS_END) {
            fprintf(stderr, "kernel_launch: unexpected shapes (n_in %d, in0 %d, out %d, ws %zu, need %zu)\n", n_in, n_in > 0 ? in_sizes[0] : -1, out_size, ws_size, (size_t)WS_END); grid = -1; return; }
        int dev = 0, cus = 0, per_cu = 0;
        hipGetDevice(&dev); hipDeviceGetAttribute(&cus, hipDeviceAttributeMultiprocessorCount, dev);
        if (hipFuncSetAttribute((const void*)mk_fwd, hipFuncAttributeMaxDynamicSharedMemorySize, LDS_BYTES) != hipSuccess) { fprintf(stderr, "kernel_launch: hipFuncSetAttribute failed\n"); grid = -1; return; }
        if (hipOccupancyMaxActiveBlocksPerMultiprocessor(&per_cu, (const void*)mk_fwd, 512, LDS_BYTES) != hipSuccess || per_cu < 1) { fprintf(stderr, "kernel_launch: occupancy query says %d\n", per_cu); per_cu = 1; }
        (void)hipGetLastError();
        grid = cus;
    }
    if (grid < 0) return;
    Params p{};
    p.x = (const float*)d_in[0]; p.meta = (const float*)d_in[1]; p.ng = (const float*)d_in[2]; p.wg = (const float*)d_in[3]; p.wu = (const float*)d_in[4]; p.wd = (const float*)d_in[5];
    p.win = (const float*)d_in[6]; p.w2 = (const float*)d_in[7]; p.b2 = (const float*)d_in[8]; p.gn = (const float*)d_in[9]; p.qn = (const float*)d_in[10]; p.kn = (const float*)d_in[11];
    p.wpa = (const float*)d_in[12]; p.wpb = (const float*)d_in[13]; p.bm = (const float*)d_in[14]; p.wout = (const float*)d_in[15]; p.fn = (const float*)d_in[16];
    p.out = (float*)d_out; p.ws = (unsigned char*)d_ws;
#if MK_SINGLE
    p.ph_lo = 0; p.ph_hi = NPH;
    { void* args[] = {&p}; hipError_t e = hipLaunchCooperativeKernel((const void*)mk_fwd, dim3(grid), dim3(512), args, LDS_BYTES, stream);
      if (e != hipSuccess) fprintf(stderr, "cooperative launch failed: %s\n", hipGetErrorString(e)); }
#else
    for (int ph = 0; ph < NPH; ++ph) { p.ph_lo = ph; p.ph_hi = ph + 1; void* args[] = {&p};
        hipError_t e = hipLaunchCooperativeKernel((const void*)mk_fwd, dim3(grid), dim3(512), args, LDS_BYTES, stream);
        if (e != hipSuccess) { fprintf(stderr, "cooperative launch %d failed: %s\n", ph, hipGetErrorString(e)); break; } }
#endif
}
```

```cpp
#include <hip/hip_runtime.h>
#include <hip/hip_cooperative_groups.h>
#include <cstdio>
#include <cstdint>
namespace cg = cooperative_groups;
__device__ __forceinline__ int mk_tid() { int t = threadIdx.x; asm volatile("" : "+v"(t)); return t; }
#define PG8_HALF_PM 128
namespace pg8 {
#define PG8_LAS __attribute__((address_space(3)))
typedef unsigned short bf16_t;
typedef short bf16x8 __attribute__((ext_vector_type(8)));
typedef float f32x4 __attribute__((ext_vector_type(4)));
typedef unsigned u32x4 __attribute__((ext_vector_type(4)));
constexpr int BM = 256, BK = 64, HALF = 128, HTB = HALF * BK * 2  , STAGE_BYTES = 8 * HTB, NXCD = 8, WGM = 8;

__host__ __device__ __forceinline__ int lds_byte(int r, int c) { const int st = (r >> 4) * 2 + (c >> 5), rr = r & 15, cc = c & 31, ob = rr * 64 + cc * 2; return st * 1024 + (ob ^ (((ob >> 9) & 1) << 5)); }
__host__ __device__ __forceinline__ void stage_rc(int b, int& R, int& C) { const int st = b / 1024, sb = b % 1024, swz = sb ^ (((sb >> 9) & 1) << 5); R = (st >> 1) * 16 + swz / 64; C = (st & 1) * 32 + (swz % 64) / 2; }
__host__ __device__ __forceinline__ int perm32(int rho) { const int n = rho >> 4, i = rho & 15; return 8 * (i >> 2) + 4 * n + (i & 3); }

struct Unit { int pm, pn, kh; };
struct Gemm { const bf16_t* A; const bf16_t* Bt; int M, N, K, KL; };

struct StaticOrder {
    int nM, nN, nwg, G, c;
    __host__ __device__ void init(int M, int N, int G_, int c_) { nM = M / BM; nN = N / BM; nwg = nM * nN; G = G_; c = c_; }
    __host__ __device__ bool next(int i, Unit& u) const {
        const long L = (long)i * G + c; if (L >= nwg) return false;
        int wgid = (int)L; { const int q = nwg / NXCD, r = nwg % NXCD, xcd = wgid % NXCD, off = wgid / NXCD; wgid = (xcd < r ? xcd * (q + 1) : r * (q + 1) + (xcd - r) * q) + off; }
        const int nig = WGM * nN, gid = wgid / nig, fm = gid * WGM, gsz = (nM - fm) < WGM ? (nM - fm) : WGM;
        u.pm = fm + ((wgid % nig) % gsz); u.pn = (wgid % nig) / gsz; u.kh = 0; return true;
    }
    __device__ __forceinline__ void a_ready(const Unit&) const {}
    __device__ __forceinline__ void done(const Unit&) const {}
};

__device__ __forceinline__ unsigned cvt_pk_bf16(float lo, float hi) { unsigned r; asm volatile("v_cvt_pk_bf16_f32 %0, %1, %2" : "=v"(r) : "v"(lo), "v"(hi)); return r; }
typedef float f32x2 __attribute__((ext_vector_type(2)));
template <class Epi, class Sched, bool ALIGN_EPI = false, bool SP2 = false>
__device__ __forceinline__ void gemm_phase(PG8_LAS unsigned char* lds, const Gemm g, const Sched& S, const Epi& E) {
    const int tid = mk_tid(), wid = __builtin_amdgcn_readfirstlane(tid >> 6), lane = tid & 63, wr = wid >> 2, wc = wid & 3, fr = lane & 15, fq = lane >> 4;
    const int K = g.K, nt = g.KL / BK;
    unsigned voffA[2], voffB[2];
#pragma unroll
    for (int i = 0; i < 2; ++i) { int R, C; stage_rc(tid * 16 + i * 8192, R, C); const int Rb = Epi::PERM ? ((R & ~31) + perm32(R & 31)) : R;
        voffA[i] = (unsigned)(R * K + C) * 2u; voffB[i] = (unsigned)(Rb * K + C) * 2u; }
    const size_t kstep = (size_t)(BK * 2);
    const size_t hstep = (size_t)HALF * K * 2;
    const size_t tstep = 2 * hstep;
    const unsigned ldsw = (unsigned)wid * 1024u;
    const int aoff = lds_byte(wr * 64 + fr, fq * 8), boff = lds_byte(wc * 32 + fr, fq * 8);
#define PG8_SA(b, h) (((b) * 2 + (h)) * HTB)
#define PG8_SB(b, h) ((4 + (b) * 2 + (h)) * HTB)
#define PG8_STAGE(bufoff, gbase, voff) do { _Pragma("unroll") for (int _i = 0; _i < 2; ++_i) \
        __builtin_amdgcn_global_load_lds((const unsigned*)((const char*)(gbase) + (voff)[_i]), (PG8_LAS unsigned*)(lds + (bufoff) + ldsw + _i * 8192), 16, 0, 0); } while (0)
#define PG8_LDA(dst, b, h) do { _Pragma("unroll") for (int m = 0; m < 4; ++m) _Pragma("unroll") for (int k = 0; k < 2; ++k) dst[m][k] = *(const PG8_LAS bf16x8*)(lds + PG8_SA(b, h) + aoff + m * 2048 + k * 1024); } while (0)
#define PG8_LDB(dst, b, h) do { _Pragma("unroll") for (int n = 0; n < 2; ++n) _Pragma("unroll") for (int k = 0; k < 2; ++k) dst[n][k] = *(const PG8_LAS bf16x8*)(lds + PG8_SB(b, h) + boff + n * 2048 + k * 1024); } while (0)
#define PG8_MMA(ai, bj, At, Bt) do { __builtin_amdgcn_s_setprio(1); _Pragma("unroll") for (int m = 0; m < 4; ++m) _Pragma("unroll") for (int n = 0; n < 2; ++n) _Pragma("unroll") for (int k = 0; k < 2; ++k) \
        acc[ai][bj][m][n] = __builtin_amdgcn_mfma_f32_16x16x32_bf16(Bt[n][k], At[m][k], acc[ai][bj][m][n], 0, 0, 0); __builtin_amdgcn_s_setprio(0); } while (0)
#define PG8_WAIT_V(n) asm volatile("s_waitcnt vmcnt(" #n ")" ::: "memory")
#define PG8_WAIT_L(n) asm volatile("s_waitcnt lgkmcnt(" #n ")" ::: "memory")
#define PG8_BAR __builtin_amdgcn_s_barrier()
#define PG8_SCHED __builtin_amdgcn_sched_barrier(0)
    Unit cur, nxt; int ui = 0;
    if (!S.next(0, cur)) return;
    f32x4 acc[2][2][4][2];
#pragma unroll
    for (int a = 0; a < 2; ++a)
#pragma unroll
        for (int b = 0; b < 2; ++b)
#pragma unroll
            for (int m = 0; m < 4; ++m)
#pragma unroll
                for (int n = 0; n < 2; ++n) acc[a][b][m][n] = (f32x4){0.f, 0.f, 0.f, 0.f};
    bf16x8 At[4][2], B0[2][2], B1[2][2];
    const size_t khb = (size_t)g.KL * 2;
    const char* cA = (const char*)g.A + (size_t)cur.pm * tstep + cur.kh * khb; const char* cB = (const char*)g.Bt + (size_t)cur.pn * tstep + cur.kh * khb;
    S.a_ready(cur);
    if constexpr (SP2) {
        PG8_STAGE(PG8_SB(0, 0), cB, voffB); PG8_STAGE(PG8_SB(0, 1), cB + hstep, voffB); PG8_STAGE(PG8_SA(0, 0), cA, voffA); PG8_STAGE(PG8_SA(0, 1), cA + hstep, voffA);
        if (wr == 1) PG8_BAR;
        PG8_WAIT_V(2); PG8_BAR;
        PG8_STAGE(PG8_SB(1, 0), cB + kstep, voffB); PG8_STAGE(PG8_SA(1, 0), cA + kstep, voffA); PG8_STAGE(PG8_SB(1, 1), cB + hstep + kstep, voffB);
        PG8_WAIT_V(6); PG8_BAR;
    } else {
        PG8_STAGE(PG8_SB(0, 0), cB, voffB); PG8_STAGE(PG8_SA(0, 0), cA, voffA); PG8_STAGE(PG8_SB(0, 1), cB + hstep, voffB); PG8_STAGE(PG8_SA(0, 1), cA + hstep, voffA);
        if (wr == 1) PG8_BAR;
        PG8_WAIT_V(4); PG8_BAR;
        PG8_STAGE(PG8_SB(1, 0), cB + kstep, voffB); PG8_STAGE(PG8_SA(1, 0), cA + kstep, voffA); PG8_STAGE(PG8_SB(1, 1), cB + hstep + kstep, voffB);
        PG8_WAIT_V(6); PG8_BAR;
    }
    for (;;) {
        const bool has_next = S.next(ui + 1, nxt);
        const bool full_unit = (cur.pm != PG8_HALF_PM);
        const char* nA = has_next ? (const char*)g.A + (size_t)nxt.pm * tstep + nxt.kh * khb : cA; const char* nB = has_next ? (const char*)g.Bt + (size_t)nxt.pn * tstep + nxt.kh * khb : cB;
        for (int t = 0; t < nt; t += 2) {
            const bool last = (t == nt - 2);
            const char* a1 = cA + (size_t)(t + 1) * kstep;
            const char* a2 = last ? nA : cA + (size_t)(t + 2) * kstep; const char* b2 = last ? nB : cB + (size_t)(t + 2) * kstep;
            const char* a3 = a2 + kstep; const char* b3 = b2 + kstep;
            if (last && has_next) S.a_ready(nxt);
            if constexpr (SP2) {
            PG8_LDB(B0, 0, 0); PG8_LDB(B1, 0, 1); PG8_SCHED; PG8_LDA(At, 0, 0); PG8_STAGE(PG8_SA(1, 1), a1 + hstep, voffA);
            PG8_WAIT_V(8); PG8_WAIT_L(0); PG8_BAR; PG8_MMA(0, 0, At, B0); PG8_MMA(0, 1, At, B1); PG8_BAR; PG8_SCHED;
            if (full_unit) PG8_LDA(At, 0, 1); PG8_STAGE(PG8_SB(0, 0), b2, voffB); PG8_STAGE(PG8_SB(0, 1), b2 + hstep, voffB); PG8_STAGE(PG8_SA(0, 0), a2, voffA);
            PG8_WAIT_V(8); PG8_WAIT_L(0); PG8_BAR; if (full_unit) { PG8_MMA(1, 0, At, B0); PG8_MMA(1, 1, At, B1); } PG8_BAR; PG8_SCHED;
            PG8_LDB(B0, 1, 0); PG8_LDB(B1, 1, 1); PG8_SCHED; PG8_LDA(At, 1, 0); PG8_STAGE(PG8_SA(0, 1), a2 + hstep, voffA);
            PG8_WAIT_V(8); PG8_WAIT_L(0); PG8_BAR; PG8_MMA(0, 0, At, B0); PG8_MMA(0, 1, At, B1); PG8_BAR; PG8_SCHED;
            if (full_unit) PG8_LDA(At, 1, 1); PG8_STAGE(PG8_SB(1, 0), b3, voffB); PG8_STAGE(PG8_SB(1, 1), b3 + hstep, voffB); PG8_STAGE(PG8_SA(1, 0), a3, voffA);
            PG8_WAIT_V(8); PG8_WAIT_L(0); PG8_BAR; if (full_unit) { PG8_MMA(1, 0, At, B0); PG8_MMA(1, 1, At, B1); } PG8_BAR; PG8_SCHED;
            } else {
            PG8_LDB(B0, 0, 0); PG8_SCHED; PG8_LDA(At, 0, 0); PG8_STAGE(PG8_SA(1, 1), a1 + hstep, voffA);
            PG8_WAIT_L(8); PG8_BAR; PG8_WAIT_L(0); PG8_MMA(0, 0, At, B0); PG8_BAR; PG8_SCHED;
            PG8_LDB(B1, 0, 1); PG8_STAGE(PG8_SB(0, 0), b2, voffB);
            PG8_BAR; PG8_WAIT_L(0); PG8_MMA(0, 1, At, B1); PG8_BAR;
            PG8_LDA(At, 0, 1); PG8_STAGE(PG8_SA(0, 0), a2, voffA);
            PG8_BAR; PG8_WAIT_L(0); PG8_MMA(1, 0, At, B0); PG8_BAR; PG8_SCHED;
            PG8_STAGE(PG8_SB(0, 1), b2 + hstep, voffB);
            PG8_WAIT_V(6); PG8_BAR; PG8_MMA(1, 1, At, B1); PG8_BAR;
            PG8_LDB(B0, 1, 0); PG8_SCHED; PG8_LDA(At, 1, 0); PG8_STAGE(PG8_SA(0, 1), a2 + hstep, voffA);
            PG8_WAIT_L(8); PG8_BAR; PG8_WAIT_L(0); PG8_MMA(0, 0, At, B0); PG8_BAR; PG8_SCHED;
            PG8_LDB(B1, 1, 1); PG8_STAGE(PG8_SB(1, 0), b3, voffB);
            PG8_BAR; PG8_WAIT_L(0); PG8_MMA(0, 1, At, B1); PG8_BAR;
            PG8_LDA(At, 1, 1); PG8_STAGE(PG8_SA(1, 0), a3, voffA);
            PG8_BAR; PG8_WAIT_L(0); PG8_MMA(1, 0, At, B0); PG8_BAR; PG8_SCHED;
            PG8_STAGE(PG8_SB(1, 1), b3 + hstep, voffB);
            PG8_WAIT_V(6); PG8_BAR; PG8_MMA(1, 1, At, B1); PG8_BAR;
            }
        }
        if constexpr (ALIGN_EPI) { if (wr == 0) PG8_BAR; }
        bool keep_acc = false;
        if constexpr (Epi::MIDK) { if (cur.kh == 0) { E.mid(acc, cur, wr, wc, fr, fq); keep_acc = true; } }
        if constexpr (!Epi::AFTER_DRAIN) { if (!keep_acc) { E(acc, cur, wr, wc, fr, fq); S.done(cur); } }
        if (!has_next) break;
        if (!keep_acc)
#pragma unroll
        for (int a = 0; a < 2; ++a)
#pragma unroll
            for (int b = 0; b < 2; ++b)
#pragma unroll
                for (int m = 0; m < 4; ++m)
#pragma unroll
                    for (int n = 0; n < 2; ++n) acc[a][b][m][n] = (f32x4){0.f, 0.f, 0.f, 0.f};
        cur = nxt; cA = nA; cB = nB; ++ui;
        if constexpr (ALIGN_EPI) { if (wr == 1) PG8_BAR; }
    }
    PG8_WAIT_V(0);
    if constexpr (!ALIGN_EPI) { if (wr == 0) PG8_BAR; }
    PG8_BAR;
    if constexpr (Epi::AFTER_DRAIN) { E.fused(acc, cur, wr, wc, fr, fq, lds, wid, lane); S.done(cur); }
#undef PG8_SA
#undef PG8_SB
#undef PG8_STAGE
#undef PG8_LDA
#undef PG8_LDB
#undef PG8_MMA
#undef PG8_WAIT_V
#undef PG8_WAIT_L
#undef PG8_BAR
#undef PG8_SCHED
}
}
#ifndef PH_MASK
#define PH_MASK 0xffff
#endif
#define PHON(k) ((PH_MASK >> (k)) & 1)
#ifndef MK_SINGLE
#define MK_SINGLE 1
#endif
#define LAS __attribute__((address_space(3)))
typedef unsigned short bf16_t;
typedef short bf16x8 __attribute__((ext_vector_type(8)));
typedef float f32x4 __attribute__((ext_vector_type(4)));
typedef float f32x16 __attribute__((ext_vector_type(16)));
typedef unsigned u32x4 __attribute__((ext_vector_type(4)));
typedef unsigned u32x2 __attribute__((ext_vector_type(2)));

constexpr int D = 1024, NB = 8, SEQ = 4096, DEPTH = 4, NMETA = 16, DFF = 2816, DIN = 4384;
constexpr int MX = NB * SEQ;
constexpr int MROWS = MX + 256;
constexpr int NVALID = MX + NB * NMETA;
constexpr int LP = 4160;
constexpr int NCH = 65;
constexpr float EPS = 1e-6f;
constexpr float LOG2E = 1.4426950408889634f;
constexpr int WIN_N = 4608;
constexpr int NPH = 42;

constexpr size_t SZ_H = (size_t)MROWS * D * 4, SZ_512 = (size_t)MROWS * 512 * 2, SZ_128 = (size_t)MROWS * 128 * 2;
constexpr size_t SZ_VT = (size_t)NB * 2 * 64 * LP * 2, SZ_LR = (size_t)MROWS * 32 * 4, SZ_GT = (size_t)MROWS * 2048 * 2;
constexpr size_t OFF_H = 0;
constexpr size_t OFF_QKA = OFF_H + SZ_H, OFF_VA = OFF_QKA + SZ_512, OFF_RA = OFF_VA + SZ_512, OFF_QB = OFF_RA + SZ_512;
constexpr size_t OFF_KB = OFF_QB + SZ_512, OFF_VT = OFF_KB + SZ_128, OFF_LR = OFF_VT + SZ_VT, OFF_GT = OFF_LR + SZ_LR, R_END = OFF_GT + SZ_GT;
constexpr size_t OFF_HID = OFF_QKA;
constexpr size_t OFF_Y = OFF_QKA;
static_assert((size_t)MROWS * DFF * 2 <= R_END - OFF_QKA, "hid overlay");
constexpr size_t SZ_S = (size_t)64 * NCH * 8192 * 2, SZ_DEC = (size_t)64 * NCH * 64 * 4, SZ_SSQ = (size_t)13 * MROWS * 16 * 4, SZ_ROPE = (size_t)SEQ * 64 * 4;
constexpr size_t OFF_S = R_END, OFF_DEC = OFF_S + SZ_S, OFF_SSQ = OFF_DEC + SZ_DEC, OFF_ROPE = OFF_SSQ + SZ_SSQ, OFF_CTR = OFF_ROPE + SZ_ROPE, OFF_BAR = OFF_CTR + 4096, WS_END = OFF_BAR + 16384;
constexpr size_t OO_WT = 0;
constexpr size_t WT_GU0 = 0, WT_DN0 = WT_GU0 + (size_t)5632 * 1024, WT_WIN = WT_DN0 + (size_t)1024 * 2816, WT_PA = WT_WIN + (size_t)WIN_N * 1024,
                 WT_PB = WT_PA + (size_t)1024 * 512, WT_OUT = WT_PB + (size_t)1024 * 512, WT_GU1 = WT_OUT + (size_t)1024 * 1024, WT_DN1 = WT_GU1 + (size_t)5632 * 1024,
                 WT_END = WT_DN1 + (size_t)1024 * 2816;
static_assert(OO_WT + 2 * WT_END * 2 <= (size_t)MX * D * 4, "d_out scratch");

constexpr int LDS_BYTES = 147456;

struct Params {
    const float *x, *meta, *ng, *wg, *wu, *wd, *win, *w2, *b2, *gn, *qn, *kn, *wpa, *wpb, *bm, *wout, *fn;
    float* out; unsigned char* ws; int ph_lo, ph_hi;
};

typedef float f32x2_t __attribute__((ext_vector_type(2))); typedef __bf16 bf16x2_t __attribute__((ext_vector_type(2)));
__device__ __forceinline__ unsigned pk(float lo, float hi) { f32x2_t v = {lo, hi}; bf16x2_t b = __builtin_convertvector(v, bf16x2_t); return __builtin_bit_cast(unsigned, b); }
__device__ __forceinline__ float bflo(unsigned w) { return __uint_as_float(w << 16); }
__device__ __forceinline__ float bfhi(unsigned w) { return __uint_as_float(w & 0xffff0000u); }
__device__ __forceinline__ float bf1(unsigned short b) { return __uint_as_float((unsigned)b << 16); }
__device__ __forceinline__ unsigned short f2bf(float f) { return (unsigned short)(pk(f, 0.f) & 0xffffu); }
__device__ __forceinline__ float fexp(float x) { return __builtin_amdgcn_exp2f(x * LOG2E); }
__device__ __forceinline__ float sigm(float x) { return __builtin_amdgcn_rcpf(1.f + fexp(-x)); }
__device__ __forceinline__ float siluf(float x) { return x * sigm(x); }
__device__ __forceinline__ float rstd_row(const float* ssq, int row) {
    const f32x4* q = (const f32x4*)(ssq + (size_t)row * 16); const f32x4 a = q[0], b = q[1], c = q[2], d = q[3];
    const float t = ((a[0] + a[1]) + (a[2] + a[3])) + ((b[0] + b[1]) + (b[2] + b[3])) + ((c[0] + c[1]) + (c[2] + c[3])) + ((d[0] + d[1]) + (d[2] + d[3]));
    return __builtin_amdgcn_rsqf(t * (1.0f / D) + EPS); }
#define LDS_WAIT() asm volatile("s_waitcnt lgkmcnt(0)" ::: "memory")
#define DPPF(old, src, ctrl, rmask, bmask, bc) __builtin_bit_cast(float, __builtin_amdgcn_update_dpp(__builtin_bit_cast(int, (float)(old)), __builtin_bit_cast(int, (float)(src)), ctrl, rmask, bmask, bc))
__device__ __forceinline__ float wave_incl_scan(float v) {
    v += DPPF(0.f, v, 0x111, 0xf, 0xf, true); v += DPPF(0.f, v, 0x112, 0xf, 0xf, true); v += DPPF(0.f, v, 0x114, 0xf, 0xf, true); v += DPPF(0.f, v, 0x118, 0xf, 0xf, true);
    v += DPPF(0.f, v, 0x142, 0xa, 0xf, false); v += DPPF(0.f, v, 0x143, 0xc, 0xf, false); return v; }
__device__ __forceinline__ float lane_bcast(float v, int l) { return __builtin_bit_cast(float, __builtin_amdgcn_readlane(__builtin_bit_cast(int, v), l)); }

struct MetaOrder {
    pg8::StaticOrder main; int nN, c, G, nmain, dbl;
    __device__ __forceinline__ void init(int N, int G_, int c_, int dbl_ = 0) { main.init(MX, N, G_, c_); nN = N / 256; c = c_; G = G_; dbl = dbl_; const int nw = 128 * nN; nmain = (c_ < nw) ? (nw - c_ + G_ - 1) / G_ : 0; }
    __device__ __forceinline__ bool next(int ii, pg8::Unit& u) const {
        const int i = dbl ? (ii >> 1) : ii, kh = dbl ? (ii & 1) : 0;
        if (i < nmain) { const bool ok = main.next(i, u); u.kh = kh; return ok; }
        const int j = (i - nmain) * G + c; if (j >= nN) return false;
        u.pm = PG8_HALF_PM; u.pn = j; u.kh = kh; return true; }
    __device__ __forceinline__ void a_ready(const pg8::Unit&) const {}
    __device__ __forceinline__ void done(const pg8::Unit&) const {}
};

struct EpiSwiglu {
    static constexpr bool PERM = true, AFTER_DRAIN = false, MIDK = false;
    bf16_t* O; const float* ssq;
    __device__ __forceinline__ void operator()(const f32x4 (&acc)[2][2][4][2], const pg8::Unit& u, int wr, int wc, int fr, int fq) const {
        int row0 = u.pm * 256 + wr * 64 + fr; asm volatile("" : "+v"(row0)); const int col0 = u.pn * 128 + wc * 32 + 8 * fq;
#pragma unroll
        for (int ai = 0; ai < 2; ++ai)
#pragma unroll
            for (int m = 0; m < 4; ++m) {
                if (ai == 1 && u.pm == PG8_HALF_PM) continue;
                const int row = row0 + ai * 128 + m * 16; const float rs = rstd_row(ssq, row);
                float h[8];
#pragma unroll
                for (int n = 0; n < 2; ++n)
#pragma unroll
                    for (int e = 0; e < 4; ++e) { const float g = acc[ai][0][m][n][e] * rs, up = acc[ai][1][m][n][e] * rs; h[n * 4 + e] = siluf(g) * up; }
                u32x4 w; w.x = pk(h[0], h[1]); w.y = pk(h[2], h[3]); w.z = pk(h[4], h[5]); w.w = pk(h[6], h[7]);
                *(u32x4*)(O + (size_t)row * DFF + col0) = w;
                asm volatile("" ::: "memory");
            }
    }
};
struct EpiResid {
    static constexpr bool PERM = true, AFTER_DRAIN = false, MIDK = false;
    bf16_t* HB; float* ssq_out; float scale;
    __device__ __forceinline__ void operator()(const f32x4 (&acc)[2][2][4][2], const pg8::Unit& u, int wr, int wc, int fr, int fq) const {
        int row0 = u.pm * 256 + wr * 64 + fr; asm volatile("" : "+v"(row0)); const int col0 = u.pn * 256 + wc * 32 + 8 * fq;
#pragma unroll
        for (int ai = 0; ai < 2; ++ai)
#pragma unroll
            for (int m = 0; m < 4; ++m) {
                if (ai == 1 && u.pm == PG8_HALF_PM) continue;
                const int row = row0 + ai * 128 + m * 16; float ss = 0.f;
#pragma unroll
                for (int bj = 0; bj < 2; ++bj) {
                    bf16_t* hp = HB + (size_t)row * D + col0 + bj * 128;
                    const u32x4 hw = *(const u32x4*)hp;
                    f32x4 h0 = (f32x4){bflo(hw.x), bfhi(hw.x), bflo(hw.y), bfhi(hw.y)}, h1 = (f32x4){bflo(hw.z), bfhi(hw.z), bflo(hw.w), bfhi(hw.w)};
                    h0 = h0 + acc[ai][bj][m][0] * scale; h1 = h1 + acc[ai][bj][m][1] * scale;
                    u32x4 w; w.x = pk(h0[0], h0[1]); w.y = pk(h0[2], h0[3]); w.z = pk(h1[0], h1[1]); w.w = pk(h1[2], h1[3]);
                    *(u32x4*)hp = w;
                    ss += (h0[0] * h0[0] + h0[1] * h0[1]) + (h0[2] * h0[2] + h0[3] * h0[3]) + (h1[0] * h1[0] + h1[1] * h1[1]) + (h1[2] * h1[2] + h1[3] * h1[3]);
                }
                ss += __shfl_xor(ss, 16); ss += __shfl_xor(ss, 32);
                if (fq == 0) ssq_out[(size_t)row * 16 + u.pn * 4 + wc] = ss;
                asm volatile("" ::: "memory");
            }
    }
};
struct EpiWin {
    static constexpr bool PERM = true, AFTER_DRAIN = false, MIDK = false;
    unsigned char* ws; const float* ssq; const float* bm;
    __device__ __forceinline__ void operator()(const f32x4 (&acc)[2][2][4][2], const pg8::Unit& u, int wr, int wc, int fr, int fq) const {
        int row0 = u.pm * 256 + wr * 64 + fr; asm volatile("" : "+v"(row0)); const int cw = wc * 32 + 8 * fq, pn = u.pn;
#pragma unroll
        for (int ai = 0; ai < 2; ++ai)
#pragma unroll
            for (int m = 0; m < 4; ++m) {
                if (ai == 1 && u.pm == PG8_HALF_PM) continue;
                const int row = row0 + ai * 128 + m * 16; const float rs = rstd_row(ssq, row);
                if (pn < 8) {
                    bf16_t* base = (pn < 4) ? (bf16_t*)(ws + OFF_QKA + (size_t)(pn >> 1) * SZ_512) + (size_t)row * 512 + (pn & 1) * 256 + cw
                                            : (bf16_t*)(ws + OFF_RA) + (size_t)row * 1024 + (pn - 4) * 256 + cw;
                    const float sc = (pn == 0) ? rs * 0.125f : rs; const bool gate = (pn == 4 || pn == 5);
#pragma unroll
                    for (int bj = 0; bj < 2; ++bj) { f32x4 a = acc[ai][bj][m][0] * sc, b = acc[ai][bj][m][1] * sc;
                        if (gate) { a = (f32x4){siluf(a[0]), siluf(a[1]), siluf(a[2]), siluf(a[3])}; b = (f32x4){siluf(b[0]), siluf(b[1]), siluf(b[2]), siluf(b[3])}; }
                        u32x4 w; w.x = pk(a[0], a[1]); w.y = pk(a[2], a[3]); w.z = pk(b[0], b[1]); w.w = pk(b[2], b[3]); *(u32x4*)(base + bj * 128) = w; }
                } else if (pn == 8) {
                    { const f32x4 a = acc[ai][0][m][0] * rs, b = acc[ai][0][m][1] * rs;
                      u32x4 w; w.x = pk(a[0], a[1]); w.y = pk(a[2], a[3]); w.z = pk(b[0], b[1]); w.w = pk(b[2], b[3]); *(u32x4*)((bf16_t*)(ws + OFF_KB) + (size_t)row * 128 + cw) = w; }
                    if (row < NVALID) {
                        int bb, pos; if (row < MX) { bb = row >> 12; pos = 64 + (row & 4095); } else { bb = (row - MX) >> 4; pos = 48 + ((row - MX) & 15); }
                        const int kvh = cw >> 6, d0 = cw & 63;
                        bf16_t* vt = (bf16_t*)(ws + OFF_VT) + ((size_t)(bb * 2 + kvh) * 64 + d0) * LP + pos;
#pragma unroll
                        for (int n = 0; n < 2; ++n)
#pragma unroll
                            for (int e = 0; e < 4; ++e) vt[(size_t)(n * 4 + e) * LP] = f2bf(acc[ai][1][m][n][e] * rs);
                    }
                } else if (pn == 9) {
                    if (wc == 0) { float* lp = (float*)(ws + OFF_LR) + (size_t)row * 32 + 8 * fq; *(f32x4*)lp = acc[ai][0][m][0] * rs; *(f32x4*)(lp + 4) = acc[ai][0][m][1] * rs; }
                } else {
                    const int gc = (pn - 10) * 256 + cw; bf16_t* base = (bf16_t*)(ws + OFF_GT) + (size_t)row * 2048 + gc;
#pragma unroll
                    for (int bj = 0; bj < 2; ++bj) { const f32x4 b0 = *(const f32x4*)(bm + gc + bj * 128), b1 = *(const f32x4*)(bm + gc + bj * 128 + 4);
                        const f32x4 a = acc[ai][bj][m][0] * rs + b0, b = acc[ai][bj][m][1] * rs + b1;
                        u32x4 w; w.x = pk(sigm(a[0]), sigm(a[1])); w.y = pk(sigm(a[2]), sigm(a[3])); w.z = pk(sigm(b[0]), sigm(b[1])); w.w = pk(sigm(b[2]), sigm(b[3])); *(u32x4*)(base + bj * 128) = w; }
                }
                asm volatile("" ::: "memory");
            }
    }
};
struct EpiMergeF {
    static constexpr bool PERM = true, AFTER_DRAIN = false, MIDK = true;
    bf16_t* Y; const bf16_t* G;
    __device__ __forceinline__ void mid(f32x4 (&acc)[2][2][4][2], const pg8::Unit& u, int wr, int wc, int fr, int fq) const {
        int row0 = u.pm * 256 + wr * 64 + fr; asm volatile("" : "+v"(row0)); const int col0 = u.pn * 256 + wc * 32 + 8 * fq;
#pragma unroll
        for (int ai = 0; ai < 2; ++ai)
#pragma unroll
            for (int m = 0; m < 4; ++m) {
                if (ai == 1 && u.pm == PG8_HALF_PM) continue;
                const int row = row0 + ai * 128 + m * 16;
#pragma unroll
                for (int bj = 0; bj < 2; ++bj) { const int col = col0 + bj * 128;
                    const u32x4 ga = *(const u32x4*)(G + (size_t)row * 2048 + col), gb = *(const u32x4*)(G + (size_t)row * 2048 + 1024 + col);
                    f32x4 r0, r1;
                    r0[0] = bflo(ga.x) * __builtin_amdgcn_rcpf(bflo(gb.x)); r0[1] = bfhi(ga.x) * __builtin_amdgcn_rcpf(bfhi(gb.x)); r0[2] = bflo(ga.y) * __builtin_amdgcn_rcpf(bflo(gb.y)); r0[3] = bfhi(ga.y) * __builtin_amdgcn_rcpf(bfhi(gb.y));
                    r1[0] = bflo(ga.z) * __builtin_amdgcn_rcpf(bflo(gb.z)); r1[1] = bfhi(ga.z) * __builtin_amdgcn_rcpf(bfhi(gb.z)); r1[2] = bflo(ga.w) * __builtin_amdgcn_rcpf(bflo(gb.w)); r1[3] = bfhi(ga.w) * __builtin_amdgcn_rcpf(bfhi(gb.w));
                    acc[ai][bj][m][0] = acc[ai][bj][m][0] * r0; acc[ai][bj][m][1] = acc[ai][bj][m][1] * r1;
                }
                asm volatile("" ::: "memory");
            }
    }
    __device__ __forceinline__ void operator()(const f32x4 (&acc)[2][2][4][2], const pg8::Unit& u, int wr, int wc, int fr, int fq) const {
        int row0 = u.pm * 256 + wr * 64 + fr; asm volatile("" : "+v"(row0)); const int col0 = u.pn * 256 + wc * 32 + 8 * fq;
#pragma unroll
        for (int ai = 0; ai < 2; ++ai)
#pragma unroll
            for (int m = 0; m < 4; ++m) {
                if (ai == 1 && u.pm == PG8_HALF_PM) continue;
                const int row = row0 + ai * 128 + m * 16;
#pragma unroll
                for (int bj = 0; bj < 2; ++bj) { const int col = col0 + bj * 128;
                    const u32x4 gb = *(const u32x4*)(G + (size_t)row * 2048 + 1024 + col);
                    float v[8];
                    v[0] = bflo(gb.x) * acc[ai][bj][m][0][0]; v[1] = bfhi(gb.x) * acc[ai][bj][m][0][1]; v[2] = bflo(gb.y) * acc[ai][bj][m][0][2]; v[3] = bfhi(gb.y) * acc[ai][bj][m][0][3];
                    v[4] = bflo(gb.z) * acc[ai][bj][m][1][0]; v[5] = bfhi(gb.z) * acc[ai][bj][m][1][1]; v[6] = bflo(gb.w) * acc[ai][bj][m][1][2]; v[7] = bfhi(gb.w) * acc[ai][bj][m][1][3];
                    u32x4 w; w.x = pk(v[0], v[1]); w.y = pk(v[2], v[3]); w.z = pk(v[4], v[5]); w.w = pk(v[6], v[7]); *(u32x4*)(Y + (size_t)row * D + col) = w;
                }
                asm volatile("" ::: "memory");
            }
    }
};

__device__ __forceinline__ void conv_item(const float* W, int N, int K, int src_n0, const float* gain, bf16_t* WT, int n0, int k0, LAS float* scr, int lane, int dk = 0) {
#pragma unroll
    for (int i = 0; i < 8; ++i) { const int kk = 8 * i + (lane >> 3), n4 = (lane & 7) * 4; f32x4 v = (f32x4){0.f, 0.f, 0.f, 0.f};
        if (src_n0 >= 0) { v = *(const f32x4*)(W + (size_t)(k0 + kk) * N + src_n0 + n4); if (gain) v = v * gain[k0 + kk]; }
        scr[kk * 33 + n4] = v[0]; scr[kk * 33 + n4 + 1] = v[1]; scr[kk * 33 + n4 + 2] = v[2]; scr[kk * 33 + n4 + 3] = v[3]; }
    LDS_WAIT(); __builtin_amdgcn_wave_barrier();
    const int c = lane & 7;
#pragma unroll
    for (int j = 0; j < 4; ++j) { const int n = (lane >> 3) + 8 * j; const LAS float* s = scr + (8 * c) * 33 + n;
        u32x4 o; o.x = pk(s[0 * 33], s[1 * 33]); o.y = pk(s[2 * 33], s[3 * 33]); o.z = pk(s[4 * 33], s[5 * 33]); o.w = pk(s[6 * 33], s[7 * 33]);
        *(u32x4*)(WT + (size_t)(n0 + n) * K + dk + k0 + 8 * c) = o; }
    LDS_WAIT(); __builtin_amdgcn_wave_barrier();
}
__device__ __forceinline__ int conv_win_src(int n0) {
    if (n0 < 1536) return n0;
    if (n0 < 2304) return n0 + 32;
    if (n0 == 2304) return 1536;
    if (n0 < 2560) return -1;
    return n0 - 224;
}
constexpr int CV_GU = 16 * 176, CV_DN = 44 * 32, CV_WIN = 16 * 144, CV_P = 8 * 32, CV_O = 16 * 32;
constexpr int CV_NIT = 2 * CV_GU + 2 * CV_DN + CV_WIN + 2 * CV_P + CV_O;
__device__ __forceinline__ void conv_one(const Params& p, int l, int it, LAS float* scr, int lane) {
    bf16_t* WT = (bf16_t*)((unsigned char*)p.out + OO_WT) + (size_t)(l & 1) * WT_END;
    int r = it;
    if (r < 2 * CV_GU) { const int f = r / CV_GU; r -= f * CV_GU; const int kb = r / 176, nb = r % 176, n0 = nb * 32;
        const int t = n0 >> 8, half = (n0 >> 7) & 1, j0 = n0 & 127;
        const float* W = (half ? p.wu : p.wg) + (size_t)(l * 2 + f) * D * DFF;
        conv_item(W, DFF, D, 128 * t + j0, p.ng + (size_t)(l * 3 + (f ? 2 : 0)) * D, WT + (f ? WT_GU1 : WT_GU0), n0, kb * 64, scr, lane); return; }
    r -= 2 * CV_GU;
    if (r < 2 * CV_DN) { const int f = r / CV_DN; r -= f * CV_DN; const int kb = r / 32, nb = r % 32;
        conv_item(p.wd + (size_t)(l * 2 + f) * DFF * D, D, DFF, nb * 32, nullptr, WT + (f ? WT_DN1 : WT_DN0), nb * 32, kb * 64, scr, lane); return; }
    r -= 2 * CV_DN;
    if (r < CV_WIN) { const int kb = r / 144, nb = r % 144;
        conv_item(p.win + (size_t)l * D * DIN, DIN, D, conv_win_src(nb * 32), p.ng + (size_t)(l * 3 + 1) * D, WT + WT_WIN, nb * 32, kb * 64, scr, lane); return; }
    r -= CV_WIN;
    if (r < 2 * CV_P) { const int f = r / CV_P; r -= f * CV_P; const int kb = r / 32, nb = r % 32;
        conv_item((f ? p.wpb : p.wpa) + (size_t)l * 512 * D, D, 1024, nb * 32, nullptr, WT + WT_PA, nb * 32, kb * 64, scr, lane, f * 512); return; }
    r -= 2 * CV_P;
    { const int kb = r / 32, nb = r % 32; conv_item(p.wout + (size_t)l * D * D, D, D, nb * 32, nullptr, WT + WT_OUT, nb * 32, kb * 64, scr, lane); }
}
__device__ __forceinline__ void conv_layer(const Params& p, int l, LAS unsigned char* lds, int gw, int ngw, int wid, int lane) {
    LAS float* scr = (LAS float*)(lds + wid * 8448);
    for (int it = gw; it < CV_NIT; it += ngw) conv_one(p, l, it, scr, lane);
}

__device__ __forceinline__ float wave_sum(float v) {
#pragma unroll
    for (int o = 1; o < 64; o <<= 1) v += __shfl_xor(v, o);
    return v;
}
__device__ __forceinline__ void prologue(const Params& p, int gw, int ngw, int lane) {
    bf16_t* HB = (bf16_t*)(p.ws + OFF_H); float* SSQ = (float*)(p.ws + OFF_SSQ);
    for (int row = gw; row < MROWS; row += ngw) {
        f32x4 v[4]; float s = 0.f;
#pragma unroll
        for (int j = 0; j < 4; ++j) {
            if (row < MX) v[j] = *((const f32x4*)(p.x + (size_t)row * D) + lane + 64 * j);
            else if (row < NVALID) v[j] = *((const f32x4*)(p.meta + (size_t)((row - MX) & 15) * D) + lane + 64 * j);
            else v[j] = (f32x4){0.f, 0.f, 0.f, 0.f};
            s += (v[j][0] * v[j][0] + v[j][1] * v[j][1]) + (v[j][2] * v[j][2] + v[j][3] * v[j][3]);
        }
        s = wave_sum(s);
#pragma unroll
        for (int j = 0; j < 4; ++j) {
            u32x2 w; w.x = pk(v[j][0], v[j][1]); w.y = pk(v[j][2], v[j][3]); *((u32x2*)(HB + (size_t)row * D) + lane + 64 * j) = w; }
        if (lane < 16) SSQ[(size_t)row * 16 + lane] = (lane == 0) ? s : 0.f;
    }
    const int gt = gw * 64 + lane, ngt = ngw * 64;
    float* ROPE = (float*)(p.ws + OFF_ROPE);
    for (int i = gt; i < SEQ * 32; i += ngt) { const int t = i >> 5, f = i & 31, fi = f & 15; const float pos = (float)((f < 16) ? (t >> 6) : (t & 63));
        const float inv = exp2f(-(float)fi * (13.287712379549449f / 16.0f)); float rev = pos * inv * 0.15915494309189535f; rev -= floorf(rev);
        ROPE[t * 64 + f] = __builtin_amdgcn_cosf(rev); ROPE[t * 64 + 32 + f] = __builtin_amdgcn_sinf(rev); }
    if (gt < DEPTH) ((unsigned*)(p.ws + OFF_CTR))[gt * 64] = 0u;
    bf16_t* VT = (bf16_t*)(p.ws + OFF_VT);
    for (int i = gt; i < NB * 2 * 64 * 48; i += ngt) { const int r = i / 48, c = i % 48; VT[(size_t)r * LP + c] = 0; }
}
__device__ __forceinline__ void final_norm(const Params& p, int gw, int ngw, int lane) {
    const bf16_t* HB = (const bf16_t*)(p.ws + OFF_H); const float* SSQ = (const float*)(p.ws + OFF_SSQ) + (size_t)12 * MROWS * 16;
    for (int row = gw; row < MX; row += ngw) { const float rs = rstd_row(SSQ, row);
#pragma unroll
        for (int j = 0; j < 4; ++j) { const u32x2 w = *((const u32x2*)(HB + (size_t)row * D) + lane + 64 * j); const f32x4 g = *((const f32x4*)p.fn + lane + 64 * j);
            const f32x4 v = (f32x4){bflo(w.x), bfhi(w.x), bflo(w.y), bfhi(w.y)};
            *((f32x4*)(p.out + (size_t)row * D) + lane + 64 * j) = v * rs * g; } }
}

__device__ __forceinline__ void prep_qk(const Params& p, int l, int gt, int ngt) {
    const float* ROPE = (const float*)(p.ws + OFF_ROPE); const int j = gt & 7;
    for (int item = gt >> 3; item < NVALID * 10; item += ngt >> 3) {
        const int row = item / 10, hd = item % 10;
        bf16_t* ptr = ((hd < 8) ? (bf16_t*)(p.ws + OFF_RA) + (size_t)row * 1024 + 512 + hd * 64 : (bf16_t*)(p.ws + OFF_KB) + (size_t)row * 128 + (hd - 8) * 64) + 8 * j;
        const float* gain = ((hd < 8) ? p.qn : p.kn) + l * 64 + 8 * j; const float osc = (hd < 8) ? 0.125f * LOG2E : 1.0f;
        const u32x4 w = *(const u32x4*)ptr; const f32x4 g0 = *(const f32x4*)gain, g1 = *(const f32x4*)(gain + 4);
        float v[8] = {bflo(w.x), bfhi(w.x), bflo(w.y), bfhi(w.y), bflo(w.z), bfhi(w.z), bflo(w.w), bfhi(w.w)};
        float ss = 0.f;
#pragma unroll
        for (int e = 0; e < 8; ++e) ss += v[e] * v[e];
        ss += __shfl_xor(ss, 1); ss += __shfl_xor(ss, 2); ss += __shfl_xor(ss, 4);
        const float rs = __builtin_amdgcn_rsqf(ss * (1.0f / 64.0f) + EPS);
#pragma unroll
        for (int e = 0; e < 8; ++e) v[e] = v[e] * rs * ((e < 4) ? g0[e] : g1[e - 4]);
        if (row < MX) {
            const float* cs = ROPE + (size_t)(row & 4095) * 64 + 16 * (j >> 2) + 8 * (j & 1);
            const f32x4 c0 = *(const f32x4*)cs, c1 = *(const f32x4*)(cs + 4), s0 = *(const f32x4*)(cs + 32), s1 = *(const f32x4*)(cs + 36);
#pragma unroll
            for (int e = 0; e < 8; ++e) { const float c = (e < 4) ? c0[e] : c1[e - 4], sn = (e < 4) ? s0[e] : s1[e - 4]; const float o = __shfl_xor(v[e], 2);
                v[e] = (j & 2) ? (v[e] * c + o * sn) : (v[e] * c - o * sn); } }
        *(u32x4*)ptr = (u32x4){pk(v[0] * osc, v[1] * osc), pk(v[2] * osc, v[3] * osc), pk(v[4] * osc, v[5] * osc), pk(v[6] * osc, v[7] * osc)};
    }
}

constexpr int AT_TILE = 64 * 144, AT_K = 0, AT_V = 2 * AT_TILE, AT_VP = 136, AT_VTILE = 64 * AT_VP;
template <int NBLK, bool TRACK> __device__ __forceinline__ void attn_unit(const Params& p, int b, int kvh, int jb, LAS unsigned char* lds) {
    const int tid = mk_tid(), lane = tid & 63, wid = __builtin_amdgcn_readfirstlane(tid >> 6), r32 = lane & 31, hi = lane >> 5;
    bf16_t* QB = (bf16_t*)(p.ws + OFF_RA) + 512; const bf16_t* KB = (const bf16_t*)(p.ws + OFF_KB); const bf16_t* VT = (const bf16_t*)(p.ws + OFF_VT);
    const int hq = kvh * 4 + (wid >> 1);
    bool qvalid[NBLK]; bf16_t* qp[NBLK]; bf16x8 qr[NBLK][4];
#pragma unroll
    for (int blk = 0; blk < NBLK; ++blk) { const int rr = (wid & 1) * 64 + blk * 32 + r32;
        qvalid[blk] = (jb >= 0) || (rr < 16);
        const size_t qrow = (jb >= 0) ? (size_t)b * SEQ + jb * 128 + rr : (size_t)MX + b * 16 + (rr & 15);
        qp[blk] = QB + qrow * 1024 + hq * 64;
#pragma unroll
        for (int ds = 0; ds < 4; ++ds) qr[blk][ds] = qvalid[blk] ? *(const bf16x8*)(qp[blk] + ds * 16 + hi * 8) : (bf16x8){0, 0, 0, 0, 0, 0, 0, 0}; }
    const int tk = tid >> 3, tc = tid & 7;
    const bf16_t* vsrc = VT + ((size_t)(b * 2 + kvh) * 64 + tk) * LP + tc * 8;
    const bf16_t* ksrc = KB + ((size_t)b * SEQ + tk) * 128 + kvh * 64 + tc * 8;
    const bf16_t* ksrc0 = KB + ((size_t)MX + b * 16 + (tk - 48)) * 128 + kvh * 64 + tc * 8;
    const int lst = tk * 144 + tc * 16, lstv = tk * AT_VP + tc * 16;
    u32x4 kreg, vreg;
    kreg = (tk >= 48) ? *(const u32x4*)ksrc0 : (u32x4){0u, 0u, 0u, 0u}; vreg = *(const u32x4*)vsrc;
    *(LAS u32x4*)(lds + AT_K + lst) = kreg; *(LAS u32x2*)(lds + AT_V + lstv) = (u32x2){vreg.x, vreg.y}; *(LAS u32x2*)(lds + AT_V + lstv + 8) = (u32x2){vreg.z, vreg.w};
    __syncthreads();
    f32x16 o0[NBLK], o1[NBLK]; float mrun[NBLK], lrun[NBLK];
#pragma unroll
    for (int blk = 0; blk < NBLK; ++blk) { mrun[blk] = -1e30f; lrun[blk] = 0.f;
#pragma unroll
        for (int r = 0; r < 16; ++r) { o0[blk][r] = 0.f; o1[blk][r] = 0.f; } }
    for (int t = 0; t < NCH; ++t) {
        const int buf = t & 1;
        if (t + 1 < NCH) { kreg = *(const u32x4*)(ksrc + (size_t)t * 64 * 128); vreg = *(const u32x4*)(vsrc + (t + 1) * 64); }
        const LAS unsigned char* Kl = lds + AT_K + buf * AT_TILE; const LAS unsigned char* Vl = lds + AT_V + buf * AT_VTILE;
        f32x16 p0[NBLK], p1[NBLK];
#pragma unroll
        for (int blk = 0; blk < NBLK; ++blk)
#pragma unroll
            for (int r = 0; r < 16; ++r) { p0[blk][r] = 0.f; p1[blk][r] = 0.f; }
#pragma unroll
        for (int ds = 0; ds < 4; ++ds) {
            const bf16x8 k0 = *(const LAS bf16x8*)(Kl + r32 * 144 + ds * 32 + hi * 16), k1 = *(const LAS bf16x8*)(Kl + (r32 + 32) * 144 + ds * 32 + hi * 16);
#pragma unroll
            for (int blk = 0; blk < NBLK; ++blk) {
                p0[blk] = __builtin_amdgcn_mfma_f32_32x32x16_bf16(k0, qr[blk][ds], p0[blk], 0, 0, 0);
                p1[blk] = __builtin_amdgcn_mfma_f32_32x32x16_bf16(k1, qr[blk][ds], p1[blk], 0, 0, 0); }
        }
        u32x4 pw[NBLK][4];
#pragma unroll
        for (int blk = 0; blk < NBLK; ++blk) {
            if (t == 0) {
#pragma unroll
                for (int r = 0; r < 16; ++r) { p0[blk][r] = -1e30f; if (r < 8) p1[blk][r] = -1e30f; }
            }
            float ls = 0.f;
            if (TRACK) {
                float mx = fmaxf(p0[blk][0], p1[blk][0]);
#pragma unroll
                for (int r = 1; r < 16; ++r) mx = fmaxf(mx, fmaxf(p0[blk][r], p1[blk][r]));
                mx = fmaxf(mx, __shfl_xor(mx, 32));
                if (__any(mx > mrun[blk] + 8.0f)) {
                    const float mnew = fmaxf(mrun[blk], mx), alpha = __builtin_amdgcn_exp2f(mrun[blk] - mnew);
                    lrun[blk] *= alpha; mrun[blk] = mnew;
#pragma unroll
                    for (int r = 0; r < 16; ++r) { o0[blk][r] *= alpha; o1[blk][r] *= alpha; }
                }
#pragma unroll
                for (int r = 0; r < 16; ++r) { p0[blk][r] = __builtin_amdgcn_exp2f(p0[blk][r] - mrun[blk]); p1[blk][r] = __builtin_amdgcn_exp2f(p1[blk][r] - mrun[blk]); ls += p0[blk][r] + p1[blk][r]; }
            } else {
#pragma unroll
                for (int r = 0; r < 16; ++r) { p0[blk][r] = __builtin_amdgcn_exp2f(p0[blk][r]); p1[blk][r] = __builtin_amdgcn_exp2f(p1[blk][r]); }
                typedef float f32x8v __attribute__((ext_vector_type(8))); typedef float f32x2v __attribute__((ext_vector_type(2)));
                const f32x16 sv = p0[blk] + p1[blk];
                const f32x8v s8 = sv.lo + sv.hi; const f32x4 s4 = s8.lo + s8.hi; const f32x2v s2 = s4.lo + s4.hi; ls = s2.x + s2.y;
            }
            lrun[blk] += ls;
            pw[blk][0] = (u32x4){pk(p0[blk][0], p0[blk][1]), pk(p0[blk][2], p0[blk][3]), pk(p0[blk][4], p0[blk][5]), pk(p0[blk][6], p0[blk][7])};
            pw[blk][1] = (u32x4){pk(p0[blk][8], p0[blk][9]), pk(p0[blk][10], p0[blk][11]), pk(p0[blk][12], p0[blk][13]), pk(p0[blk][14], p0[blk][15])};
            pw[blk][2] = (u32x4){pk(p1[blk][0], p1[blk][1]), pk(p1[blk][2], p1[blk][3]), pk(p1[blk][4], p1[blk][5]), pk(p1[blk][6], p1[blk][7])};
            pw[blk][3] = (u32x4){pk(p1[blk][8], p1[blk][9]), pk(p1[blk][10], p1[blk][11]), pk(p1[blk][12], p1[blk][13]), pk(p1[blk][14], p1[blk][15])};
        }
#pragma unroll
        for (int s = 0; s < 4; ++s) {
            { const u32x2 a = *(const LAS u32x2*)(Vl + r32 * AT_VP + (16 * s + 4 * hi) * 2), c = *(const LAS u32x2*)(Vl + r32 * AT_VP + (16 * s + 8 + 4 * hi) * 2);
              const bf16x8 vf = __builtin_bit_cast(bf16x8, (u32x4){a.x, a.y, c.x, c.y});
#pragma unroll
              for (int blk = 0; blk < NBLK; ++blk) o0[blk] = __builtin_amdgcn_mfma_f32_32x32x16_bf16(vf, __builtin_bit_cast(bf16x8, pw[blk][s]), o0[blk], 0, 0, 0); }
            { const u32x2 a = *(const LAS u32x2*)(Vl + (r32 + 32) * AT_VP + (16 * s + 4 * hi) * 2), c = *(const LAS u32x2*)(Vl + (r32 + 32) * AT_VP + (16 * s + 8 + 4 * hi) * 2);
              const bf16x8 vf = __builtin_bit_cast(bf16x8, (u32x4){a.x, a.y, c.x, c.y});
#pragma unroll
              for (int blk = 0; blk < NBLK; ++blk) o1[blk] = __builtin_amdgcn_mfma_f32_32x32x16_bf16(vf, __builtin_bit_cast(bf16x8, pw[blk][s]), o1[blk], 0, 0, 0); }
        }
        if (t + 1 < NCH) { *(LAS u32x4*)(lds + AT_K + (buf ^ 1) * AT_TILE + lst) = kreg; *(LAS u32x2*)(lds + AT_V + (buf ^ 1) * AT_VTILE + lstv) = (u32x2){vreg.x, vreg.y}; *(LAS u32x2*)(lds + AT_V + (buf ^ 1) * AT_VTILE + lstv + 8) = (u32x2){vreg.z, vreg.w}; }
        __syncthreads();
    }
#pragma unroll
    for (int blk = 0; blk < NBLK; ++blk) {
        float l = lrun[blk]; l += __shfl_xor(l, 32);
        const float inv = 1.0f / l;
        if (qvalid[blk]) {
#pragma unroll
            for (int g = 0; g < 4; ++g) {
                u32x2 w0; w0.x = pk(o0[blk][4 * g] * inv, o0[blk][4 * g + 1] * inv); w0.y = pk(o0[blk][4 * g + 2] * inv, o0[blk][4 * g + 3] * inv);
                u32x2 w1; w1.x = pk(o1[blk][4 * g] * inv, o1[blk][4 * g + 1] * inv); w1.y = pk(o1[blk][4 * g + 2] * inv, o1[blk][4 * g + 3] * inv);
                *(u32x2*)(qp[blk] + 8 * g + 4 * hi) = w0; *(u32x2*)(qp[blk] + 32 + 8 * g + 4 * hi) = w1;
            }
        }
    }
}
__device__ __forceinline__ void attn_phase(const Params& p, int l, LAS unsigned char* lds, int vcu, int G) {
    const int lane = mk_tid() & 63;
    float gq = fabsf(p.qn[l * 64 + lane]), gk = fabsf(p.kn[l * 64 + lane]);
#pragma unroll
    for (int o = 1; o < 64; o <<= 1) { gq = fmaxf(gq, __shfl_xor(gq, o)); gk = fmaxf(gk, __shfl_xor(gk, o)); }
    const bool safe = __builtin_amdgcn_readfirstlane((gq * gk * 11.55f < 40.0f) ? 1 : 0) != 0;
    const int nper = (512 + G - 1) / G;
    if (safe) {
        for (int i = 0; i < nper; ++i) { const int id = vcu * nper + i; if (id < 512) attn_unit<2, false>(p, id >> 6, (id >> 5) & 1, id & 31, lds); }
        for (int m = 0; m < 16; ++m) if ((m * G) / 16 == vcu) attn_unit<1, false>(p, m >> 1, m & 1, -1, lds);
    } else {
        for (int i = 0; i < nper; ++i) { const int id = vcu * nper + i; if (id < 512) attn_unit<2, true>(p, id >> 6, (id >> 5) & 1, id & 31, lds); }
        for (int m = 0; m < 16; ++m) if ((m * G) / 16 == vcu) attn_unit<1, true>(p, m >> 1, m & 1, -1, lds);
    }
}

__device__ __forceinline__ void gla_scan(const Params& p, int gt, int ngt) {
    bf16_t* S = (bf16_t*)(p.ws + OFF_S); const float* DEC = (const float*)(p.ws + OFF_DEC);
    if (gt & 1) return;
    for (int task = gt >> 1; task < 64 * 1024; task += ngt >> 1) {
        const int bhd = task >> 10, e = (task & 1023) * 8, c = e & 63, dir = bhd & 1;
        bf16_t* sp = S + (size_t)bhd * NCH * 8192 + e; const float* dp = DEC + (size_t)bhd * NCH * 64 + c;
        f32x4 s0 = (f32x4){0.f, 0.f, 0.f, 0.f}, s1 = s0;
#pragma unroll 5
        for (int k = 0; k < NCH; ++k) { const int ch = dir ? (NCH - 1 - k) : k;
            const u32x4 kv = *(const u32x4*)(sp + (size_t)ch * 8192); const f32x4 d0 = *(const f32x4*)(dp + ch * 64), d1 = *(const f32x4*)(dp + ch * 64 + 4);
            *(u32x4*)(sp + (size_t)ch * 8192) = (u32x4){pk(s0[0], s0[1]), pk(s0[2], s0[3]), pk(s1[0], s1[1]), pk(s1[2], s1[3])};
            s0 = d0 * s0 + (f32x4){bflo(kv.x), bfhi(kv.x), bflo(kv.y), bfhi(kv.y)}; s1 = d1 * s1 + (f32x4){bflo(kv.z), bfhi(kv.z), bflo(kv.w), bfhi(kv.w)}; }
    }
}
constexpr int GL2_QD = 0;
constexpr int GL2_KI = 18432;
constexpr int GL2_VT = 36864;
constexpr int GL2_ATT = 55296;
constexpr int GL2_W2 = 64512;
constexpr int GL2_SZ = 64512 + 8192 + 512;
constexpr int GLA_UNITS = 32 * NCH;
static_assert(2 * GL2_SZ + 16 <= LDS_BYTES && GLA_UNITS % 2 == 0, "GLA LDS");
template <bool G3> __device__ __forceinline__ void gla_pair(const Params& p, int l, int u, bool valid, LAS unsigned char* lds) {
    const int tid = mk_tid(), lane = tid & 63, wid = __builtin_amdgcn_readfirstlane(tid >> 6), w4 = wid & 3, t8 = tid & 255, fr = lane & 15, fq = lane >> 4;
    const bf16_t* QKA = (const bf16_t*)(p.ws + OFF_QKA); const bf16_t* VA = (const bf16_t*)(p.ws + OFF_VA); bf16_t* RA = (bf16_t*)(p.ws + OFF_RA);
    const float* LR = (const float*)(p.ws + OFF_LR); bf16_t* S = (bf16_t*)(p.ws + OFF_S); float* DEC = (float*)(p.ws + OFF_DEC);
    const int bh = u / NCH, chunk = u % NCH, b = bh >> 2, h = bh & 3, c0 = w4 * 16;
#define GL_ROW(i) ((chunk == 0) ? ((size_t)MX + b * 16 + ((i) - 48)) : ((size_t)b * SEQ + (chunk - 1) * 64 + (i)))
#define GL_NUL(i) ((chunk == 0) && ((i) < 48))
    const int i = lane; const bool nul = GL_NUL(i); const size_t row = nul ? (size_t)MX : GL_ROW(i);
    LAS float* w2s = (LAS float*)(lds + GL2_W2); LAS float* b2s = w2s + 2048;
#pragma unroll
    for (int q = 0; q < 2; ++q) { const int ch = t8 + 256 * q, rr = ch >> 4, c4 = (ch & 15) * 4;
        *(LAS f32x4*)(w2s + rr * 64 + c4) = *(const f32x4*)(p.w2 + (size_t)(l * 32 + rr) * 256 + h * 64 + c4); }
    if (t8 < 32) { const int dd = t8 >> 4, c4 = (t8 & 15) * 4; *(LAS f32x4*)(b2s + dd * 64 + c4) = *(const f32x4*)(p.b2 + (size_t)(l * 2 + dd) * 256 + h * 64 + c4); }
    __syncthreads();
    float bcv[2][16];
#pragma unroll
    for (int dir = 0; dir < 2; ++dir) {
        float lrv[16];
        { const float* lrp = LR + row * 32 + dir * 16;
#pragma unroll
          for (int q = 0; q < 4; ++q) { const f32x4 t = *(const f32x4*)(lrp + 4 * q); lrv[4 * q] = t[0]; lrv[4 * q + 1] = t[1]; lrv[4 * q + 2] = t[2]; lrv[4 * q + 3] = t[3]; } }
        const LAS float* w2p = w2s + dir * 1024 + c0; const LAS float* b2p = b2s + dir * 64 + c0;
#pragma unroll
        for (int cc = 0; cc < 16; ++cc) {
            float x = b2p[cc];
#pragma unroll
            for (int r = 0; r < 16; ++r) x += lrv[r] * w2p[r * 64 + cc];
            const float lg = nul ? 0.f : __builtin_amdgcn_logf(1.f + __builtin_amdgcn_exp2f(fminf(-x, 60.f) * LOG2E)) * (-0.6931471805599453f / 16.0f);
            float sc = wave_incl_scan(lg);
            if (dir == 1) sc = lane_bcast(sc, 63) - sc + lg;
            bcv[dir][cc] = sc;
        }
    }
    LAS bf16_t* vT = (LAS bf16_t*)(lds + GL2_VT);
#pragma unroll
    for (int q = 0; q < 4; ++q) { const int vc = w4 * 4 + q;
        const u32x4 w = nul ? (u32x4){0u, 0u, 0u, 0u} : *(const u32x4*)(VA + row * 512 + h * 128 + vc * 8);
        vT[(vc * 8 + 0) * 72 + i] = (bf16_t)(w.x & 0xffffu); vT[(vc * 8 + 1) * 72 + i] = (bf16_t)(w.x >> 16); vT[(vc * 8 + 2) * 72 + i] = (bf16_t)(w.y & 0xffffu); vT[(vc * 8 + 3) * 72 + i] = (bf16_t)(w.y >> 16);
        vT[(vc * 8 + 4) * 72 + i] = (bf16_t)(w.z & 0xffffu); vT[(vc * 8 + 5) * 72 + i] = (bf16_t)(w.z >> 16); vT[(vc * 8 + 6) * 72 + i] = (bf16_t)(w.w & 0xffffu); vT[(vc * 8 + 7) * 72 + i] = (bf16_t)(w.w >> 16); }
    float kf[16], qf[16];
    { const u32x4 k0 = nul ? (u32x4){0u, 0u, 0u, 0u} : *(const u32x4*)(QKA + row * 512 + 256 + h * 64 + c0), k1 = nul ? (u32x4){0u, 0u, 0u, 0u} : *(const u32x4*)(QKA + row * 512 + 256 + h * 64 + c0 + 8);
      kf[0] = bflo(k0.x); kf[1] = bfhi(k0.x); kf[2] = bflo(k0.y); kf[3] = bfhi(k0.y); kf[4] = bflo(k0.z); kf[5] = bfhi(k0.z); kf[6] = bflo(k0.w); kf[7] = bfhi(k0.w);
      kf[8] = bflo(k1.x); kf[9] = bfhi(k1.x); kf[10] = bflo(k1.y); kf[11] = bfhi(k1.y); kf[12] = bflo(k1.z); kf[13] = bfhi(k1.z); kf[14] = bflo(k1.w); kf[15] = bfhi(k1.w); }
    if (G3) { const u32x4 q0 = nul ? (u32x4){0u, 0u, 0u, 0u} : *(const u32x4*)(QKA + row * 512 + h * 64 + c0), q1 = nul ? (u32x4){0u, 0u, 0u, 0u} : *(const u32x4*)(QKA + row * 512 + h * 64 + c0 + 8);
      qf[0] = bflo(q0.x); qf[1] = bfhi(q0.x); qf[2] = bflo(q0.y); qf[3] = bfhi(q0.y); qf[4] = bflo(q0.z); qf[5] = bfhi(q0.z); qf[6] = bflo(q0.w); qf[7] = bfhi(q0.w);
      qf[8] = bflo(q1.x); qf[9] = bfhi(q1.x); qf[10] = bflo(q1.y); qf[11] = bfhi(q1.y); qf[12] = bflo(q1.z); qf[13] = bfhi(q1.z); qf[14] = bflo(q1.w); qf[15] = bfhi(q1.w); }
    bf16x8 sfr[2][2][2]; u32x4 rpre[4];
    if (G3) {
#pragma unroll
        for (int dir = 0; dir < 2; ++dir) { const bf16_t* sp = S + ((size_t)(bh * 2 + dir) * NCH + chunk) * 8192;
#pragma unroll
            for (int vt = 0; vt < 2; ++vt)
#pragma unroll
                for (int ks = 0; ks < 2; ++ks) sfr[dir][vt][ks] = *(const bf16x8*)(sp + (size_t)((w4 * 2 + vt) * 16 + fr) * 64 + 32 * ks + 8 * fq); }
        { const int ii = t8 >> 2, part = t8 & 3; const size_t rr = GL_NUL(ii) ? (size_t)MX : GL_ROW(ii); const bf16_t* rp = RA + rr * 1024 + h * 128 + part * 32;
#pragma unroll
          for (int q = 0; q < 4; ++q) rpre[q] = *(const u32x4*)(rp + 8 * q); }
    }
    if (!G3) {
        LAS bf16_t* keT = (LAS bf16_t*)(lds + GL2_QD);
#pragma unroll
        for (int cc = 0; cc < 16; ++cc) {
            const float btF = lane_bcast(bcv[0][cc], 63), btB = lane_bcast(bcv[1][cc], 0);
            keT[(c0 + cc) * 72 + i] = f2bf(kf[cc] * fexp(btF - bcv[0][cc])); keT[(64 + c0 + cc) * 72 + i] = f2bf(kf[cc] * fexp(btB - bcv[1][cc]));
            if (valid && lane == 0) { DEC[((size_t)(bh * 2 + 0) * NCH + chunk) * 64 + c0 + cc] = fexp(btF); DEC[((size_t)(bh * 2 + 1) * NCH + chunk) * 64 + c0 + cc] = fexp(btB); }
        }
        __syncthreads();
#pragma unroll
        for (int dir = 0; dir < 2; ++dir) { bf16_t* sbase = S + ((size_t)(bh * 2 + dir) * NCH + chunk) * 8192;
#pragma unroll
          for (int vt = 0; vt < 2; ++vt) { const int v0 = (w4 * 2 + vt) * 16;
              const bf16x8 a0 = *(const LAS bf16x8*)(vT + (v0 + fr) * 72 + 8 * fq), a1 = *(const LAS bf16x8*)(vT + (v0 + fr) * 72 + 32 + 8 * fq);
              u32x2 w[4];
#pragma unroll
              for (int ct = 0; ct < 4; ++ct) { const int crow = dir * 64 + 16 * (fr >> 2) + 4 * ct + (fr & 3);
                  const bf16x8 b0 = *(const LAS bf16x8*)(keT + crow * 72 + 8 * fq), b1 = *(const LAS bf16x8*)(keT + crow * 72 + 32 + 8 * fq);
                  f32x4 acc = (f32x4){0.f, 0.f, 0.f, 0.f};
                  acc = __builtin_amdgcn_mfma_f32_16x16x32_bf16(b0, a0, acc, 0, 0, 0); acc = __builtin_amdgcn_mfma_f32_16x16x32_bf16(b1, a1, acc, 0, 0, 0);
                  w[ct].x = pk(acc[0], acc[1]); w[ct].y = pk(acc[2], acc[3]); }
              if (valid) { bf16_t* dst = sbase + (size_t)(v0 + fr) * 64 + 16 * fq;
                  *(u32x4*)dst = (u32x4){w[0].x, w[0].y, w[1].x, w[1].y}; *(u32x4*)(dst + 8) = (u32x4){w[2].x, w[2].y, w[3].x, w[3].y}; } } }
        __syncthreads();
    } else {
        LAS bf16_t* qd = (LAS bf16_t*)(lds + GL2_QD); LAS bf16_t* ki = (LAS bf16_t*)(lds + GL2_KI); LAS bf16_t* att = (LAS bf16_t*)(lds + GL2_ATT);
#pragma unroll
        for (int dir = 0; dir < 2; ++dir) { float qo[16], ko[16];
#pragma unroll
            for (int cc = 0; cc < 16; ++cc) { qo[cc] = qf[cc] * fexp(bcv[dir][cc]); ko[cc] = kf[cc] * fexp(-bcv[dir][cc]); }
            *(LAS u32x4*)(qd + (dir * 64 + i) * 72 + c0) = (u32x4){pk(qo[0], qo[1]), pk(qo[2], qo[3]), pk(qo[4], qo[5]), pk(qo[6], qo[7])};
            *(LAS u32x4*)(qd + (dir * 64 + i) * 72 + c0 + 8) = (u32x4){pk(qo[8], qo[9]), pk(qo[10], qo[11]), pk(qo[12], qo[13]), pk(qo[14], qo[15])};
            *(LAS u32x4*)(ki + (dir * 64 + i) * 72 + c0) = (u32x4){pk(ko[0], ko[1]), pk(ko[2], ko[3]), pk(ko[4], ko[5]), pk(ko[6], ko[7])};
            *(LAS u32x4*)(ki + (dir * 64 + i) * 72 + c0 + 8) = (u32x4){pk(ko[8], ko[9]), pk(ko[10], ko[11]), pk(ko[12], ko[13]), pk(ko[14], ko[15])}; }
        __syncthreads();
        const int i0 = w4 * 16;
        bf16x8 aFq[2], aBq[2];
#pragma unroll
        for (int ks = 0; ks < 2; ++ks) { aFq[ks] = *(const LAS bf16x8*)(qd + (i0 + fr) * 72 + 32 * ks + 8 * fq); aBq[ks] = *(const LAS bf16x8*)(qd + (64 + i0 + fr) * 72 + 32 * ks + 8 * fq); }
#pragma unroll
        for (int jt = 0; jt < 4; ++jt) { const int j0 = jt * 16;
            f32x4 aF = (f32x4){0.f, 0.f, 0.f, 0.f}, aB = (f32x4){0.f, 0.f, 0.f, 0.f};
#pragma unroll
            for (int ks = 0; ks < 2; ++ks) {
                const bf16x8 kf_ = *(const LAS bf16x8*)(ki + (j0 + fr) * 72 + 32 * ks + 8 * fq), kb_ = *(const LAS bf16x8*)(ki + (64 + j0 + fr) * 72 + 32 * ks + 8 * fq);
                aF = __builtin_amdgcn_mfma_f32_16x16x32_bf16(aFq[ks], kf_, aF, 0, 0, 0); aB = __builtin_amdgcn_mfma_f32_16x16x32_bf16(aBq[ks], kb_, aB, 0, 0, 0); }
#pragma unroll
            for (int r = 0; r < 4; ++r) { const int ii = i0 + 4 * fq + r, jj = j0 + fr; const float v = ((ii >= jj) ? aF[r] : 0.f) + ((jj >= ii) ? aB[r] : 0.f); att[ii * 72 + jj] = f2bf(v); } }
        __syncthreads();
        LAS bf16_t* ol = ki;
        { bf16x8 bV[2][2];
#pragma unroll
          for (int vt = 0; vt < 2; ++vt)
#pragma unroll
              for (int ks = 0; ks < 2; ++ks) bV[vt][ks] = *(const LAS bf16x8*)(vT + ((w4 * 2 + vt) * 16 + fr) * 72 + 32 * ks + 8 * fq);
#pragma unroll
          for (int it = 0; it < 4; ++it) { const int ib = it * 16; bf16x8 aA[2], aF2[2], aB2[2];
#pragma unroll
              for (int ks = 0; ks < 2; ++ks) { aA[ks] = *(const LAS bf16x8*)(att + (ib + fr) * 72 + 32 * ks + 8 * fq); aF2[ks] = *(const LAS bf16x8*)(qd + (ib + fr) * 72 + 32 * ks + 8 * fq);
                  aB2[ks] = *(const LAS bf16x8*)(qd + (64 + ib + fr) * 72 + 32 * ks + 8 * fq); }
#pragma unroll
              for (int vt = 0; vt < 2; ++vt) { const int v0 = (w4 * 2 + vt) * 16; f32x4 acc = (f32x4){0.f, 0.f, 0.f, 0.f};
#pragma unroll
                  for (int ks = 0; ks < 2; ++ks) { acc = __builtin_amdgcn_mfma_f32_16x16x32_bf16(aA[ks], bV[vt][ks], acc, 0, 0, 0);
                      acc = __builtin_amdgcn_mfma_f32_16x16x32_bf16(aF2[ks], sfr[0][vt][ks], acc, 0, 0, 0); acc = __builtin_amdgcn_mfma_f32_16x16x32_bf16(aB2[ks], sfr[1][vt][ks], acc, 0, 0, 0); }
#pragma unroll
                  for (int r = 0; r < 4; ++r) ol[(ib + 4 * fq + r) * 136 + v0 + fr] = f2bf(acc[r]); } } }
        __syncthreads();
        { const int ii = t8 >> 2, part = t8 & 3; const bool nl = GL_NUL(ii); float ov[32]; float ss = 0.f;
#pragma unroll
          for (int q = 0; q < 4; ++q) { const u32x4 t = *(const LAS u32x4*)(ol + ii * 136 + part * 32 + 8 * q);
              ov[8 * q] = bflo(t.x); ov[8 * q + 1] = bfhi(t.x); ov[8 * q + 2] = bflo(t.y); ov[8 * q + 3] = bfhi(t.y); ov[8 * q + 4] = bflo(t.z); ov[8 * q + 5] = bfhi(t.z); ov[8 * q + 6] = bflo(t.w); ov[8 * q + 7] = bfhi(t.w); }
#pragma unroll
          for (int e = 0; e < 32; ++e) ss += ov[e] * ov[e];
          ss += __shfl_xor(ss, 1); ss += __shfl_xor(ss, 2);
          const float rs = __builtin_amdgcn_rsqf(ss * (1.0f / 128.0f) + EPS);
          if (valid && !nl) { bf16_t* rp = RA + GL_ROW(ii) * 1024 + h * 128 + part * 32; const float* gp = p.gn + (size_t)l * 512 + h * 128 + part * 32;
#pragma unroll
              for (int q = 0; q < 4; ++q) { const u32x4 rw = rpre[q]; const f32x4 g0 = *(const f32x4*)(gp + 8 * q), g1 = *(const f32x4*)(gp + 8 * q + 4);
                  const float rf[8] = {bflo(rw.x), bfhi(rw.x), bflo(rw.y), bfhi(rw.y), bflo(rw.z), bfhi(rw.z), bflo(rw.w), bfhi(rw.w)}; float y[8];
#pragma unroll
                  for (int e = 0; e < 8; ++e) y[e] = ov[8 * q + e] * rs * ((e < 4) ? g0[e] : g1[e - 4]) * rf[e];
                  *(u32x4*)(rp + 8 * q) = (u32x4){pk(y[0], y[1]), pk(y[2], y[3]), pk(y[4], y[5]), pk(y[6], y[7])}; } } }
        __syncthreads();
    }
#undef GL_ROW
#undef GL_NUL
}
template <bool G3> __device__ __forceinline__ void gla_phase(const Params& p, int l, LAS unsigned char* lds, int bx, int G) {
    const int grp = __builtin_amdgcn_readfirstlane(mk_tid() >> 8);
    const int niter = (GLA_UNITS + 2 * G - 1) / (2 * G);
    for (int it = 0; it < niter; ++it) { int u = (it * G + bx) * 2 + grp; const bool valid = u < GLA_UNITS; if (!valid) u = GLA_UNITS - 1;
        gla_pair<G3>(p, l, u, valid, lds + grp * GL2_SZ); }
}

__device__ __forceinline__ void gla_pool(const Params& p, int l, LAS unsigned char* lds) {
    const int tid = mk_tid(), grp = __builtin_amdgcn_readfirstlane(tid >> 8);
    unsigned* ctr = (unsigned*)(p.ws + OFF_CTR) + l * 64; LAS unsigned* slot = (LAS unsigned*)(lds + 2 * GL2_SZ);
    for (;;) {
        if (tid == 0) *slot = atomicAdd(ctr, 1u);
        __syncthreads();
        const unsigned k = *slot;
        __syncthreads();
        if (k < (unsigned)(GLA_UNITS / 2)) { gla_pair<true>(p, l, (int)k * 2 + grp, true, lds + grp * GL2_SZ); continue; }
        const int j = (int)k - GLA_UNITS / 2;
        if (l + 1 >= DEPTH || j >= (CV_NIT + 7) / 8) break;
        { const int wid = __builtin_amdgcn_readfirstlane(tid >> 6), it = j * 8 + wid; if (it < CV_NIT) conv_one(p, l + 1, it, (LAS float*)(lds + wid * 8448), tid & 63); }
        __syncthreads();
    }
}

#define XB_TMO      128
#define XB_XCNT(j)  (256  + 64 * (j))
#define XB_XSUB(j)  (1280 + 64 * (j))
#define XB_XGEN(j)  (2304 + 64 * (j))
#define XB_TOP      3328
#define XB_TOPGEN   3392
#define XCD_BAR_WORDS 3456
#define XB_SPIN_CAP (1u << 18)

__device__ __forceinline__ unsigned xb_ld(unsigned* p)              { return __hip_atomic_load(p, __ATOMIC_RELAXED, __HIP_MEMORY_SCOPE_AGENT); }
__device__ __forceinline__ unsigned xb_add(unsigned* p, unsigned v) { return __hip_atomic_fetch_add(p, v, __ATOMIC_RELAXED, __HIP_MEMORY_SCOPE_AGENT); }
__device__ __forceinline__ unsigned xb_xcc_id() { return (unsigned)__builtin_amdgcn_s_getreg((3 << 11) | 20) & 0xFu; }
#define XB_SPIN(cond, bar) do { unsigned _sp = 0; while (cond) { __builtin_amdgcn_s_sleep(1); \
    if ((++_sp & 255u) == 0u) { if (xb_ld(&(bar)[XB_TMO])) break; if (_sp > XB_SPIN_CAP) { atomicAdd(&(bar)[XB_TMO], 1u); break; } } } } while (0)
struct XcdBarrier {
    unsigned* bar; unsigned x;
    volatile LAS unsigned* st;
};

__device__ __forceinline__ XcdBarrier xcd_barrier_post(unsigned* bar, volatile LAS unsigned* st) {
    XcdBarrier b; b.bar = bar; b.x = xb_xcc_id(); b.st = st;
    if (threadIdx.x == 0) (void)xb_add(&bar[XB_XCNT(b.x)], 1u);
    return b;
}
__device__ __forceinline__ void xcd_barrier_complete(unsigned* bar, unsigned x, unsigned& nloc, unsigned& nx) {
    const unsigned G = gridDim.x * gridDim.y * gridDim.z;
    unsigned sum, cnt, mine, sp = 0u;
    for (;;) {
        sum = 0u; cnt = 0u; mine = 0u;
#pragma unroll
        for (unsigned j = 0; j < 16; ++j) { const unsigned c = xb_ld(&bar[XB_XCNT(j)]); sum += c; cnt += (c > 0u) ? 1u : 0u; mine = (j == x) ? c : mine; }
        if (sum == G) break;
        __builtin_amdgcn_s_sleep(1);
        if ((++sp & 255u) == 0u) { if (xb_ld(&bar[XB_TMO])) break; if (sp > XB_SPIN_CAP) { atomicAdd(&bar[XB_TMO], 1u); break; } }
    }
    nloc = mine > 0u ? mine : 1u; nx = cnt > 0u ? cnt : 1u;
}

__device__ __forceinline__ void xcd_barrier(const XcdBarrier& b) {
    asm volatile("s_waitcnt vmcnt(0)" ::: "memory");
    __syncthreads();
    if (threadIdx.x == 0) {
        unsigned* bar = b.bar;
        __builtin_amdgcn_s_waitcnt(0);
        unsigned nloc = b.st[0], nx = b.st[1];
        if (nloc == 0u) { xcd_barrier_complete(bar, b.x, nloc, nx); b.st[0] = nloc; b.st[1] = nx; }
        const unsigned old = xb_add(&bar[XB_XSUB(b.x)], 1u);
        const unsigned gen = old / nloc;
        if (old + 1u == (gen + 1u) * nloc) {
            __builtin_amdgcn_fence(__ATOMIC_RELEASE, "agent");
            asm volatile("s_waitcnt vmcnt(0)" ::: "memory");
            const unsigned og = xb_add(&bar[XB_TOP], 1u);
            const unsigned tg = og / nx;
            if (og + 1u == (tg + 1u) * nx) xb_add(&bar[XB_TOPGEN], 1u);
            else XB_SPIN(xb_ld(&bar[XB_TOPGEN]) == tg, bar);
            __builtin_amdgcn_fence(__ATOMIC_ACQUIRE, "agent");
            xb_add(&bar[XB_XGEN(b.x)], 1u);
            asm volatile("s_waitcnt vmcnt(0)" ::: "memory");
        } else {
            XB_SPIN(xb_ld(&bar[XB_XGEN(b.x)]) == gen, bar);
            __builtin_amdgcn_fence(__ATOMIC_ACQUIRE, "agent");
            asm volatile("s_waitcnt vmcnt(0)" ::: "memory");
        }
    }
    __syncthreads();
}

__global__ void __launch_bounds__(512) mk_fwd(Params pin) {
    extern __shared__ __attribute__((aligned(16))) unsigned char lds_raw[];
    LAS unsigned char* lds = (LAS unsigned char*)lds_raw;
    cg::grid_group grid = cg::this_grid();
    const Params p0 = pin;
    volatile LAS unsigned* xst = (volatile LAS unsigned*)(lds + LDS_BYTES - 16);
    if (threadIdx.x < 2) xst[threadIdx.x] = 0u;
    __syncthreads();
    XcdBarrier xbar = xcd_barrier_post((unsigned*)(p0.ws + OFF_BAR), xst);
    if (p0.ph_hi < 0) grid.sync();
#ifdef MK_TIMING
    unsigned long long tA = 0, tB = 0, tprev = __builtin_amdgcn_s_memrealtime();
#endif
    for (int ph = p0.ph_lo; ph < p0.ph_hi; ++ph) {
        if (ph > p0.ph_lo) { long zb = 0; asm volatile("" : "+s"(zb)); XcdBarrier xb = xbar; xb.bar += zb; xcd_barrier(xb); }
#ifdef MK_TIMING
        if (ph > p0.ph_lo) { const unsigned long long tn = __builtin_amdgcn_s_memrealtime(); const int pp = ph - 1; const int ss = (pp == 0 || pp == NPH - 1) ? 11 : (pp - 1) % 10;
            if ((MK_TA >> ss) & 1) tA += tn - tprev; if ((MK_TB >> ss) & 1) tB += tn - tprev; tprev = tn; }
#endif
        long z = 0; asm volatile("" : "+s"(z));
        Params p = p0;
        p.x += z; p.meta += z; p.ng += z; p.wg += z; p.wu += z; p.wd += z; p.win += z; p.w2 += z; p.b2 += z; p.gn += z; p.qn += z; p.kn += z; p.wpa += z; p.wpb += z; p.bm += z; p.wout += z; p.fn += z; p.out += z; p.ws += z;
        const int tid = mk_tid();
        int G = gridDim.x, bx = blockIdx.x; asm volatile("" : "+s"(G), "+s"(bx));
        const int vcu = (G % 8 == 0) ? (bx % 8) * (G / 8) + bx / 8 : bx;
        const int lane = tid & 63, wid = __builtin_amdgcn_readfirstlane(tid >> 6);
        const int gw = bx * 8 + wid, ngw = G * 8, gt = bx * 512 + tid, ngt = G * 512;
        unsigned char* ws = p.ws;
        bf16_t* HB = (bf16_t*)(ws + OFF_H);
        float* SSQ = (float*)(ws + OFF_SSQ); bf16_t* HID = (bf16_t*)(ws + OFF_HID); bf16_t* Y = (bf16_t*)(ws + OFF_Y);
        if (PHON(11) && ph == 0) { prologue(p, gw, ngw, lane); conv_layer(p, 0, lds, gw, ngw, wid, lane); continue; }
        if (ph == NPH - 1) { final_norm(p, gw, ngw, lane); continue; }
        const int l = (ph - 1) / 10, s = (ph - 1) % 10;
        bf16_t* WT = (bf16_t*)((unsigned char*)p.out + OO_WT) + (size_t)(l & 1) * WT_END;
        if (PHON(0) && (s == 0 || s == 8)) {
            const int f = (s == 8);
            pg8::Gemm g{HB, WT + (f ? WT_GU1 : WT_GU0), MROWS, 5632, D, D}; MetaOrder S; S.init(5632, G, bx);
            EpiSwiglu E{HID, SSQ + (size_t)(3 * l + (f ? 2 : 0)) * MROWS * 16};
            pg8::gemm_phase<EpiSwiglu, MetaOrder, true, true>(lds, g, S, E);
        } else if (PHON(1) && (s == 1 || s == 7 || s == 9)) {
            pg8::Gemm g; float scale; int so;
            if (s == 1) { g = pg8::Gemm{HID, WT + WT_DN0, MROWS, D, DFF, DFF}; scale = 0.5f; so = 3 * l + 1; }
            else if (s == 9) { g = pg8::Gemm{HID, WT + WT_DN1, MROWS, D, DFF, DFF}; scale = 0.5f; so = 3 * l + 3; }
            else { g = pg8::Gemm{Y, WT + WT_OUT, MROWS, D, D, D}; scale = 1.0f; so = 3 * l + 2; }
            MetaOrder S; S.init(D, G, bx);
            EpiResid E{HB, SSQ + (size_t)so * MROWS * 16, scale};
            pg8::gemm_phase<EpiResid, MetaOrder, true, true>(lds, g, S, E);
        } else if (PHON(2) && s == 2) {
            pg8::Gemm g{HB, WT + WT_WIN, MROWS, WIN_N, D, D}; MetaOrder S; S.init(WIN_N, G, bx);
            EpiWin E{ws, SSQ + (size_t)(3 * l + 1) * MROWS * 16, p.bm + (size_t)l * 2048};
            pg8::gemm_phase<EpiWin, MetaOrder, true, true>(lds, g, S, E);
        } else if (PHON(3) && s == 3) {
            if (PHON(12)) prep_qk(p, l, gt, ngt);
            if (PHON(13)) gla_phase<false>(p, l, lds, bx, G);
        } else if (PHON(4) && s == 4) {
            if (PHON(15)) gla_scan(p, gt, ngt);
        } else if (PHON(5) && s == 5) {
            if (PHON(14)) attn_phase(p, l, lds, vcu, G);
            gla_pool(p, l, lds);
        } else if (PHON(6) && s == 6) {
            MetaOrder S; S.init(D, G, bx, 1);
            pg8::Gemm g{(const bf16_t*)(ws + OFF_RA), WT + WT_PA, MROWS, D, 1024, 512}; EpiMergeF E{Y, (const bf16_t*)(ws + OFF_GT)};
            pg8::gemm_phase<EpiMergeF, MetaOrder, true, true>(lds, g, S, E);
        }
    }
#ifdef MK_TIMING
    {
        unsigned* cnt = (unsigned*)(p0.ws + OFF_ROPE);
        grid.sync();
        if (blockIdx.x == 0 && threadIdx.x == 0) { *cnt = (unsigned)(tA * 10ull); __threadfence(); }
        grid.sync();
        const unsigned N = *(volatile unsigned*)cnt; float* o = p0.out;
        for (unsigned i = blockIdx.x * 512 + threadIdx.x; i < N; i += gridDim.x * 512) o[i] += 0.01f;
        if (blockIdx.x == 0 && threadIdx.x == 0) { const unsigned long long t0 = __builtin_amdgcn_s_memrealtime(); while (__builtin_amdgcn_s_memrealtime() - t0 < tB) __builtin_amdgcn_s_sleep(8); }
    }
#endif
}

extern "C" void kernel_launch(void* const* d_in, const int* in_sizes, int n_in, void* d_out, int out_size, void* d_ws, size_t ws_size, hipStream_t stream) {
    static int grid = 0;
    if (grid == 0) {
        if (n_in != 17 || in_sizes[0] != MX * D || out_size != MX * D || ws_size < WS_END) {
            fprintf(stderr, "kernel_launch: unexpected shapes (n_in %d, in0 %d, out %d, ws %zu, need %zu)\n", n_in, n_in > 0 ? in_sizes[0] : -1, out_size, ws_size, (size_t)WS_END); grid = -1; return; }
        int dev = 0, cus = 0, per_cu = 0;
        hipGetDevice(&dev); hipDeviceGetAttribute(&cus, hipDeviceAttributeMultiprocessorCount, dev);
        if (hipFuncSetAttribute((const void*)mk_fwd, hipFuncAttributeMaxDynamicSharedMemorySize, LDS_BYTES) != hipSuccess) { fprintf(stderr, "kernel_launch: hipFuncSetAttribute failed\n"); grid = -1; return; }
        if (hipOccupancyMaxActiveBlocksPerMultiprocessor(&per_cu, (const void*)mk_fwd, 512, LDS_BYTES) != hipSuccess || per_cu < 1) { fprintf(stderr, "kernel_launch: occupancy query says %d\n", per_cu); per_cu = 1; }
        (void)hipGetLastError();
        grid = cus;
    }
    if (grid < 0) return;
    Params p{};
    p.x = (const float*)d_in[0]; p.meta = (const float*)d_in[1]; p.ng = (const float*)d_in[2]; p.wg = (const float*)d_in[3]; p.wu = (const float*)d_in[4]; p.wd = (const float*)d_in[5];
    p.win = (const float*)d_in[6]; p.w2 = (const float*)d_in[7]; p.b2 = (const float*)d_in[8]; p.gn = (const float*)d_in[9]; p.qn = (const float*)d_in[10]; p.kn = (const float*)d_in[11];
    p.wpa = (const float*)d_in[12]; p.wpb = (const float*)d_in[13]; p.bm = (const float*)d_in[14]; p.wout = (const float*)d_in[15]; p.fn = (const float*)d_in[16];
    p.out = (float*)d_out; p.ws = (unsigned char*)d_ws;
    if (hipMemsetAsync((char*)d_ws + OFF_BAR, 0, 16384, stream) != hipSuccess) { fprintf(stderr, "kernel_launch: memset of the barrier words failed\n"); return; }
#if MK_SINGLE
    p.ph_lo = 0; p.ph_hi = NPH;
    { void* args[] = {&p}; hipError_t e = hipLaunchCooperativeKernel((const void*)mk_fwd, dim3(grid), dim3(512), args, LDS_BYTES, stream);
      if (e != hipSuccess) fprintf(stderr, "cooperative launch failed: %s\n", hipGetErrorString(e)); }
#else
    for (int ph = 0; ph < NPH; ++ph) { p.ph_lo = ph; p.ph_hi = ph + 1; void* args[] = {&p};
        hipError_t e = hipLaunchCooperativeKernel((const void*)mk_fwd, dim3(grid), dim3(512), args, LDS_BYTES, stream);
        if (e != hipSuccess) { fprintf(stderr, "cooperative launch %d failed: %s\n", ph, hipGetErrorString(e)); break; } }
#endif
}
```

```cpp
#include <hip/hip_runtime.h>
#include <hip/hip_cooperative_groups.h>
#include <cstdio>
#include <cstdint>
namespace cg = cooperative_groups;
__device__ __forceinline__ int mk_tid() { int t = threadIdx.x; asm volatile("" : "+v"(t)); return t; }
#define PG8_HALF_PM 128
namespace pg8 {
#define PG8_LAS __attribute__((address_space(3)))
typedef unsigned short bf16_t;
typedef short bf16x8 __attribute__((ext_vector_type(8)));
typedef float f32x4 __attribute__((ext_vector_type(4)));
typedef unsigned u32x4 __attribute__((ext_vector_type(4)));
constexpr int BM = 256, BK = 64, HALF = 128, HTB = HALF * BK * 2  , STAGE_BYTES = 8 * HTB, NXCD = 8, WGM = 8;

__host__ __device__ __forceinline__ int lds_byte(int r, int c) { const int st = (r >> 4) * 2 + (c >> 5), rr = r & 15, cc = c & 31, ob = rr * 64 + cc * 2; return st * 1024 + (ob ^ (((ob >> 9) & 1) << 5)); }
__host__ __device__ __forceinline__ void stage_rc(int b, int& R, int& C) { const int st = b / 1024, sb = b % 1024, swz = sb ^ (((sb >> 9) & 1) << 5); R = (st >> 1) * 16 + swz / 64; C = (st & 1) * 32 + (swz % 64) / 2; }
__host__ __device__ __forceinline__ int perm32(int rho) { const int n = rho >> 4, i = rho & 15; return 8 * (i >> 2) + 4 * n + (i & 3); }

struct Unit { int pm, pn, kh; };
struct Gemm { const bf16_t* A; const bf16_t* Bt; int M, N, K, KL; };

struct StaticOrder {
    int nM, nN, nwg, G, c;
    __host__ __device__ void init(int M, int N, int G_, int c_) { nM = M / BM; nN = N / BM; nwg = nM * nN; G = G_; c = c_; }
    __host__ __device__ bool next(int i, Unit& u) const {
        const long L = (long)i * G + c; if (L >= nwg) return false;
        int wgid = (int)L; { const int q = nwg / NXCD, r = nwg % NXCD, xcd = wgid % NXCD, off = wgid / NXCD; wgid = (xcd < r ? xcd * (q + 1) : r * (q + 1) + (xcd - r) * q) + off; }
        const int nig = WGM * nN, gid = wgid / nig, fm = gid * WGM, gsz = (nM - fm) < WGM ? (nM - fm) : WGM;
        u.pm = fm + ((wgid % nig) % gsz); u.pn = (wgid % nig) / gsz; u.kh = 0; return true;
    }
    __device__ __forceinline__ void a_ready(const Unit&) const {}
    __device__ __forceinline__ void done(const Unit&) const {}
};

__device__ __forceinline__ unsigned cvt_pk_bf16(float lo, float hi) { unsigned r; asm volatile("v_cvt_pk_bf16_f32 %0, %1, %2" : "=v"(r) : "v"(lo), "v"(hi)); return r; }
typedef float f32x2 __attribute__((ext_vector_type(2)));
template <class Epi, class Sched, bool ALIGN_EPI = false, bool SP2 = false>
__device__ __forceinline__ void gemm_phase(PG8_LAS unsigned char* lds, const Gemm g, const Sched& S, const Epi& E) {
    const int tid = mk_tid(), wid = __builtin_amdgcn_readfirstlane(tid >> 6), lane = tid & 63, wr = wid >> 2, wc = wid & 3, fr = lane & 15, fq = lane >> 4;
    const int K = g.K, nt = g.KL / BK;
    unsigned voffA[2], voffB[2];
#pragma unroll
    for (int i = 0; i < 2; ++i) { int R, C; stage_rc(tid * 16 + i * 8192, R, C); const int Rb = Epi::PERM ? ((R & ~31) + perm32(R & 31)) : R;
        voffA[i] = (unsigned)(R * K + C) * 2u; voffB[i] = (unsigned)(Rb * K + C) * 2u; }
    const size_t kstep = (size_t)(BK * 2);
    const size_t hstep = (size_t)HALF * K * 2;
    const size_t tstep = 2 * hstep;
    const unsigned ldsw = (unsigned)wid * 1024u;
    const int aoff = lds_byte(wr * 64 + fr, fq * 8), boff = lds_byte(wc * 32 + fr, fq * 8);
#define PG8_SA(b, h) (((b) * 2 + (h)) * HTB)
#define PG8_SB(b, h) ((4 + (b) * 2 + (h)) * HTB)
#define PG8_STAGE(bufoff, gbase, voff) do { _Pragma("unroll") for (int _i = 0; _i < 2; ++_i) \
        __builtin_amdgcn_global_load_lds((const unsigned*)((const char*)(gbase) + (voff)[_i]), (PG8_LAS unsigned*)(lds + (bufoff) + ldsw + _i * 8192), 16, 0, 0); } while (0)
#define PG8_LDA(dst, b, h) do { _Pragma("unroll") for (int m = 0; m < 4; ++m) _Pragma("unroll") for (int k = 0; k < 2; ++k) dst[m][k] = *(const PG8_LAS bf16x8*)(lds + PG8_SA(b, h) + aoff + m * 2048 + k * 1024); } while (0)
#define PG8_LDB(dst, b, h) do { _Pragma("unroll") for (int n = 0; n < 2; ++n) _Pragma("unroll") for (int k = 0; k < 2; ++k) dst[n][k] = *(const PG8_LAS bf16x8*)(lds + PG8_SB(b, h) + boff + n * 2048 + k * 1024); } while (0)
#define PG8_MMA(ai, bj, At, Bt) do { __builtin_amdgcn_s_setprio(1); _Pragma("unroll") for (int m = 0; m < 4; ++m) _Pragma("unroll") for (int n = 0; n < 2; ++n) _Pragma("unroll") for (int k = 0; k < 2; ++k) \
        acc[ai][bj][m][n] = __builtin_amdgcn_mfma_f32_16x16x32_bf16(Bt[n][k], At[m][k], acc[ai][bj][m][n], 0, 0, 0); __builtin_amdgcn_s_setprio(0); } while (0)
#define PG8_WAIT_V(n) asm volatile("s_waitcnt vmcnt(" #n ")" ::: "memory")
#define PG8_WAIT_L(n) asm volatile("s_waitcnt lgkmcnt(" #n ")" ::: "memory")
#define PG8_BAR __builtin_amdgcn_s_barrier()
#define PG8_SCHED __builtin_amdgcn_sched_barrier(0)
    Unit cur, nxt; int ui = 0;
    if (!S.next(0, cur)) return;
    f32x4 acc[2][2][4][2];
#pragma unroll
    for (int a = 0; a < 2; ++a)
#pragma unroll
        for (int b = 0; b < 2; ++b)
#pragma unroll
            for (int m = 0; m < 4; ++m)
#pragma unroll
                for (int n = 0; n < 2; ++n) acc[a][b][m][n] = (f32x4){0.f, 0.f, 0.f, 0.f};
    bf16x8 At[4][2], B0[2][2], B1[2][2];
    const size_t khb = (size_t)g.KL * 2;
    const char* cA = (const char*)g.A + (size_t)cur.pm * tstep + cur.kh * khb; const char* cB = (const char*)g.Bt + (size_t)cur.pn * tstep + cur.kh * khb;
    S.a_ready(cur);
    if constexpr (SP2) {
        PG8_STAGE(PG8_SB(0, 0), cB, voffB); PG8_STAGE(PG8_SB(0, 1), cB + hstep, voffB); PG8_STAGE(PG8_SA(0, 0), cA, voffA); PG8_STAGE(PG8_SA(0, 1), cA + hstep, voffA);
        if (wr == 1) PG8_BAR;
        PG8_WAIT_V(2); PG8_BAR;
        PG8_STAGE(PG8_SB(1, 0), cB + kstep, voffB); PG8_STAGE(PG8_SA(1, 0), cA + kstep, voffA); PG8_STAGE(PG8_SB(1, 1), cB + hstep + kstep, voffB);
        PG8_WAIT_V(6); PG8_BAR;
    } else {
        PG8_STAGE(PG8_SB(0, 0), cB, voffB); PG8_STAGE(PG8_SA(0, 0), cA, voffA); PG8_STAGE(PG8_SB(0, 1), cB + hstep, voffB); PG8_STAGE(PG8_SA(0, 1), cA + hstep, voffA);
        if (wr == 1) PG8_BAR;
        PG8_WAIT_V(4); PG8_BAR;
        PG8_STAGE(PG8_SB(1, 0), cB + kstep, voffB); PG8_STAGE(PG8_SA(1, 0), cA + kstep, voffA); PG8_STAGE(PG8_SB(1, 1), cB + hstep + kstep, voffB);
        PG8_WAIT_V(6); PG8_BAR;
    }
    for (;;) {
        const bool has_next = S.next(ui + 1, nxt);
        const bool full_unit = (cur.pm != PG8_HALF_PM);
        const char* nA = has_next ? (const char*)g.A + (size_t)nxt.pm * tstep + nxt.kh * khb : cA; const char* nB = has_next ? (const char*)g.Bt + (size_t)nxt.pn * tstep + nxt.kh * khb : cB;
        for (int t = 0; t < nt; t += 2) {
            const bool last = (t == nt - 2);
            const char* a1 = cA + (size_t)(t + 1) * kstep;
            const char* a2 = last ? nA : cA + (size_t)(t + 2) * kstep; const char* b2 = last ? nB : cB + (size_t)(t + 2) * kstep;
            const char* a3 = a2 + kstep; const char* b3 = b2 + kstep;
            if (last && has_next) S.a_ready(nxt);
            if constexpr (SP2) {
            PG8_LDB(B0, 0, 0); PG8_LDB(B1, 0, 1); PG8_SCHED; PG8_LDA(At, 0, 0); PG8_STAGE(PG8_SA(1, 1), a1 + hstep, voffA);
            PG8_WAIT_V(8); PG8_WAIT_L(0); PG8_BAR; PG8_MMA(0, 0, At, B0); PG8_MMA(0, 1, At, B1); PG8_BAR; PG8_SCHED;
            PG8_LDA(At, 0, 1); PG8_STAGE(PG8_SB(0, 0), b2, voffB); PG8_STAGE(PG8_SB(0, 1), b2 + hstep, voffB); PG8_STAGE(PG8_SA(0, 0), a2, voffA);
            PG8_WAIT_V(8); PG8_WAIT_L(0); PG8_BAR; if (full_unit) { PG8_MMA(1, 0, At, B0); PG8_MMA(1, 1, At, B1); } PG8_BAR; PG8_SCHED;
            PG8_LDB(B0, 1, 0); PG8_LDB(B1, 1, 1); PG8_SCHED; PG8_LDA(At, 1, 0); PG8_STAGE(PG8_SA(0, 1), a2 + hstep, voffA);
            PG8_WAIT_V(8); PG8_WAIT_L(0); PG8_BAR; PG8_MMA(0, 0, At, B0); PG8_MMA(0, 1, At, B1); PG8_BAR; PG8_SCHED;
            PG8_LDA(At, 1, 1); PG8_STAGE(PG8_SB(1, 0), b3, voffB); PG8_STAGE(PG8_SB(1, 1), b3 + hstep, voffB); PG8_STAGE(PG8_SA(1, 0), a3, voffA);
            PG8_WAIT_V(8); PG8_WAIT_L(0); PG8_BAR; if (full_unit) { PG8_MMA(1, 0, At, B0); PG8_MMA(1, 1, At, B1); } PG8_BAR; PG8_SCHED;
            } else {
            PG8_LDB(B0, 0, 0); PG8_SCHED; PG8_LDA(At, 0, 0); PG8_STAGE(PG8_SA(1, 1), a1 + hstep, voffA);
            PG8_WAIT_L(8); PG8_BAR; PG8_WAIT_L(0); PG8_MMA(0, 0, At, B0); PG8_BAR; PG8_SCHED;
            PG8_LDB(B1, 0, 1); PG8_STAGE(PG8_SB(0, 0), b2, voffB);
            PG8_BAR; PG8_WAIT_L(0); PG8_MMA(0, 1, At, B1); PG8_BAR;
            PG8_LDA(At, 0, 1); PG8_STAGE(PG8_SA(0, 0), a2, voffA);
            PG8_BAR; PG8_WAIT_L(0); PG8_MMA(1, 0, At, B0); PG8_BAR; PG8_SCHED;
            PG8_STAGE(PG8_SB(0, 1), b2 + hstep, voffB);
            PG8_WAIT_V(6); PG8_BAR; PG8_MMA(1, 1, At, B1); PG8_BAR;
            PG8_LDB(B0, 1, 0); PG8_SCHED; PG8_LDA(At, 1, 0); PG8_STAGE(PG8_SA(0, 1), a2 + hstep, voffA);
            PG8_WAIT_L(8); PG8_BAR; PG8_WAIT_L(0); PG8_MMA(0, 0, At, B0); PG8_BAR; PG8_SCHED;
            PG8_LDB(B1, 1, 1); PG8_STAGE(PG8_SB(1, 0), b3, voffB);
            PG8_BAR; PG8_WAIT_L(0); PG8_MMA(0, 1, At, B1); PG8_BAR;
            PG8_LDA(At, 1, 1); PG8_STAGE(PG8_SA(1, 0), a3, voffA);
            PG8_BAR; PG8_WAIT_L(0); PG8_MMA(1, 0, At, B0); PG8_BAR; PG8_SCHED;
            PG8_STAGE(PG8_SB(1, 1), b3 + hstep, voffB);
            PG8_WAIT_V(6); PG8_BAR; PG8_MMA(1, 1, At, B1); PG8_BAR;
            }
        }
        if constexpr (ALIGN_EPI) { if (wr == 0) PG8_BAR; }
        bool keep_acc = false;
        if constexpr (Epi::MIDK) { if (cur.kh == 0) { E.mid(acc, cur, wr, wc, fr, fq); keep_acc = true; } }
        if constexpr (!Epi::AFTER_DRAIN) { if (!keep_acc) { E(acc, cur, wr, wc, fr, fq); S.done(cur); } }
        if (!has_next) break;
        if (!keep_acc)
#pragma unroll
        for (int a = 0; a < 2; ++a)
#pragma unroll
            for (int b = 0; b < 2; ++b)
#pragma unroll
                for (int m = 0; m < 4; ++m)
#pragma unroll
                    for (int n = 0; n < 2; ++n) acc[a][b][m][n] = (f32x4){0.f, 0.f, 0.f, 0.f};
        cur = nxt; cA = nA; cB = nB; ++ui;
        if constexpr (ALIGN_EPI) { if (wr == 1) PG8_BAR; }
    }
    PG8_WAIT_V(0);
    if constexpr (!ALIGN_EPI) { if (wr == 0) PG8_BAR; }
    PG8_BAR;
    if constexpr (Epi::AFTER_DRAIN) { E.fused(acc, cur, wr, wc, fr, fq, lds, wid, lane); S.done(cur); }
#undef PG8_SA
#undef PG8_SB
#undef PG8_STAGE
#undef PG8_LDA
#undef PG8_LDB
#undef PG8_MMA
#undef PG8_WAIT_V
#undef PG8_WAIT_L
#undef PG8_BAR
#undef PG8_SCHED
}
}
#ifndef PH_MASK
#define PH_MASK 0xffff
#endif
#define PHON(k) ((PH_MASK >> (k)) & 1)
#ifndef MK_SINGLE
#define MK_SINGLE 1
#endif
#define LAS __attribute__((address_space(3)))
typedef unsigned short bf16_t;
typedef short bf16x8 __attribute__((ext_vector_type(8)));
typedef float f32x4 __attribute__((ext_vector_type(4)));
typedef float f32x16 __attribute__((ext_vector_type(16)));
typedef unsigned u32x4 __attribute__((ext_vector_type(4)));
typedef unsigned u32x2 __attribute__((ext_vector_type(2)));

constexpr int D = 1024, NB = 8, SEQ = 4096, DEPTH = 4, NMETA = 16, DFF = 2816, DIN = 4384;
constexpr int MX = NB * SEQ;
constexpr int MROWS = MX + 256;
constexpr int NVALID = MX + NB * NMETA;
constexpr int LP = 4160;
constexpr int NCH = 65;
constexpr float EPS = 1e-6f;
constexpr float LOG2E = 1.4426950408889634f;
constexpr int WIN_N = 4608;
constexpr int NPH = 42;

constexpr size_t SZ_H = (size_t)MROWS * D * 4, SZ_512 = (size_t)MROWS * 512 * 2, SZ_128 = (size_t)MROWS * 128 * 2;
constexpr size_t SZ_VT = (size_t)NB * 2 * 64 * LP * 2, SZ_LR = (size_t)MROWS * 32 * 4, SZ_GT = (size_t)MROWS * 2048 * 2;
constexpr size_t OFF_H = 0;
constexpr size_t OFF_QKA = OFF_H + SZ_H, OFF_VA = OFF_QKA + SZ_512, OFF_RA = OFF_VA + SZ_512, OFF_QB = OFF_RA + SZ_512;
constexpr size_t OFF_KB = OFF_QB + SZ_512, OFF_VT = OFF_KB + SZ_128, OFF_LR = OFF_VT + SZ_VT, OFF_GT = OFF_LR + SZ_LR, R_END = OFF_GT + SZ_GT;
constexpr size_t OFF_HID = OFF_QKA;
constexpr size_t OFF_Y = OFF_QKA;
static_assert((size_t)MROWS * DFF * 2 <= R_END - OFF_QKA, "hid overlay");
constexpr size_t SZ_S = (size_t)64 * NCH * 8192 * 2, SZ_DEC = (size_t)64 * NCH * 64 * 4, SZ_SSQ = (size_t)13 * MROWS * 16 * 4, SZ_ROPE = (size_t)SEQ * 64 * 4;
constexpr size_t OFF_S = R_END, OFF_DEC = OFF_S + SZ_S, OFF_SSQ = OFF_DEC + SZ_DEC, OFF_ROPE = OFF_SSQ + SZ_SSQ, OFF_CTR = OFF_ROPE + SZ_ROPE, OFF_BAR = OFF_CTR + 4096, WS_END = OFF_BAR + 16384;
constexpr size_t OO_WT = 0;
constexpr size_t WT_GU0 = 0, WT_DN0 = WT_GU0 + (size_t)5632 * 1024, WT_WIN = WT_DN0 + (size_t)1024 * 2816, WT_PA = WT_WIN + (size_t)WIN_N * 1024,
                 WT_PB = WT_PA + (size_t)1024 * 512, WT_OUT = WT_PB + (size_t)1024 * 512, WT_GU1 = WT_OUT + (size_t)1024 * 1024, WT_DN1 = WT_GU1 + (size_t)5632 * 1024,
                 WT_END = WT_DN1 + (size_t)1024 * 2816;
static_assert(OO_WT + 2 * WT_END * 2 <= (size_t)MX * D * 4, "d_out scratch");

constexpr int LDS_BYTES = 147456;

struct Params {
    const float *x, *meta, *ng, *wg, *wu, *wd, *win, *w2, *b2, *gn, *qn, *kn, *wpa, *wpb, *bm, *wout, *fn;
    float* out; unsigned char* ws; int ph_lo, ph_hi;
};

typedef float f32x2_t __attribute__((ext_vector_type(2))); typedef __bf16 bf16x2_t __attribute__((ext_vector_type(2)));
__device__ __forceinline__ unsigned pk(float lo, float hi) { f32x2_t v = {lo, hi}; bf16x2_t b = __builtin_convertvector(v, bf16x2_t); return __builtin_bit_cast(unsigned, b); }
__device__ __forceinline__ float bflo(unsigned w) { return __uint_as_float(w << 16); }
__device__ __forceinline__ float bfhi(unsigned w) { return __uint_as_float(w & 0xffff0000u); }
__device__ __forceinline__ float bf1(unsigned short b) { return __uint_as_float((unsigned)b << 16); }
__device__ __forceinline__ unsigned short f2bf(float f) { return (unsigned short)(pk(f, 0.f) & 0xffffu); }
__device__ __forceinline__ float fexp(float x) { return __builtin_amdgcn_exp2f(x * LOG2E); }
__device__ __forceinline__ float sigm(float x) { return __builtin_amdgcn_rcpf(1.f + fexp(-x)); }
__device__ __forceinline__ float siluf(float x) { return x * sigm(x); }
__device__ __forceinline__ float rstd_row(const float* ssq, int row) {
    const f32x4* q = (const f32x4*)(ssq + (size_t)row * 16); const f32x4 a = q[0], b = q[1], c = q[2], d = q[3];
    const float t = ((a[0] + a[1]) + (a[2] + a[3])) + ((b[0] + b[1]) + (b[2] + b[3])) + ((c[0] + c[1]) + (c[2] + c[3])) + ((d[0] + d[1]) + (d[2] + d[3]));
    return __builtin_amdgcn_rsqf(t * (1.0f / D) + EPS); }
#define LDS_WAIT() asm volatile("s_waitcnt lgkmcnt(0)" ::: "memory")
#define DPPF(old, src, ctrl, rmask, bmask, bc) __builtin_bit_cast(float, __builtin_amdgcn_update_dpp(__builtin_bit_cast(int, (float)(old)), __builtin_bit_cast(int, (float)(src)), ctrl, rmask, bmask, bc))
__device__ __forceinline__ float wave_incl_scan(float v) {
    v += DPPF(0.f, v, 0x111, 0xf, 0xf, true); v += DPPF(0.f, v, 0x112, 0xf, 0xf, true); v += DPPF(0.f, v, 0x114, 0xf, 0xf, true); v += DPPF(0.f, v, 0x118, 0xf, 0xf, true);
    v += DPPF(0.f, v, 0x142, 0xa, 0xf, false); v += DPPF(0.f, v, 0x143, 0xc, 0xf, false); return v; }
__device__ __forceinline__ float lane_bcast(float v, int l) { return __builtin_bit_cast(float, __builtin_amdgcn_readlane(__builtin_bit_cast(int, v), l)); }

struct MetaOrder {
    pg8::StaticOrder main; int nN, c, G, nmain, dbl;
    __device__ __forceinline__ void init(int N, int G_, int c_, int dbl_ = 0) { main.init(MX, N, G_, c_); nN = N / 256; c = c_; G = G_; dbl = dbl_; const int nw = 128 * nN; nmain = (c_ < nw) ? (nw - c_ + G_ - 1) / G_ : 0; }
    __device__ __forceinline__ bool next(int ii, pg8::Unit& u) const {
        const int i = dbl ? (ii >> 1) : ii, kh = dbl ? (ii & 1) : 0;
        if (i < nmain) { const bool ok = main.next(i, u); u.kh = kh; return ok; }
        const int j = (i - nmain) * G + c; if (j >= nN) return false;
        u.pm = PG8_HALF_PM; u.pn = j; u.kh = kh; return true; }
    __device__ __forceinline__ void a_ready(const pg8::Unit&) const {}
    __device__ __forceinline__ void done(const pg8::Unit&) const {}
};

struct EpiSwiglu {
    static constexpr bool PERM = true, AFTER_DRAIN = false, MIDK = false;
    bf16_t* O; const float* ssq;
    __device__ __forceinline__ void operator()(const f32x4 (&acc)[2][2][4][2], const pg8::Unit& u, int wr, int wc, int fr, int fq) const {
        int row0 = u.pm * 256 + wr * 64 + fr; asm volatile("" : "+v"(row0)); const int col0 = u.pn * 128 + wc * 32 + 8 * fq;
#pragma unroll
        for (int ai = 0; ai < 2; ++ai)
#pragma unroll
            for (int m = 0; m < 4; ++m) {
                if (ai == 1 && u.pm == PG8_HALF_PM) continue;
                const int row = row0 + ai * 128 + m * 16; const float rs = rstd_row(ssq, row);
                float h[8];
#pragma unroll
                for (int n = 0; n < 2; ++n)
#pragma unroll
                    for (int e = 0; e < 4; ++e) { const float g = acc[ai][0][m][n][e] * rs, up = acc[ai][1][m][n][e] * rs; h[n * 4 + e] = siluf(g) * up; }
                u32x4 w; w.x = pk(h[0], h[1]); w.y = pk(h[2], h[3]); w.z = pk(h[4], h[5]); w.w = pk(h[6], h[7]);
                *(u32x4*)(O + (size_t)row * DFF + col0) = w;
                asm volatile("" ::: "memory");
            }
    }
};
struct EpiResid {
    static constexpr bool PERM = true, AFTER_DRAIN = false, MIDK = false;
    bf16_t* HB; float* ssq_out; float scale;
    __device__ __forceinline__ void operator()(const f32x4 (&acc)[2][2][4][2], const pg8::Unit& u, int wr, int wc, int fr, int fq) const {
        int row0 = u.pm * 256 + wr * 64 + fr; asm volatile("" : "+v"(row0)); const int col0 = u.pn * 256 + wc * 32 + 8 * fq;
#pragma unroll
        for (int ai = 0; ai < 2; ++ai)
#pragma unroll
            for (int m = 0; m < 4; ++m) {
                if (ai == 1 && u.pm == PG8_HALF_PM) continue;
                const int row = row0 + ai * 128 + m * 16; float ss = 0.f;
#pragma unroll
                for (int bj = 0; bj < 2; ++bj) {
                    bf16_t* hp = HB + (size_t)row * D + col0 + bj * 128;
                    const u32x4 hw = *(const u32x4*)hp;
                    f32x4 h0 = (f32x4){bflo(hw.x), bfhi(hw.x), bflo(hw.y), bfhi(hw.y)}, h1 = (f32x4){bflo(hw.z), bfhi(hw.z), bflo(hw.w), bfhi(hw.w)};
                    h0 = h0 + acc[ai][bj][m][0] * scale; h1 = h1 + acc[ai][bj][m][1] * scale;
                    u32x4 w; w.x = pk(h0[0], h0[1]); w.y = pk(h0[2], h0[3]); w.z = pk(h1[0], h1[1]); w.w = pk(h1[2], h1[3]);
                    *(u32x4*)hp = w;
                    ss += (h0[0] * h0[0] + h0[1] * h0[1]) + (h0[2] * h0[2] + h0[3] * h0[3]) + (h1[0] * h1[0] + h1[1] * h1[1]) + (h1[2] * h1[2] + h1[3] * h1[3]);
                }
                ss += __shfl_xor(ss, 16); ss += __shfl_xor(ss, 32);
                if (fq == 0) ssq_out[(size_t)row * 16 + u.pn * 4 + wc] = ss;
                asm volatile("" ::: "memory");
            }
    }
};
struct EpiWin {
    static constexpr bool PERM = true, AFTER_DRAIN = false, MIDK = false;
    unsigned char* ws; const float* ssq; const float* bm;
    __device__ __forceinline__ void operator()(const f32x4 (&acc)[2][2][4][2], const pg8::Unit& u, int wr, int wc, int fr, int fq) const {
        int row0 = u.pm * 256 + wr * 64 + fr; asm volatile("" : "+v"(row0)); const int cw = wc * 32 + 8 * fq, pn = u.pn;
#pragma unroll
        for (int ai = 0; ai < 2; ++ai)
#pragma unroll
            for (int m = 0; m < 4; ++m) {
                if (ai == 1 && u.pm == PG8_HALF_PM) continue;
                const int row = row0 + ai * 128 + m * 16; const float rs = rstd_row(ssq, row);
                if (pn < 8) {
                    bf16_t* base = (pn < 4) ? (bf16_t*)(ws + OFF_QKA + (size_t)(pn >> 1) * SZ_512) + (size_t)row * 512 + (pn & 1) * 256 + cw
                                            : (bf16_t*)(ws + OFF_RA) + (size_t)row * 1024 + (pn - 4) * 256 + cw;
                    const float sc = (pn == 0) ? rs * 0.125f : rs; const bool gate = (pn == 4 || pn == 5);
#pragma unroll
                    for (int bj = 0; bj < 2; ++bj) { f32x4 a = acc[ai][bj][m][0] * sc, b = acc[ai][bj][m][1] * sc;
                        if (gate) { a = (f32x4){siluf(a[0]), siluf(a[1]), siluf(a[2]), siluf(a[3])}; b = (f32x4){siluf(b[0]), siluf(b[1]), siluf(b[2]), siluf(b[3])}; }
                        u32x4 w; w.x = pk(a[0], a[1]); w.y = pk(a[2], a[3]); w.z = pk(b[0], b[1]); w.w = pk(b[2], b[3]); *(u32x4*)(base + bj * 128) = w; }
                } else if (pn == 8) {
                    { const f32x4 a = acc[ai][0][m][0] * rs, b = acc[ai][0][m][1] * rs;
                      u32x4 w; w.x = pk(a[0], a[1]); w.y = pk(a[2], a[3]); w.z = pk(b[0], b[1]); w.w = pk(b[2], b[3]); *(u32x4*)((bf16_t*)(ws + OFF_KB) + (size_t)row * 128 + cw) = w; }
                    if (row < NVALID) {
                        int bb, pos; if (row < MX) { bb = row >> 12; pos = 64 + (row & 4095); } else { bb = (row - MX) >> 4; pos = 48 + ((row - MX) & 15); }
                        const int kvh = cw >> 6, d0 = cw & 63;
                        bf16_t* vt = (bf16_t*)(ws + OFF_VT) + ((size_t)(bb * 2 + kvh) * 64 + d0) * LP + pos;
#pragma unroll
                        for (int n = 0; n < 2; ++n)
#pragma unroll
                            for (int e = 0; e < 4; ++e) vt[(size_t)(n * 4 + e) * LP] = f2bf(acc[ai][1][m][n][e] * rs);
                    }
                } else if (pn == 9) {
                    if (wc == 0) { float* lp = (float*)(ws + OFF_LR) + (size_t)row * 32 + 8 * fq; *(f32x4*)lp = acc[ai][0][m][0] * rs; *(f32x4*)(lp + 4) = acc[ai][0][m][1] * rs; }
                } else {
                    const int gc = (pn - 10) * 256 + cw; bf16_t* base = (bf16_t*)(ws + OFF_GT) + (size_t)row * 2048 + gc;
#pragma unroll
                    for (int bj = 0; bj < 2; ++bj) { const f32x4 b0 = *(const f32x4*)(bm + gc + bj * 128), b1 = *(const f32x4*)(bm + gc + bj * 128 + 4);
                        const f32x4 a = acc[ai][bj][m][0] * rs + b0, b = acc[ai][bj][m][1] * rs + b1;
                        u32x4 w; w.x = pk(sigm(a[0]), sigm(a[1])); w.y = pk(sigm(a[2]), sigm(a[3])); w.z = pk(sigm(b[0]), sigm(b[1])); w.w = pk(sigm(b[2]), sigm(b[3])); *(u32x4*)(base + bj * 128) = w; }
                }
                asm volatile("" ::: "memory");
            }
    }
};
struct EpiMergeF {
    static constexpr bool PERM = true, AFTER_DRAIN = false, MIDK = true;
    bf16_t* Y; const bf16_t* G;
    __device__ __forceinline__ void mid(f32x4 (&acc)[2][2][4][2], const pg8::Unit& u, int wr, int wc, int fr, int fq) const {
        int row0 = u.pm * 256 + wr * 64 + fr; asm volatile("" : "+v"(row0)); const int col0 = u.pn * 256 + wc * 32 + 8 * fq;
#pragma unroll
        for (int ai = 0; ai < 2; ++ai)
#pragma unroll
            for (int m = 0; m < 4; ++m) {
                if (ai == 1 && u.pm == PG8_HALF_PM) continue;
                const int row = row0 + ai * 128 + m * 16;
#pragma unroll
                for (int bj = 0; bj < 2; ++bj) { const int col = col0 + bj * 128;
                    const u32x4 ga = *(const u32x4*)(G + (size_t)row * 2048 + col), gb = *(const u32x4*)(G + (size_t)row * 2048 + 1024 + col);
                    f32x4 r0, r1;
                    r0[0] = bflo(ga.x) * __builtin_amdgcn_rcpf(bflo(gb.x)); r0[1] = bfhi(ga.x) * __builtin_amdgcn_rcpf(bfhi(gb.x)); r0[2] = bflo(ga.y) * __builtin_amdgcn_rcpf(bflo(gb.y)); r0[3] = bfhi(ga.y) * __builtin_amdgcn_rcpf(bfhi(gb.y));
                    r1[0] = bflo(ga.z) * __builtin_amdgcn_rcpf(bflo(gb.z)); r1[1] = bfhi(ga.z) * __builtin_amdgcn_rcpf(bfhi(gb.z)); r1[2] = bflo(ga.w) * __builtin_amdgcn_rcpf(bflo(gb.w)); r1[3] = bfhi(ga.w) * __builtin_amdgcn_rcpf(bfhi(gb.w));
                    acc[ai][bj][m][0] = acc[ai][bj][m][0] * r0; acc[ai][bj][m][1] = acc[ai][bj][m][1] * r1;
                }
                asm volatile("" ::: "memory");
            }
    }
    __device__ __forceinline__ void operator()(const f32x4 (&acc)[2][2][4][2], const pg8::Unit& u, int wr, int wc, int fr, int fq) const {
        int row0 = u.pm * 256 + wr * 64 + fr; asm volatile("" : "+v"(row0)); const int col0 = u.pn * 256 + wc * 32 + 8 * fq;
#pragma unroll
        for (int ai = 0; ai < 2; ++ai)
#pragma unroll
            for (int m = 0; m < 4; ++m) {
                if (ai == 1 && u.pm == PG8_HALF_PM) continue;
                const int row = row0 + ai * 128 + m * 16;
#pragma unroll
                for (int bj = 0; bj < 2; ++bj) { const int col = col0 + bj * 128;
                    const u32x4 gb = *(const u32x4*)(G + (size_t)row * 2048 + 1024 + col);
                    float v[8];
                    v[0] = bflo(gb.x) * acc[ai][bj][m][0][0]; v[1] = bfhi(gb.x) * acc[ai][bj][m][0][1]; v[2] = bflo(gb.y) * acc[ai][bj][m][0][2]; v[3] = bfhi(gb.y) * acc[ai][bj][m][0][3];
                    v[4] = bflo(gb.z) * acc[ai][bj][m][1][0]; v[5] = bfhi(gb.z) * acc[ai][bj][m][1][1]; v[6] = bflo(gb.w) * acc[ai][bj][m][1][2]; v[7] = bfhi(gb.w) * acc[ai][bj][m][1][3];
                    u32x4 w; w.x = pk(v[0], v[1]); w.y = pk(v[2], v[3]); w.z = pk(v[4], v[5]); w.w = pk(v[6], v[7]); *(u32x4*)(Y + (size_t)row * D + col) = w;
                }
                asm volatile("" ::: "memory");
            }
    }
};

__device__ __forceinline__ void conv_item(const float* W, int N, int K, int src_n0, const float* gain, bf16_t* WT, int n0, int k0, LAS float* scr, int lane, int dk = 0) {
#pragma unroll
    for (int i = 0; i < 8; ++i) { const int kk = 8 * i + (lane >> 3), n4 = (lane & 7) * 4; f32x4 v = (f32x4){0.f, 0.f, 0.f, 0.f};
        if (src_n0 >= 0) { v = *(const f32x4*)(W + (size_t)(k0 + kk) * N + src_n0 + n4); if (gain) v = v * gain[k0 + kk]; }
        scr[kk * 33 + n4] = v[0]; scr[kk * 33 + n4 + 1] = v[1]; scr[kk * 33 + n4 + 2] = v[2]; scr[kk * 33 + n4 + 3] = v[3]; }
    LDS_WAIT(); __builtin_amdgcn_wave_barrier();
    const int c = lane & 7;
#pragma unroll
    for (int j = 0; j < 4; ++j) { const int n = (lane >> 3) + 8 * j; const LAS float* s = scr + (8 * c) * 33 + n;
        u32x4 o; o.x = pk(s[0 * 33], s[1 * 33]); o.y = pk(s[2 * 33], s[3 * 33]); o.z = pk(s[4 * 33], s[5 * 33]); o.w = pk(s[6 * 33], s[7 * 33]);
        *(u32x4*)(WT + (size_t)(n0 + n) * K + dk + k0 + 8 * c) = o; }
    LDS_WAIT(); __builtin_amdgcn_wave_barrier();
}
__device__ __forceinline__ int conv_win_src(int n0) {
    if (n0 < 1536) return n0;
    if (n0 < 2304) return n0 + 32;
    if (n0 == 2304) return 1536;
    if (n0 < 2560) return -1;
    return n0 - 224;
}
constexpr int CV_GU = 16 * 176, CV_DN = 44 * 32, CV_WIN = 16 * 144, CV_P = 8 * 32, CV_O = 16 * 32;
constexpr int CV_NIT = 2 * CV_GU + 2 * CV_DN + CV_WIN + 2 * CV_P + CV_O;
__device__ __forceinline__ void conv_one(const Params& p, int l, int it, LAS float* scr, int lane) {
    bf16_t* WT = (bf16_t*)((unsigned char*)p.out + OO_WT) + (size_t)(l & 1) * WT_END;
    int r = it;
    if (r < 2 * CV_GU) { const int f = r / CV_GU; r -= f * CV_GU; const int kb = r / 176, nb = r % 176, n0 = nb * 32;
        const int t = n0 >> 8, half = (n0 >> 7) & 1, j0 = n0 & 127;
        const float* W = (half ? p.wu : p.wg) + (size_t)(l * 2 + f) * D * DFF;
        conv_item(W, DFF, D, 128 * t + j0, p.ng + (size_t)(l * 3 + (f ? 2 : 0)) * D, WT + (f ? WT_GU1 : WT_GU0), n0, kb * 64, scr, lane); return; }
    r -= 2 * CV_GU;
    if (r < 2 * CV_DN) { const int f = r / CV_DN; r -= f * CV_DN; const int kb = r / 32, nb = r % 32;
        conv_item(p.wd + (size_t)(l * 2 + f) * DFF * D, D, DFF, nb * 32, nullptr, WT + (f ? WT_DN1 : WT_DN0), nb * 32, kb * 64, scr, lane); return; }
    r -= 2 * CV_DN;
    if (r < CV_WIN) { const int kb = r / 144, nb = r % 144;
        conv_item(p.win + (size_t)l * D * DIN, DIN, D, conv_win_src(nb * 32), p.ng + (size_t)(l * 3 + 1) * D, WT + WT_WIN, nb * 32, kb * 64, scr, lane); return; }
    r -= CV_WIN;
    if (r < 2 * CV_P) { const int f = r / CV_P; r -= f * CV_P; const int kb = r / 32, nb = r % 32;
        conv_item((f ? p.wpb : p.wpa) + (size_t)l * 512 * D, D, 1024, nb * 32, nullptr, WT + WT_PA, nb * 32, kb * 64, scr, lane, f * 512); return; }
    r -= 2 * CV_P;
    { const int kb = r / 32, nb = r % 32; conv_item(p.wout + (size_t)l * D * D, D, D, nb * 32, nullptr, WT + WT_OUT, nb * 32, kb * 64, scr, lane); }
}
__device__ __forceinline__ void conv_layer(const Params& p, int l, LAS unsigned char* lds, int gw, int ngw, int wid, int lane) {
    LAS float* scr = (LAS float*)(lds + wid * 8448);
    for (int it = gw; it < CV_NIT; it += ngw) conv_one(p, l, it, scr, lane);
}

__device__ __forceinline__ float wave_sum(float v) {
#pragma unroll
    for (int o = 1; o < 64; o <<= 1) v += __shfl_xor(v, o);
    return v;
}
__device__ __forceinline__ void prologue(const Params& p, int gw, int ngw, int lane) {
    bf16_t* HB = (bf16_t*)(p.ws + OFF_H); float* SSQ = (float*)(p.ws + OFF_SSQ);
    for (int row = gw; row < MROWS; row += ngw) {
        f32x4 v[4]; float s = 0.f;
#pragma unroll
        for (int j = 0; j < 4; ++j) {
            if (row < MX) v[j] = *((const f32x4*)(p.x + (size_t)row * D) + lane + 64 * j);
            else if (row < NVALID) v[j] = *((const f32x4*)(p.meta + (size_t)((row - MX) & 15) * D) + lane + 64 * j);
            else v[j] = (f32x4){0.f, 0.f, 0.f, 0.f};
            s += (v[j][0] * v[j][0] + v[j][1] * v[j][1]) + (v[j][2] * v[j][2] + v[j][3] * v[j][3]);
        }
        s = wave_sum(s);
#pragma unroll
        for (int j = 0; j < 4; ++j) {
            u32x2 w; w.x = pk(v[j][0], v[j][1]); w.y = pk(v[j][2], v[j][3]); *((u32x2*)(HB + (size_t)row * D) + lane + 64 * j) = w; }
        if (lane < 16) SSQ[(size_t)row * 16 + lane] = (lane == 0) ? s : 0.f;
    }
    const int gt = gw * 64 + lane, ngt = ngw * 64;
    float* ROPE = (float*)(p.ws + OFF_ROPE);
    for (int i = gt; i < SEQ * 32; i += ngt) { const int t = i >> 5, f = i & 31, fi = f & 15; const float pos = (float)((f < 16) ? (t >> 6) : (t & 63));
        const float inv = exp2f(-(float)fi * (13.287712379549449f / 16.0f)); float rev = pos * inv * 0.15915494309189535f; rev -= floorf(rev);
        ROPE[t * 64 + f] = __builtin_amdgcn_cosf(rev); ROPE[t * 64 + 32 + f] = __builtin_amdgcn_sinf(rev); }
    if (gt < DEPTH) ((unsigned*)(p.ws + OFF_CTR))[gt * 64] = 0u;
    bf16_t* VT = (bf16_t*)(p.ws + OFF_VT);
    for (int i = gt; i < NB * 2 * 64 * 48; i += ngt) { const int r = i / 48, c = i % 48; VT[(size_t)r * LP + c] = 0; }
}
__device__ __forceinline__ void final_norm(const Params& p, int gw, int ngw, int lane) {
    const bf16_t* HB = (const bf16_t*)(p.ws + OFF_H); const float* SSQ = (const float*)(p.ws + OFF_SSQ) + (size_t)12 * MROWS * 16;
    for (int row = gw; row < MX; row += ngw) { const float rs = rstd_row(SSQ, row);
#pragma unroll
        for (int j = 0; j < 4; ++j) { const u32x2 w = *((const u32x2*)(HB + (size_t)row * D) + lane + 64 * j); const f32x4 g = *((const f32x4*)p.fn + lane + 64 * j);
            const f32x4 v = (f32x4){bflo(w.x), bfhi(w.x), bflo(w.y), bfhi(w.y)};
            *((f32x4*)(p.out + (size_t)row * D) + lane + 64 * j) = v * rs * g; } }
}

__device__ __forceinline__ void prep_qk(const Params& p, int l, int gt, int ngt) {
    const float* ROPE = (const float*)(p.ws + OFF_ROPE); const int j = gt & 7;
    for (int item = gt >> 3; item < NVALID * 10; item += ngt >> 3) {
        const int row = item / 10, hd = item % 10;
        bf16_t* ptr = ((hd < 8) ? (bf16_t*)(p.ws + OFF_RA) + (size_t)row * 1024 + 512 + hd * 64 : (bf16_t*)(p.ws + OFF_KB) + (size_t)row * 128 + (hd - 8) * 64) + 8 * j;
        const float* gain = ((hd < 8) ? p.qn : p.kn) + l * 64 + 8 * j; const float osc = (hd < 8) ? 0.125f * LOG2E : 1.0f;
        const u32x4 w = *(const u32x4*)ptr; const f32x4 g0 = *(const f32x4*)gain, g1 = *(const f32x4*)(gain + 4);
        float v[8] = {bflo(w.x), bfhi(w.x), bflo(w.y), bfhi(w.y), bflo(w.z), bfhi(w.z), bflo(w.w), bfhi(w.w)};
        float ss = 0.f;
#pragma unroll
        for (int e = 0; e < 8; ++e) ss += v[e] * v[e];
        ss += __shfl_xor(ss, 1); ss += __shfl_xor(ss, 2); ss += __shfl_xor(ss, 4);
        const float rs = __builtin_amdgcn_rsqf(ss * (1.0f / 64.0f) + EPS);
#pragma unroll
        for (int e = 0; e < 8; ++e) v[e] = v[e] * rs * ((e < 4) ? g0[e] : g1[e - 4]);
        if (row < MX) {
            const float* cs = ROPE + (size_t)(row & 4095) * 64 + 16 * (j >> 2) + 8 * (j & 1);
            const f32x4 c0 = *(const f32x4*)cs, c1 = *(const f32x4*)(cs + 4), s0 = *(const f32x4*)(cs + 32), s1 = *(const f32x4*)(cs + 36);
#pragma unroll
            for (int e = 0; e < 8; ++e) { const float c = (e < 4) ? c0[e] : c1[e - 4], sn = (e < 4) ? s0[e] : s1[e - 4]; const float o = __shfl_xor(v[e], 2);
                v[e] = (j & 2) ? (v[e] * c + o * sn) : (v[e] * c - o * sn); } }
        *(u32x4*)ptr = (u32x4){pk(v[0] * osc, v[1] * osc), pk(v[2] * osc, v[3] * osc), pk(v[4] * osc, v[5] * osc), pk(v[6] * osc, v[7] * osc)};
    }
}

constexpr int AT_TILE = 64 * 144, AT_K = 0, AT_V = 2 * AT_TILE, AT_VP = 136, AT_VTILE = 64 * AT_VP;
template <int NBLK, bool TRACK> __device__ __forceinline__ void attn_unit(const Params& p, int b, int kvh, int jb, LAS unsigned char* lds) {
    const int tid = mk_tid(), lane = tid & 63, wid = __builtin_amdgcn_readfirstlane(tid >> 6), r32 = lane & 31, hi = lane >> 5;
    bf16_t* QB = (bf16_t*)(p.ws + OFF_RA) + 512; const bf16_t* KB = (const bf16_t*)(p.ws + OFF_KB); const bf16_t* VT = (const bf16_t*)(p.ws + OFF_VT);
    const int hq = kvh * 4 + (wid >> 1);
    bool qvalid[NBLK]; bf16_t* qp[NBLK]; bf16x8 qr[NBLK][4];
#pragma unroll
    for (int blk = 0; blk < NBLK; ++blk) { const int rr = (wid & 1) * 64 + blk * 32 + r32;
        qvalid[blk] = (jb >= 0) || (rr < 16);
        const size_t qrow = (jb >= 0) ? (size_t)b * SEQ + jb * 128 + rr : (size_t)MX + b * 16 + (rr & 15);
        qp[blk] = QB + qrow * 1024 + hq * 64;
#pragma unroll
        for (int ds = 0; ds < 4; ++ds) qr[blk][ds] = qvalid[blk] ? *(const bf16x8*)(qp[blk] + ds * 16 + hi * 8) : (bf16x8){0, 0, 0, 0, 0, 0, 0, 0}; }
    const int tk = tid >> 3, tc = tid & 7;
    const bf16_t* vsrc = VT + ((size_t)(b * 2 + kvh) * 64 + tk) * LP + tc * 8;
    const bf16_t* ksrc = KB + ((size_t)b * SEQ + tk) * 128 + kvh * 64 + tc * 8;
    const bf16_t* ksrc0 = KB + ((size_t)MX + b * 16 + (tk - 48)) * 128 + kvh * 64 + tc * 8;
    const int lst = tk * 144 + tc * 16, lstv = tk * AT_VP + tc * 16;
    u32x4 kreg, vreg;
    kreg = (tk >= 48) ? *(const u32x4*)ksrc0 : (u32x4){0u, 0u, 0u, 0u}; vreg = *(const u32x4*)vsrc;
    *(LAS u32x4*)(lds + AT_K + lst) = kreg; *(LAS u32x2*)(lds + AT_V + lstv) = (u32x2){vreg.x, vreg.y}; *(LAS u32x2*)(lds + AT_V + lstv + 8) = (u32x2){vreg.z, vreg.w};
    __syncthreads();
    f32x16 o0[NBLK], o1[NBLK]; float mrun[NBLK], lrun[NBLK];
#pragma unroll
    for (int blk = 0; blk < NBLK; ++blk) { mrun[blk] = -1e30f; lrun[blk] = 0.f;
#pragma unroll
        for (int r = 0; r < 16; ++r) { o0[blk][r] = 0.f; o1[blk][r] = 0.f; } }
    for (int t = 0; t < NCH; ++t) {
        const int buf = t & 1;
        if (t + 1 < NCH) { kreg = *(const u32x4*)(ksrc + (size_t)t * 64 * 128); vreg = *(const u32x4*)(vsrc + (t + 1) * 64); }
        const LAS unsigned char* Kl = lds + AT_K + buf * AT_TILE; const LAS unsigned char* Vl = lds + AT_V + buf * AT_VTILE;
        f32x16 p0[NBLK], p1[NBLK];
#pragma unroll
        for (int blk = 0; blk < NBLK; ++blk)
#pragma unroll
            for (int r = 0; r < 16; ++r) { p0[blk][r] = 0.f; p1[blk][r] = 0.f; }
#pragma unroll
        for (int ds = 0; ds < 4; ++ds) {
            const bf16x8 k0 = *(const LAS bf16x8*)(Kl + r32 * 144 + ds * 32 + hi * 16), k1 = *(const LAS bf16x8*)(Kl + (r32 + 32) * 144 + ds * 32 + hi * 16);
#pragma unroll
            for (int blk = 0; blk < NBLK; ++blk) {
                p0[blk] = __builtin_amdgcn_mfma_f32_32x32x16_bf16(k0, qr[blk][ds], p0[blk], 0, 0, 0);
                p1[blk] = __builtin_amdgcn_mfma_f32_32x32x16_bf16(k1, qr[blk][ds], p1[blk], 0, 0, 0); }
        }
        u32x4 pw[NBLK][4];
#pragma unroll
        for (int blk = 0; blk < NBLK; ++blk) {
            if (t == 0) {
#pragma unroll
                for (int r = 0; r < 16; ++r) { p0[blk][r] = -1e30f; if (r < 8) p1[blk][r] = -1e30f; }
            }
            float ls = 0.f;
            if (TRACK) {
                float mx = fmaxf(p0[blk][0], p1[blk][0]);
#pragma unroll
                for (int r = 1; r < 16; ++r) mx = fmaxf(mx, fmaxf(p0[blk][r], p1[blk][r]));
                mx = fmaxf(mx, __shfl_xor(mx, 32));
                if (__any(mx > mrun[blk] + 8.0f)) {
                    const float mnew = fmaxf(mrun[blk], mx), alpha = __builtin_amdgcn_exp2f(mrun[blk] - mnew);
                    lrun[blk] *= alpha; mrun[blk] = mnew;
#pragma unroll
                    for (int r = 0; r < 16; ++r) { o0[blk][r] *= alpha; o1[blk][r] *= alpha; }
                }
#pragma unroll
                for (int r = 0; r < 16; ++r) { p0[blk][r] = __builtin_amdgcn_exp2f(p0[blk][r] - mrun[blk]); p1[blk][r] = __builtin_amdgcn_exp2f(p1[blk][r] - mrun[blk]); ls += p0[blk][r] + p1[blk][r]; }
            } else {
#pragma unroll
                for (int r = 0; r < 16; ++r) { p0[blk][r] = __builtin_amdgcn_exp2f(p0[blk][r]); p1[blk][r] = __builtin_amdgcn_exp2f(p1[blk][r]); }
                typedef float f32x8v __attribute__((ext_vector_type(8))); typedef float f32x2v __attribute__((ext_vector_type(2)));
                const f32x16 sv = p0[blk] + p1[blk];
                const f32x8v s8 = sv.lo + sv.hi; const f32x4 s4 = s8.lo + s8.hi; const f32x2v s2 = s4.lo + s4.hi; ls = s2.x + s2.y;
            }
            lrun[blk] += ls;
            pw[blk][0] = (u32x4){pk(p0[blk][0], p0[blk][1]), pk(p0[blk][2], p0[blk][3]), pk(p0[blk][4], p0[blk][5]), pk(p0[blk][6], p0[blk][7])};
            pw[blk][1] = (u32x4){pk(p0[blk][8], p0[blk][9]), pk(p0[blk][10], p0[blk][11]), pk(p0[blk][12], p0[blk][13]), pk(p0[blk][14], p0[blk][15])};
            pw[blk][2] = (u32x4){pk(p1[blk][0], p1[blk][1]), pk(p1[blk][2], p1[blk][3]), pk(p1[blk][4], p1[blk][5]), pk(p1[blk][6], p1[blk][7])};
            pw[blk][3] = (u32x4){pk(p1[blk][8], p1[blk][9]), pk(p1[blk][10], p1[blk][11]), pk(p1[blk][12], p1[blk][13]), pk(p1[blk][14], p1[blk][15])};
        }
#pragma unroll
        for (int s = 0; s < 4; ++s) {
            { const u32x2 a = *(const LAS u32x2*)(Vl + r32 * AT_VP + (16 * s + 4 * hi) * 2), c = *(const LAS u32x2*)(Vl + r32 * AT_VP + (16 * s + 8 + 4 * hi) * 2);
              const bf16x8 vf = __builtin_bit_cast(bf16x8, (u32x4){a.x, a.y, c.x, c.y});
#pragma unroll
              for (int blk = 0; blk < NBLK; ++blk) o0[blk] = __builtin_amdgcn_mfma_f32_32x32x16_bf16(vf, __builtin_bit_cast(bf16x8, pw[blk][s]), o0[blk], 0, 0, 0); }
            { const u32x2 a = *(const LAS u32x2*)(Vl + (r32 + 32) * AT_VP + (16 * s + 4 * hi) * 2), c = *(const LAS u32x2*)(Vl + (r32 + 32) * AT_VP + (16 * s + 8 + 4 * hi) * 2);
              const bf16x8 vf = __builtin_bit_cast(bf16x8, (u32x4){a.x, a.y, c.x, c.y});
#pragma unroll
              for (int blk = 0; blk < NBLK; ++blk) o1[blk] = __builtin_amdgcn_mfma_f32_32x32x16_bf16(vf, __builtin_bit_cast(bf16x8, pw[blk][s]), o1[blk], 0, 0, 0); }
        }
        if (t + 1 < NCH) { *(LAS u32x4*)(lds + AT_K + (buf ^ 1) * AT_TILE + lst) = kreg; *(LAS u32x2*)(lds + AT_V + (buf ^ 1) * AT_VTILE + lstv) = (u32x2){vreg.x, vreg.y}; *(LAS u32x2*)(lds + AT_V + (buf ^ 1) * AT_VTILE + lstv + 8) = (u32x2){vreg.z, vreg.w}; }
        __syncthreads();
    }
#pragma unroll
    for (int blk = 0; blk < NBLK; ++blk) {
        float l = lrun[blk]; l += __shfl_xor(l, 32);
        const float inv = 1.0f / l;
        if (qvalid[blk]) {
#pragma unroll
            for (int g = 0; g < 4; ++g) {
                u32x2 w0; w0.x = pk(o0[blk][4 * g] * inv, o0[blk][4 * g + 1] * inv); w0.y = pk(o0[blk][4 * g + 2] * inv, o0[blk][4 * g + 3] * inv);
                u32x2 w1; w1.x = pk(o1[blk][4 * g] * inv, o1[blk][4 * g + 1] * inv); w1.y = pk(o1[blk][4 * g + 2] * inv, o1[blk][4 * g + 3] * inv);
                *(u32x2*)(qp[blk] + 8 * g + 4 * hi) = w0; *(u32x2*)(qp[blk] + 32 + 8 * g + 4 * hi) = w1;
            }
        }
    }
}
__device__ __forceinline__ void attn_phase(const Params& p, int l, LAS unsigned char* lds, int vcu, int G) {
    const int lane = mk_tid() & 63;
    float gq = fabsf(p.qn[l * 64 + lane]), gk = fabsf(p.kn[l * 64 + lane]);
#pragma unroll
    for (int o = 1; o < 64; o <<= 1) { gq = fmaxf(gq, __shfl_xor(gq, o)); gk = fmaxf(gk, __shfl_xor(gk, o)); }
    const bool safe = __builtin_amdgcn_readfirstlane((gq * gk * 11.55f < 40.0f) ? 1 : 0) != 0;
    const int nper = (512 + G - 1) / G;
    if (safe) {
        for (int i = 0; i < nper; ++i) { const int id = vcu * nper + i; if (id < 512) attn_unit<2, false>(p, id >> 6, (id >> 5) & 1, id & 31, lds); }
        for (int m = 0; m < 16; ++m) if ((m * G) / 16 == vcu) attn_unit<1, false>(p, m >> 1, m & 1, -1, lds);
    } else {
        for (int i = 0; i < nper; ++i) { const int id = vcu * nper + i; if (id < 512) attn_unit<2, true>(p, id >> 6, (id >> 5) & 1, id & 31, lds); }
        for (int m = 0; m < 16; ++m) if ((m * G) / 16 == vcu) attn_unit<1, true>(p, m >> 1, m & 1, -1, lds);
    }
}

__device__ __forceinline__ void gla_scan(const Params& p, int gt, int ngt) {
    bf16_t* S = (bf16_t*)(p.ws + OFF_S); const float* DEC = (const float*)(p.ws + OFF_DEC);
    if (gt & 1) return;
    for (int task = gt >> 1; task < 64 * 1024; task += ngt >> 1) {
        const int bhd = task >> 10, e = (task & 1023) * 8, c = e & 63, dir = bhd & 1;
        bf16_t* sp = S + (size_t)bhd * NCH * 8192 + e; const float* dp = DEC + (size_t)bhd * NCH * 64 + c;
        f32x4 s0 = (f32x4){0.f, 0.f, 0.f, 0.f}, s1 = s0;
#pragma unroll 5
        for (int k = 0; k < NCH; ++k) { const int ch = dir ? (NCH - 1 - k) : k;
            const u32x4 kv = *(const u32x4*)(sp + (size_t)ch * 8192); const f32x4 d0 = *(const f32x4*)(dp + ch * 64), d1 = *(const f32x4*)(dp + ch * 64 + 4);
            *(u32x4*)(sp + (size_t)ch * 8192) = (u32x4){pk(s0[0], s0[1]), pk(s0[2], s0[3]), pk(s1[0], s1[1]), pk(s1[2], s1[3])};
            s0 = d0 * s0 + (f32x4){bflo(kv.x), bfhi(kv.x), bflo(kv.y), bfhi(kv.y)}; s1 = d1 * s1 + (f32x4){bflo(kv.z), bfhi(kv.z), bflo(kv.w), bfhi(kv.w)}; }
    }
}
constexpr int GL2_QD = 0;
constexpr int GL2_KI = 18432;
constexpr int GL2_VT = 36864;
constexpr int GL2_ATT = 55296;
constexpr int GL2_W2 = 64512;
constexpr int GL2_SZ = 64512 + 8192 + 512;
constexpr int GLA_UNITS = 32 * NCH;
static_assert(2 * GL2_SZ + 16 <= LDS_BYTES && GLA_UNITS % 2 == 0, "GLA LDS");
template <bool G3> __device__ __forceinline__ void gla_pair(const Params& p, int l, int u, bool valid, LAS unsigned char* lds) {
    const int tid = mk_tid(), lane = tid & 63, wid = __builtin_amdgcn_readfirstlane(tid >> 6), w4 = wid & 3, t8 = tid & 255, fr = lane & 15, fq = lane >> 4;
    const bf16_t* QKA = (const bf16_t*)(p.ws + OFF_QKA); const bf16_t* VA = (const bf16_t*)(p.ws + OFF_VA); bf16_t* RA = (bf16_t*)(p.ws + OFF_RA);
    const float* LR = (const float*)(p.ws + OFF_LR); bf16_t* S = (bf16_t*)(p.ws + OFF_S); float* DEC = (float*)(p.ws + OFF_DEC);
    const int bh = u / NCH, chunk = u % NCH, b = bh >> 2, h = bh & 3, c0 = w4 * 16;
#define GL_ROW(i) ((chunk == 0) ? ((size_t)MX + b * 16 + ((i) - 48)) : ((size_t)b * SEQ + (chunk - 1) * 64 + (i)))
#define GL_NUL(i) ((chunk == 0) && ((i) < 48))
    const int i = lane; const bool nul = GL_NUL(i); const size_t row = nul ? (size_t)MX : GL_ROW(i);
    LAS float* w2s = (LAS float*)(lds + GL2_W2); LAS float* b2s = w2s + 2048;
#pragma unroll
    for (int q = 0; q < 2; ++q) { const int ch = t8 + 256 * q, rr = ch >> 4, c4 = (ch & 15) * 4;
        *(LAS f32x4*)(w2s + rr * 64 + c4) = *(const f32x4*)(p.w2 + (size_t)(l * 32 + rr) * 256 + h * 64 + c4); }
    if (t8 < 32) { const int dd = t8 >> 4, c4 = (t8 & 15) * 4; *(LAS f32x4*)(b2s + dd * 64 + c4) = *(const f32x4*)(p.b2 + (size_t)(l * 2 + dd) * 256 + h * 64 + c4); }
    __syncthreads();
    float bcv[2][16];
#pragma unroll
    for (int dir = 0; dir < 2; ++dir) {
        float lrv[16];
        { const float* lrp = LR + row * 32 + dir * 16;
#pragma unroll
          for (int q = 0; q < 4; ++q) { const f32x4 t = *(const f32x4*)(lrp + 4 * q); lrv[4 * q] = t[0]; lrv[4 * q + 1] = t[1]; lrv[4 * q + 2] = t[2]; lrv[4 * q + 3] = t[3]; } }
        const LAS float* w2p = w2s + dir * 1024 + c0; const LAS float* b2p = b2s + dir * 64 + c0;
#pragma unroll
        for (int cc = 0; cc < 16; ++cc) {
            float x = b2p[cc];
#pragma unroll
            for (int r = 0; r < 16; ++r) x += lrv[r] * w2p[r * 64 + cc];
            const float lg = nul ? 0.f : __builtin_amdgcn_logf(1.f + __builtin_amdgcn_exp2f(fminf(-x, 60.f) * LOG2E)) * (-0.6931471805599453f / 16.0f);
            float sc = wave_incl_scan(lg);
            if (dir == 1) sc = lane_bcast(sc, 63) - sc + lg;
            bcv[dir][cc] = sc;
        }
    }
    LAS bf16_t* vT = (LAS bf16_t*)(lds + GL2_VT);
#pragma unroll
    for (int q = 0; q < 4; ++q) { const int vc = w4 * 4 + q;
        const u32x4 w = nul ? (u32x4){0u, 0u, 0u, 0u} : *(const u32x4*)(VA + row * 512 + h * 128 + vc * 8);
        vT[(vc * 8 + 0) * 72 + i] = (bf16_t)(w.x & 0xffffu); vT[(vc * 8 + 1) * 72 + i] = (bf16_t)(w.x >> 16); vT[(vc * 8 + 2) * 72 + i] = (bf16_t)(w.y & 0xffffu); vT[(vc * 8 + 3) * 72 + i] = (bf16_t)(w.y >> 16);
        vT[(vc * 8 + 4) * 72 + i] = (bf16_t)(w.z & 0xffffu); vT[(vc * 8 + 5) * 72 + i] = (bf16_t)(w.z >> 16); vT[(vc * 8 + 6) * 72 + i] = (bf16_t)(w.w & 0xffffu); vT[(vc * 8 + 7) * 72 + i] = (bf16_t)(w.w >> 16); }
    float kf[16], qf[16];
    { const u32x4 k0 = nul ? (u32x4){0u, 0u, 0u, 0u} : *(const u32x4*)(QKA + row * 512 + 256 + h * 64 + c0), k1 = nul ? (u32x4){0u, 0u, 0u, 0u} : *(const u32x4*)(QKA + row * 512 + 256 + h * 64 + c0 + 8);
      kf[0] = bflo(k0.x); kf[1] = bfhi(k0.x); kf[2] = bflo(k0.y); kf[3] = bfhi(k0.y); kf[4] = bflo(k0.z); kf[5] = bfhi(k0.z); kf[6] = bflo(k0.w); kf[7] = bfhi(k0.w);
      kf[8] = bflo(k1.x); kf[9] = bfhi(k1.x); kf[10] = bflo(k1.y); kf[11] = bfhi(k1.y); kf[12] = bflo(k1.z); kf[13] = bfhi(k1.z); kf[14] = bflo(k1.w); kf[15] = bfhi(k1.w); }
    if (G3) { const u32x4 q0 = nul ? (u32x4){0u, 0u, 0u, 0u} : *(const u32x4*)(QKA + row * 512 + h * 64 + c0), q1 = nul ? (u32x4){0u, 0u, 0u, 0u} : *(const u32x4*)(QKA + row * 512 + h * 64 + c0 + 8);
      qf[0] = bflo(q0.x); qf[1] = bfhi(q0.x); qf[2] = bflo(q0.y); qf[3] = bfhi(q0.y); qf[4] = bflo(q0.z); qf[5] = bfhi(q0.z); qf[6] = bflo(q0.w); qf[7] = bfhi(q0.w);
      qf[8] = bflo(q1.x); qf[9] = bfhi(q1.x); qf[10] = bflo(q1.y); qf[11] = bfhi(q1.y); qf[12] = bflo(q1.z); qf[13] = bfhi(q1.z); qf[14] = bflo(q1.w); qf[15] = bfhi(q1.w); }
    bf16x8 sfr[2][2][2]; u32x4 rpre[4];
    if (G3) {
#pragma unroll
        for (int dir = 0; dir < 2; ++dir) { const bf16_t* sp = S + ((size_t)(bh * 2 + dir) * NCH + chunk) * 8192;
#pragma unroll
            for (int vt = 0; vt < 2; ++vt)
#pragma unroll
                for (int ks = 0; ks < 2; ++ks) sfr[dir][vt][ks] = *(const bf16x8*)(sp + (size_t)((w4 * 2 + vt) * 16 + fr) * 64 + 32 * ks + 8 * fq); }
        { const int ii = t8 >> 2, part = t8 & 3; const size_t rr = GL_NUL(ii) ? (size_t)MX : GL_ROW(ii); const bf16_t* rp = RA + rr * 1024 + h * 128 + part * 32;
#pragma unroll
          for (int q = 0; q < 4; ++q) rpre[q] = *(const u32x4*)(rp + 8 * q); }
    }
    if (!G3) {
        LAS bf16_t* keT = (LAS bf16_t*)(lds + GL2_QD);
#pragma unroll
        for (int cc = 0; cc < 16; ++cc) {
            const float btF = lane_bcast(bcv[0][cc], 63), btB = lane_bcast(bcv[1][cc], 0);
            keT[(c0 + cc) * 72 + i] = f2bf(kf[cc] * fexp(btF - bcv[0][cc])); keT[(64 + c0 + cc) * 72 + i] = f2bf(kf[cc] * fexp(btB - bcv[1][cc]));
            if (valid && lane == 0) { DEC[((size_t)(bh * 2 + 0) * NCH + chunk) * 64 + c0 + cc] = fexp(btF); DEC[((size_t)(bh * 2 + 1) * NCH + chunk) * 64 + c0 + cc] = fexp(btB); }
        }
        __syncthreads();
#pragma unroll
        for (int dir = 0; dir < 2; ++dir) { bf16_t* sbase = S + ((size_t)(bh * 2 + dir) * NCH + chunk) * 8192;
#pragma unroll
          for (int vt = 0; vt < 2; ++vt) { const int v0 = (w4 * 2 + vt) * 16;
              const bf16x8 a0 = *(const LAS bf16x8*)(vT + (v0 + fr) * 72 + 8 * fq), a1 = *(const LAS bf16x8*)(vT + (v0 + fr) * 72 + 32 + 8 * fq);
#pragma unroll
              for (int ct = 0; ct < 4; ++ct) { const int cb = ct * 16;
                  const bf16x8 b0 = *(const LAS bf16x8*)(keT + (dir * 64 + cb + fr) * 72 + 8 * fq), b1 = *(const LAS bf16x8*)(keT + (dir * 64 + cb + fr) * 72 + 32 + 8 * fq);
                  f32x4 acc = (f32x4){0.f, 0.f, 0.f, 0.f};
                  acc = __builtin_amdgcn_mfma_f32_16x16x32_bf16(b0, a0, acc, 0, 0, 0); acc = __builtin_amdgcn_mfma_f32_16x16x32_bf16(b1, a1, acc, 0, 0, 0);
                  u32x2 w; w.x = pk(acc[0], acc[1]); w.y = pk(acc[2], acc[3]);
                  if (valid) *(u32x2*)(sbase + (size_t)(v0 + fr) * 64 + cb + 4 * fq) = w; } } }
        __syncthreads();
    } else {
        LAS bf16_t* qd = (LAS bf16_t*)(lds + GL2_QD); LAS bf16_t* ki = (LAS bf16_t*)(lds + GL2_KI); LAS bf16_t* att = (LAS bf16_t*)(lds + GL2_ATT);
#pragma unroll
        for (int dir = 0; dir < 2; ++dir) { float qo[16], ko[16];
#pragma unroll
            for (int cc = 0; cc < 16; ++cc) { qo[cc] = qf[cc] * fexp(bcv[dir][cc]); ko[cc] = kf[cc] * fexp(-bcv[dir][cc]); }
            *(LAS u32x4*)(qd + (dir * 64 + i) * 72 + c0) = (u32x4){pk(qo[0], qo[1]), pk(qo[2], qo[3]), pk(qo[4], qo[5]), pk(qo[6], qo[7])};
            *(LAS u32x4*)(qd + (dir * 64 + i) * 72 + c0 + 8) = (u32x4){pk(qo[8], qo[9]), pk(qo[10], qo[11]), pk(qo[12], qo[13]), pk(qo[14], qo[15])};
            *(LAS u32x4*)(ki + (dir * 64 + i) * 72 + c0) = (u32x4){pk(ko[0], ko[1]), pk(ko[2], ko[3]), pk(ko[4], ko[5]), pk(ko[6], ko[7])};
            *(LAS u32x4*)(ki + (dir * 64 + i) * 72 + c0 + 8) = (u32x4){pk(ko[8], ko[9]), pk(ko[10], ko[11]), pk(ko[12], ko[13]), pk(ko[14], ko[15])}; }
        __syncthreads();
        const int i0 = w4 * 16;
        bf16x8 aFq[2], aBq[2];
#pragma unroll
        for (int ks = 0; ks < 2; ++ks) { aFq[ks] = *(const LAS bf16x8*)(qd + (i0 + fr) * 72 + 32 * ks + 8 * fq); aBq[ks] = *(const LAS bf16x8*)(qd + (64 + i0 + fr) * 72 + 32 * ks + 8 * fq); }
#pragma unroll
        for (int jt = 0; jt < 4; ++jt) { const int j0 = jt * 16;
            f32x4 aF = (f32x4){0.f, 0.f, 0.f, 0.f}, aB = (f32x4){0.f, 0.f, 0.f, 0.f};
#pragma unroll
            for (int ks = 0; ks < 2; ++ks) {
                const bf16x8 kf_ = *(const LAS bf16x8*)(ki + (j0 + fr) * 72 + 32 * ks + 8 * fq), kb_ = *(const LAS bf16x8*)(ki + (64 + j0 + fr) * 72 + 32 * ks + 8 * fq);
                aF = __builtin_amdgcn_mfma_f32_16x16x32_bf16(aFq[ks], kf_, aF, 0, 0, 0); aB = __builtin_amdgcn_mfma_f32_16x16x32_bf16(aBq[ks], kb_, aB, 0, 0, 0); }
#pragma unroll
            for (int r = 0; r < 4; ++r) { const int ii = i0 + 4 * fq + r, jj = j0 + fr; const float v = ((ii >= jj) ? aF[r] : 0.f) + ((jj >= ii) ? aB[r] : 0.f); att[ii * 72 + jj] = f2bf(v); } }
        __syncthreads();
        LAS bf16_t* ol = ki;
        { bf16x8 bV[2][2];
#pragma unroll
          for (int vt = 0; vt < 2; ++vt)
#pragma unroll
              for (int ks = 0; ks < 2; ++ks) bV[vt][ks] = *(const LAS bf16x8*)(vT + ((w4 * 2 + vt) * 16 + fr) * 72 + 32 * ks + 8 * fq);
#pragma unroll
          for (int it = 0; it < 4; ++it) { const int ib = it * 16; bf16x8 aA[2], aF2[2], aB2[2];
#pragma unroll
              for (int ks = 0; ks < 2; ++ks) { aA[ks] = *(const LAS bf16x8*)(att + (ib + fr) * 72 + 32 * ks + 8 * fq); aF2[ks] = *(const LAS bf16x8*)(qd + (ib + fr) * 72 + 32 * ks + 8 * fq);
                  aB2[ks] = *(const LAS bf16x8*)(qd + (64 + ib + fr) * 72 + 32 * ks + 8 * fq); }
#pragma unroll
              for (int vt = 0; vt < 2; ++vt) { const int v0 = (w4 * 2 + vt) * 16; f32x4 acc = (f32x4){0.f, 0.f, 0.f, 0.f};
#pragma unroll
                  for (int ks = 0; ks < 2; ++ks) { acc = __builtin_amdgcn_mfma_f32_16x16x32_bf16(aA[ks], bV[vt][ks], acc, 0, 0, 0);
                      acc = __builtin_amdgcn_mfma_f32_16x16x32_bf16(aF2[ks], sfr[0][vt][ks], acc, 0, 0, 0); acc = __builtin_amdgcn_mfma_f32_16x16x32_bf16(aB2[ks], sfr[1][vt][ks], acc, 0, 0, 0); }
#pragma unroll
                  for (int r = 0; r < 4; ++r) ol[(ib + 4 * fq + r) * 136 + v0 + fr] = f2bf(acc[r]); } } }
        __syncthreads();
        { const int ii = t8 >> 2, part = t8 & 3; const bool nl = GL_NUL(ii); float ov[32]; float ss = 0.f;
#pragma unroll
          for (int q = 0; q < 4; ++q) { const u32x4 t = *(const LAS u32x4*)(ol + ii * 136 + part * 32 + 8 * q);
              ov[8 * q] = bflo(t.x); ov[8 * q + 1] = bfhi(t.x); ov[8 * q + 2] = bflo(t.y); ov[8 * q + 3] = bfhi(t.y); ov[8 * q + 4] = bflo(t.z); ov[8 * q + 5] = bfhi(t.z); ov[8 * q + 6] = bflo(t.w); ov[8 * q + 7] = bfhi(t.w); }
#pragma unroll
          for (int e = 0; e < 32; ++e) ss += ov[e] * ov[e];
          ss += __shfl_xor(ss, 1); ss += __shfl_xor(ss, 2);
          const float rs = __builtin_amdgcn_rsqf(ss * (1.0f / 128.0f) + EPS);
          if (valid && !nl) { bf16_t* rp = RA + GL_ROW(ii) * 1024 + h * 128 + part * 32; const float* gp = p.gn + (size_t)l * 512 + h * 128 + part * 32;
#pragma unroll
              for (int q = 0; q < 4; ++q) { const u32x4 rw = rpre[q]; const f32x4 g0 = *(const f32x4*)(gp + 8 * q), g1 = *(const f32x4*)(gp + 8 * q + 4);
                  const float rf[8] = {bflo(rw.x), bfhi(rw.x), bflo(rw.y), bfhi(rw.y), bflo(rw.z), bfhi(rw.z), bflo(rw.w), bfhi(rw.w)}; float y[8];
#pragma unroll
                  for (int e = 0; e < 8; ++e) y[e] = ov[8 * q + e] * rs * ((e < 4) ? g0[e] : g1[e - 4]) * rf[e];
                  *(u32x4*)(rp + 8 * q) = (u32x4){pk(y[0], y[1]), pk(y[2], y[3]), pk(y[4], y[5]), pk(y[6], y[7])}; } } }
        __syncthreads();
    }
#undef GL_ROW
#undef GL_NUL
}
template <bool G3> __device__ __forceinline__ void gla_phase(const Params& p, int l, LAS unsigned char* lds, int bx, int G) {
    const int grp = __builtin_amdgcn_readfirstlane(mk_tid() >> 8);
    const int niter = (GLA_UNITS + 2 * G - 1) / (2 * G);
    for (int it = 0; it < niter; ++it) { int u = (it * G + bx) * 2 + grp; const bool valid = u < GLA_UNITS; if (!valid) u = GLA_UNITS - 1;
        gla_pair<G3>(p, l, u, valid, lds + grp * GL2_SZ); }
}

__device__ __forceinline__ void gla_pool(const Params& p, int l, LAS unsigned char* lds) {
    const int tid = mk_tid(), grp = __builtin_amdgcn_readfirstlane(tid >> 8);
    unsigned* ctr = (unsigned*)(p.ws + OFF_CTR) + l * 64; LAS unsigned* slot = (LAS unsigned*)(lds + 2 * GL2_SZ);
    for (;;) {
        if (tid == 0) *slot = atomicAdd(ctr, 1u);
        __syncthreads();
        const unsigned k = *slot;
        __syncthreads();
        if (k < (unsigned)(GLA_UNITS / 2)) { gla_pair<true>(p, l, (int)k * 2 + grp, true, lds + grp * GL2_SZ); continue; }
        const int j = (int)k - GLA_UNITS / 2;
        if (l + 1 >= DEPTH || j >= (CV_NIT + 7) / 8) break;
        { const int wid = __builtin_amdgcn_readfirstlane(tid >> 6), it = j * 8 + wid; if (it < CV_NIT) conv_one(p, l + 1, it, (LAS float*)(lds + wid * 8448), tid & 63); }
        __syncthreads();
    }
}

#define XB_TMO      128
#define XB_XCNT(j)  (256  + 64 * (j))
#define XB_XSUB(j)  (1280 + 64 * (j))
#define XB_XGEN(j)  (2304 + 64 * (j))
#define XB_TOP      3328
#define XB_TOPGEN   3392
#define XCD_BAR_WORDS 3456
#define XB_SPIN_CAP (1u << 18)

__device__ __forceinline__ unsigned xb_ld(unsigned* p)              { return __hip_atomic_load(p, __ATOMIC_RELAXED, __HIP_MEMORY_SCOPE_AGENT); }
__device__ __forceinline__ unsigned xb_add(unsigned* p, unsigned v) { return __hip_atomic_fetch_add(p, v, __ATOMIC_RELAXED, __HIP_MEMORY_SCOPE_AGENT); }
__device__ __forceinline__ unsigned xb_xcc_id() { return (unsigned)__builtin_amdgcn_s_getreg((3 << 11) | 20) & 0xFu; }
#define XB_SPIN(cond, bar) do { unsigned _sp = 0; while (cond) { __builtin_amdgcn_s_sleep(1); \
    if ((++_sp & 255u) == 0u) { if (xb_ld(&(bar)[XB_TMO])) break; if (_sp > XB_SPIN_CAP) { atomicAdd(&(bar)[XB_TMO], 1u); break; } } } } while (0)
struct XcdBarrier {
    unsigned* bar; unsigned x;
    volatile LAS unsigned* st;
};

__device__ __forceinline__ XcdBarrier xcd_barrier_post(unsigned* bar, volatile LAS unsigned* st) {
    XcdBarrier b; b.bar = bar; b.x = xb_xcc_id(); b.st = st;
    if (threadIdx.x == 0) (void)xb_add(&bar[XB_XCNT(b.x)], 1u);
    return b;
}
__device__ __forceinline__ void xcd_barrier_complete(unsigned* bar, unsigned x, unsigned& nloc, unsigned& nx) {
    const unsigned G = gridDim.x * gridDim.y * gridDim.z;
    unsigned sum, cnt, mine, sp = 0u;
    for (;;) {
        sum = 0u; cnt = 0u; mine = 0u;
#pragma unroll
        for (unsigned j = 0; j < 16; ++j) { const unsigned c = xb_ld(&bar[XB_XCNT(j)]); sum += c; cnt += (c > 0u) ? 1u : 0u; mine = (j == x) ? c : mine; }
        if (sum == G) break;
        __builtin_amdgcn_s_sleep(1);
        if ((++sp & 255u) == 0u) { if (xb_ld(&bar[XB_TMO])) break; if (sp > XB_SPIN_CAP) { atomicAdd(&bar[XB_TMO], 1u); break; } }
    }
    nloc = mine > 0u ? mine : 1u; nx = cnt > 0u ? cnt : 1u;
}

__device__ __forceinline__ void xcd_barrier(const XcdBarrier& b) {
    asm volatile("s_waitcnt vmcnt(0)" ::: "memory");
    __syncthreads();
    if (threadIdx.x == 0) {
        unsigned* bar = b.bar;
        __builtin_amdgcn_s_waitcnt(0);
        unsigned nloc = b.st[0], nx = b.st[1];
        if (nloc == 0u) { xcd_barrier_complete(bar, b.x, nloc, nx); b.st[0] = nloc; b.st[1] = nx; }
        const unsigned old = xb_add(&bar[XB_XSUB(b.x)], 1u);
        const unsigned gen = old / nloc;
        if (old + 1u == (gen + 1u) * nloc) {
            __builtin_amdgcn_fence(__ATOMIC_RELEASE, "agent");
            asm volatile("s_waitcnt vmcnt(0)" ::: "memory");
            const unsigned og = xb_add(&bar[XB_TOP], 1u);
            const unsigned tg = og / nx;
            if (og + 1u == (tg + 1u) * nx) xb_add(&bar[XB_TOPGEN], 1u);
            else XB_SPIN(xb_ld(&bar[XB_TOPGEN]) == tg, bar);
            __builtin_amdgcn_fence(__ATOMIC_ACQUIRE, "agent");
            xb_add(&bar[XB_XGEN(b.x)], 1u);
            asm volatile("s_waitcnt vmcnt(0)" ::: "memory");
        } else {
            XB_SPIN(xb_ld(&bar[XB_XGEN(b.x)]) == gen, bar);
            __builtin_amdgcn_fence(__ATOMIC_ACQUIRE, "agent");
            asm volatile("s_waitcnt vmcnt(0)" ::: "memory");
        }
    }
    __syncthreads();
}

__global__ void __launch_bounds__(512) mk_fwd(Params pin) {
    extern __shared__ __attribute__((aligned(16))) unsigned char lds_raw[];
    LAS unsigned char* lds = (LAS unsigned char*)lds_raw;
    cg::grid_group grid = cg::this_grid();
    const Params p0 = pin;
    volatile LAS unsigned* xst = (volatile LAS unsigned*)(lds + LDS_BYTES - 16);
    if (threadIdx.x < 2) xst[threadIdx.x] = 0u;
    __syncthreads();
    XcdBarrier xbar = xcd_barrier_post((unsigned*)(p0.ws + OFF_BAR), xst);
    if (p0.ph_hi < 0) grid.sync();
#ifdef MK_TIMING
    unsigned long long tA = 0, tB = 0, tprev = __builtin_amdgcn_s_memrealtime();
#endif
    for (int ph = p0.ph_lo; ph < p0.ph_hi; ++ph) {
        if (ph > p0.ph_lo) { long zb = 0; asm volatile("" : "+s"(zb)); XcdBarrier xb = xbar; xb.bar += zb; xcd_barrier(xb); }
#ifdef MK_TIMING
        if (ph > p0.ph_lo) { const unsigned long long tn = __builtin_amdgcn_s_memrealtime(); const int pp = ph - 1; const int ss = (pp == 0 || pp == NPH - 1) ? 11 : (pp - 1) % 10;
            if ((MK_TA >> ss) & 1) tA += tn - tprev; if ((MK_TB >> ss) & 1) tB += tn - tprev; tprev = tn; }
#endif
        long z = 0; asm volatile("" : "+s"(z));
        Params p = p0;
        p.x += z; p.meta += z; p.ng += z; p.wg += z; p.wu += z; p.wd += z; p.win += z; p.w2 += z; p.b2 += z; p.gn += z; p.qn += z; p.kn += z; p.wpa += z; p.wpb += z; p.bm += z; p.wout += z; p.fn += z; p.out += z; p.ws += z;
        const int tid = mk_tid();
        int G = gridDim.x, bx = blockIdx.x; asm volatile("" : "+s"(G), "+s"(bx));
        const int vcu = (G % 8 == 0) ? (bx % 8) * (G / 8) + bx / 8 : bx;
        const int lane = tid & 63, wid = __builtin_amdgcn_readfirstlane(tid >> 6);
        const int gw = bx * 8 + wid, ngw = G * 8, gt = bx * 512 + tid, ngt = G * 512;
        unsigned char* ws = p.ws;
        bf16_t* HB = (bf16_t*)(ws + OFF_H);
        float* SSQ = (float*)(ws + OFF_SSQ); bf16_t* HID = (bf16_t*)(ws + OFF_HID); bf16_t* Y = (bf16_t*)(ws + OFF_Y);
        if (PHON(11) && ph == 0) { prologue(p, gw, ngw, lane); conv_layer(p, 0, lds, gw, ngw, wid, lane); continue; }
        if (ph == NPH - 1) { final_norm(p, gw, ngw, lane); continue; }
        const int l = (ph - 1) / 10, s = (ph - 1) % 10;
        bf16_t* WT = (bf16_t*)((unsigned char*)p.out + OO_WT) + (size_t)(l & 1) * WT_END;
        if (PHON(0) && (s == 0 || s == 8)) {
            const int f = (s == 8);
            pg8::Gemm g{HB, WT + (f ? WT_GU1 : WT_GU0), MROWS, 5632, D, D}; MetaOrder S; S.init(5632, G, bx);
            EpiSwiglu E{HID, SSQ + (size_t)(3 * l + (f ? 2 : 0)) * MROWS * 16};
            pg8::gemm_phase<EpiSwiglu, MetaOrder, true, true>(lds, g, S, E);
        } else if (PHON(1) && (s == 1 || s == 7 || s == 9)) {
            pg8::Gemm g; float scale; int so;
            if (s == 1) { g = pg8::Gemm{HID, WT + WT_DN0, MROWS, D, DFF, DFF}; scale = 0.5f; so = 3 * l + 1; }
            else if (s == 9) { g = pg8::Gemm{HID, WT + WT_DN1, MROWS, D, DFF, DFF}; scale = 0.5f; so = 3 * l + 3; }
            else { g = pg8::Gemm{Y, WT + WT_OUT, MROWS, D, D, D}; scale = 1.0f; so = 3 * l + 2; }
            MetaOrder S; S.init(D, G, bx);
            EpiResid E{HB, SSQ + (size_t)so * MROWS * 16, scale};
            pg8::gemm_phase<EpiResid, MetaOrder, true, true>(lds, g, S, E);
        } else if (PHON(2) && s == 2) {
            pg8::Gemm g{HB, WT + WT_WIN, MROWS, WIN_N, D, D}; MetaOrder S; S.init(WIN_N, G, bx);
            EpiWin E{ws, SSQ + (size_t)(3 * l + 1) * MROWS * 16, p.bm + (size_t)l * 2048};
            pg8::gemm_phase<EpiWin, MetaOrder, true, true>(lds, g, S, E);
        } else if (PHON(3) && s == 3) {
            if (PHON(13)) gla_phase<false>(p, l, lds, bx, G);
        } else if (PHON(4) && s == 4) {
            if (PHON(15)) gla_scan(p, gt, ngt);
            if (PHON(12)) prep_qk(p, l, gt, ngt);
        } else if (PHON(5) && s == 5) {
            if (PHON(14)) attn_phase(p, l, lds, vcu, G);
            gla_pool(p, l, lds);
        } else if (PHON(6) && s == 6) {
            MetaOrder S; S.init(D, G, bx, 1);
            pg8::Gemm g{(const bf16_t*)(ws + OFF_RA), WT + WT_PA, MROWS, D, 1024, 512}; EpiMergeF E{Y, (const bf16_t*)(ws + OFF_GT)};
            pg8::gemm_phase<EpiMergeF, MetaOrder, true, true>(lds, g, S, E);
        }
    }
#ifdef MK_TIMING
    {
        unsigned* cnt = (unsigned*)(p0.ws + OFF_ROPE);
        grid.sync();
        if (blockIdx.x == 0 && threadIdx.x == 0) { *cnt = (unsigned)(tA * 10ull); __threadfence(); }
        grid.sync();
        const unsigned N = *(volatile unsigned*)cnt; float* o = p0.out;
        for (unsigned i = blockIdx.x * 512 + threadIdx.x; i < N; i += gridDim.x * 512) o[i] += 0.01f;
        if (blockIdx.x == 0 && threadIdx.x == 0) { const unsigned long long t0 = __builtin_amdgcn_s_memrealtime(); while (__builtin_amdgcn_s_memrealtime() - t0 < tB) __builtin_amdgcn_s_sleep(8); }
    }
#endif
}

extern "C" void kernel_launch(void* const* d_in, const int* in_sizes, int n_in, void* d_out, int out_size, void* d_ws, size_t ws_size, hipStream_t stream) {
    static int grid = 0;
    if (grid == 0) {
        if (n_in != 17 || in_sizes[0] != MX * D || out_size != MX * D || ws_size < WS_END) {
            fprintf(stderr, "kernel_launch: unexpected shapes (n_in %d, in0 %d, out %d, ws %zu, need %zu)\n", n_in, n_in > 0 ? in_sizes[0] : -1, out_size, ws_size, (size_t)WS_END); grid = -1; return; }
        int dev = 0, cus = 0, per_cu = 0;
        hipGetDevice(&dev); hipDeviceGetAttribute(&cus, hipDeviceAttributeMultiprocessorCount, dev);
        if (hipFuncSetAttribute((const void*)mk_fwd, hipFuncAttributeMaxDynamicSharedMemorySize, LDS_BYTES) != hipSuccess) { fprintf(stderr, "kernel_launch: hipFuncSetAttribute failed\n"); grid = -1; return; }
        if (hipOccupancyMaxActiveBlocksPerMultiprocessor(&per_cu, (const void*)mk_fwd, 512, LDS_BYTES) != hipSuccess || per_cu < 1) { fprintf(stderr, "kernel_launch: occupancy query says %d\n", per_cu); per_cu = 1; }
        (void)hipGetLastError();
        grid = cus;
    }
    if (grid < 0) return;
    Params p{};
    p.x = (const float*)d_in[0]; p.meta = (const float*)d_in[1]; p.ng = (const float*)d_in[2]; p.wg = (const float*)d_in[3]; p.wu = (const float*)d_in[4]; p.wd = (const float*)d_in[5];
    p.win = (const float*)d_in[6]; p.w2 = (const float*)d_in[7]; p.b2 = (const float*)d_in[8]; p.gn = (const float*)d_in[9]; p.qn = (const float*)d_in[10]; p.kn = (const float*)d_in[11];
    p.wpa = (const float*)d_in[12]; p.wpb = (const float*)d_in[13]; p.bm = (const float*)d_in[14]; p.wout = (const float*)d_in[15]; p.fn = (const float*)d_in[16];
    p.out = (float*)d_out; p.ws = (unsigned char*)d_ws;
    if (hipMemsetAsync((char*)d_ws + OFF_BAR, 0, 16384, stream) != hipSuccess) { fprintf(stderr, "kernel_launch: memset of the barrier words failed\n"); return; }
#if MK_SINGLE
    p.ph_lo = 0; p.ph_hi = NPH;
    { void* args[] = {&p}; hipError_t e = hipLaunchCooperativeKernel((const void*)mk_fwd, dim3(grid), dim3(512), args, LDS_BYTES, stream);
      if (e != hipSuccess) fprintf(stderr, "cooperative launch failed: %s\n", hipGetErrorString(e)); }
#else
    for (int ph = 0; ph < NPH; ++ph) { p.ph_lo = ph; p.ph_hi = ph + 1; void* args[] = {&p};
        hipError_t e = hipLaunchCooperativeKernel((const void*)mk_fwd, dim3(grid), dim3(512), args, LDS_BYTES, stream);
        if (e != hipSuccess) { fprintf(stderr, "cooperative launch %d failed: %s\n", ph, hipGetErrorString(e)); break; } }
#endif
}
```

```cpp
#include <hip/hip_runtime.h>
#include <hip/hip_cooperative_groups.h>
#include <cstdio>
#include <cstdint>
namespace cg = cooperative_groups;
__device__ __forceinline__ int mk_tid() { int t = threadIdx.x; asm volatile("" : "+v"(t)); return t; }
#define PG8_HALF_PM 128
namespace pg8 {
#define PG8_LAS __attribute__((address_space(3)))
typedef unsigned short bf16_t;
typedef short bf16x8 __attribute__((ext_vector_type(8)));
typedef float f32x4 __attribute__((ext_vector_type(4)));
typedef unsigned u32x4 __attribute__((ext_vector_type(4)));
constexpr int BM = 256, BK = 64, HALF = 128, HTB = HALF * BK * 2  , STAGE_BYTES = 8 * HTB, NXCD = 8, WGM = 8;

__host__ __device__ __forceinline__ int lds_byte(int r, int c) { const int st = (r >> 4) * 2 + (c >> 5), rr = r & 15, cc = c & 31, ob = rr * 64 + cc * 2; return st * 1024 + (ob ^ (((ob >> 9) & 1) << 5)); }
__host__ __device__ __forceinline__ void stage_rc(int b, int& R, int& C) { const int st = b / 1024, sb = b % 1024, swz = sb ^ (((sb >> 9) & 1) << 5); R = (st >> 1) * 16 + swz / 64; C = (st & 1) * 32 + (swz % 64) / 2; }
__host__ __device__ __forceinline__ int perm32(int rho) { const int n = rho >> 4, i = rho & 15; return 8 * (i >> 2) + 4 * n + (i & 3); }

struct Unit { int pm, pn, kh; };
struct Gemm { const bf16_t* A; const bf16_t* Bt; int M, N, K, KL; };

struct StaticOrder {
    int nM, nN, nwg, G, c;
    __host__ __device__ void init(int M, int N, int G_, int c_) { nM = M / BM; nN = N / BM; nwg = nM * nN; G = G_; c = c_; }
    __host__ __device__ bool next(int i, Unit& u) const {
        const long L = (long)i * G + c; if (L >= nwg) return false;
        int wgid = (int)L; { const int q = nwg / NXCD, r = nwg % NXCD, xcd = wgid % NXCD, off = wgid / NXCD; wgid = (xcd < r ? xcd * (q + 1) : r * (q + 1) + (xcd - r) * q) + off; }
        const int nig = WGM * nN, gid = wgid / nig, fm = gid * WGM, gsz = (nM - fm) < WGM ? (nM - fm) : WGM;
        u.pm = fm + ((wgid % nig) % gsz); u.pn = (wgid % nig) / gsz; u.kh = 0; return true;
    }
    __device__ __forceinline__ void a_ready(const Unit&) const {}
    __device__ __forceinline__ void done(const Unit&) const {}
};

__device__ __forceinline__ unsigned cvt_pk_bf16(float lo, float hi) { unsigned r; asm volatile("v_cvt_pk_bf16_f32 %0, %1, %2" : "=v"(r) : "v"(lo), "v"(hi)); return r; }
typedef float f32x2 __attribute__((ext_vector_type(2)));
template <class Epi, class Sched, bool ALIGN_EPI = false, bool SP2 = false>
__device__ __forceinline__ void gemm_phase(PG8_LAS unsigned char* lds, const Gemm g, const Sched& S, const Epi& E) {
    const int tid = mk_tid(), wid = __builtin_amdgcn_readfirstlane(tid >> 6), lane = tid & 63, wr = wid >> 2, wc = wid & 3, fr = lane & 15, fq = lane >> 4;
    const int K = g.K, nt = g.KL / BK;
    unsigned voffA[2], voffB[2];
#pragma unroll
    for (int i = 0; i < 2; ++i) { int R, C; stage_rc(tid * 16 + i * 8192, R, C); const int Rb = Epi::PERM ? ((R & ~31) + perm32(R & 31)) : R;
        voffA[i] = (unsigned)(R * K + C) * 2u; voffB[i] = (unsigned)(Rb * K + C) * 2u; }
    const size_t kstep = (size_t)(BK * 2);
    const size_t hstep = (size_t)HALF * K * 2;
    const size_t tstep = 2 * hstep;
    const unsigned ldsw = (unsigned)wid * 1024u;
    const int aoff = lds_byte(wr * 64 + fr, fq * 8), boff = lds_byte(wc * 32 + fr, fq * 8);
#define PG8_SA(b, h) (((b) * 2 + (h)) * HTB)
#define PG8_SB(b, h) ((4 + (b) * 2 + (h)) * HTB)
#define PG8_STAGE(bufoff, gbase, voff) do { _Pragma("unroll") for (int _i = 0; _i < 2; ++_i) \
        __builtin_amdgcn_global_load_lds((const unsigned*)((const char*)(gbase) + (voff)[_i]), (PG8_LAS unsigned*)(lds + (bufoff) + ldsw + _i * 8192), 16, 0, 0); } while (0)
#define PG8_LDA(dst, b, h) do { _Pragma("unroll") for (int m = 0; m < 4; ++m) _Pragma("unroll") for (int k = 0; k < 2; ++k) dst[m][k] = *(const PG8_LAS bf16x8*)(lds + PG8_SA(b, h) + aoff + m * 2048 + k * 1024); } while (0)
#define PG8_LDB(dst, b, h) do { _Pragma("unroll") for (int n = 0; n < 2; ++n) _Pragma("unroll") for (int k = 0; k < 2; ++k) dst[n][k] = *(const PG8_LAS bf16x8*)(lds + PG8_SB(b, h) + boff + n * 2048 + k * 1024); } while (0)
#define PG8_MMA(ai, bj, At, Bt) do { __builtin_amdgcn_s_setprio(1); _Pragma("unroll") for (int m = 0; m < 4; ++m) _Pragma("unroll") for (int n = 0; n < 2; ++n) _Pragma("unroll") for (int k = 0; k < 2; ++k) \
        acc[ai][bj][m][n] = __builtin_amdgcn_mfma_f32_16x16x32_bf16(Bt[n][k], At[m][k], acc[ai][bj][m][n], 0, 0, 0); __builtin_amdgcn_s_setprio(0); } while (0)
#define PG8_WAIT_V(n) asm volatile("s_waitcnt vmcnt(" #n ")" ::: "memory")
#define PG8_WAIT_L(n) asm volatile("s_waitcnt lgkmcnt(" #n ")" ::: "memory")
#define PG8_BAR __builtin_amdgcn_s_barrier()
#define PG8_SCHED __builtin_amdgcn_sched_barrier(0)
    Unit cur, nxt; int ui = 0;
    if (!S.next(0, cur)) return;
    f32x4 acc[2][2][4][2];
#pragma unroll
    for (int a = 0; a < 2; ++a)
#pragma unroll
        for (int b = 0; b < 2; ++b)
#pragma unroll
            for (int m = 0; m < 4; ++m)
#pragma unroll
                for (int n = 0; n < 2; ++n) acc[a][b][m][n] = (f32x4){0.f, 0.f, 0.f, 0.f};
    bf16x8 At[4][2], B0[2][2], B1[2][2];
    const size_t khb = (size_t)g.KL * 2;
    const char* cA = (const char*)g.A + (size_t)cur.pm * tstep + cur.kh * khb; const char* cB = (const char*)g.Bt + (size_t)cur.pn * tstep + cur.kh * khb;
    S.a_ready(cur);
    if constexpr (SP2) {
        PG8_STAGE(PG8_SB(0, 0), cB, voffB); PG8_STAGE(PG8_SB(0, 1), cB + hstep, voffB); PG8_STAGE(PG8_SA(0, 0), cA, voffA); PG8_STAGE(PG8_SA(0, 1), cA + hstep, voffA);
        if (wr == 1) PG8_BAR;
        PG8_WAIT_V(2); PG8_BAR;
        PG8_STAGE(PG8_SB(1, 0), cB + kstep, voffB); PG8_STAGE(PG8_SA(1, 0), cA + kstep, voffA); PG8_STAGE(PG8_SB(1, 1), cB + hstep + kstep, voffB);
        PG8_WAIT_V(6); PG8_BAR;
    } else {
        PG8_STAGE(PG8_SB(0, 0), cB, voffB); PG8_STAGE(PG8_SA(0, 0), cA, voffA); PG8_STAGE(PG8_SB(0, 1), cB + hstep, voffB); PG8_STAGE(PG8_SA(0, 1), cA + hstep, voffA);
        if (wr == 1) PG8_BAR;
        PG8_WAIT_V(4); PG8_BAR;
        PG8_STAGE(PG8_SB(1, 0), cB + kstep, voffB); PG8_STAGE(PG8_SA(1, 0), cA + kstep, voffA); PG8_STAGE(PG8_SB(1, 1), cB + hstep + kstep, voffB);
        PG8_WAIT_V(6); PG8_BAR;
    }
    for (;;) {
        const bool has_next = S.next(ui + 1, nxt);
        const bool full_unit = (cur.pm != PG8_HALF_PM);
        const char* nA = has_next ? (const char*)g.A + (size_t)nxt.pm * tstep + nxt.kh * khb : cA; const char* nB = has_next ? (const char*)g.Bt + (size_t)nxt.pn * tstep + nxt.kh * khb : cB;
        for (int t = 0; t < nt; t += 2) {
            const bool last = (t == nt - 2);
            const char* a1 = cA + (size_t)(t + 1) * kstep;
            const char* a2 = last ? nA : cA + (size_t)(t + 2) * kstep; const char* b2 = last ? nB : cB + (size_t)(t + 2) * kstep;
            const char* a3 = a2 + kstep; const char* b3 = b2 + kstep;
            if (last && has_next) S.a_ready(nxt);
            if constexpr (SP2) {
            PG8_LDB(B0, 0, 0); PG8_LDB(B1, 0, 1); PG8_SCHED; PG8_LDA(At, 0, 0); PG8_STAGE(PG8_SA(1, 1), a1 + hstep, voffA);
            PG8_WAIT_V(8); PG8_WAIT_L(0); PG8_BAR; PG8_MMA(0, 0, At, B0); PG8_MMA(0, 1, At, B1); PG8_BAR; PG8_SCHED;
            PG8_LDA(At, 0, 1); PG8_STAGE(PG8_SB(0, 0), b2, voffB); PG8_STAGE(PG8_SB(0, 1), b2 + hstep, voffB); PG8_STAGE(PG8_SA(0, 0), a2, voffA);
            PG8_WAIT_V(8); PG8_WAIT_L(0); PG8_BAR; if (full_unit) { PG8_MMA(1, 0, At, B0); PG8_MMA(1, 1, At, B1); } PG8_BAR; PG8_SCHED;
            PG8_LDB(B0, 1, 0); PG8_LDB(B1, 1, 1); PG8_SCHED; PG8_LDA(At, 1, 0); PG8_STAGE(PG8_SA(0, 1), a2 + hstep, voffA);
            PG8_WAIT_V(8); PG8_WAIT_L(0); PG8_BAR; PG8_MMA(0, 0, At, B0); PG8_MMA(0, 1, At, B1); PG8_BAR; PG8_SCHED;
            PG8_LDA(At, 1, 1); PG8_STAGE(PG8_SB(1, 0), b3, voffB); PG8_STAGE(PG8_SB(1, 1), b3 + hstep, voffB); PG8_STAGE(PG8_SA(1, 0), a3, voffA);
            PG8_WAIT_V(8); PG8_WAIT_L(0); PG8_BAR; if (full_unit) { PG8_MMA(1, 0, At, B0); PG8_MMA(1, 1, At, B1); } PG8_BAR; PG8_SCHED;
            } else {
            PG8_LDB(B0, 0, 0); PG8_SCHED; PG8_LDA(At, 0, 0); PG8_STAGE(PG8_SA(1, 1), a1 + hstep, voffA);
            PG8_WAIT_L(8); PG8_BAR; PG8_WAIT_L(0); PG8_MMA(0, 0, At, B0); PG8_BAR; PG8_SCHED;
            PG8_LDB(B1, 0, 1); PG8_STAGE(PG8_SB(0, 0), b2, voffB);
            PG8_BAR; PG8_WAIT_L(0); PG8_MMA(0, 1, At, B1); PG8_BAR;
            PG8_LDA(At, 0, 1); PG8_STAGE(PG8_SA(0, 0), a2, voffA);
            PG8_BAR; PG8_WAIT_L(0); PG8_MMA(1, 0, At, B0); PG8_BAR; PG8_SCHED;
            PG8_STAGE(PG8_SB(0, 1), b2 + hstep, voffB);
            PG8_WAIT_V(6); PG8_BAR; PG8_MMA(1, 1, At, B1); PG8_BAR;
            PG8_LDB(B0, 1, 0); PG8_SCHED; PG8_LDA(At, 1, 0); PG8_STAGE(PG8_SA(0, 1), a2 + hstep, voffA);
            PG8_WAIT_L(8); PG8_BAR; PG8_WAIT_L(0); PG8_MMA(0, 0, At, B0); PG8_BAR; PG8_SCHED;
            PG8_LDB(B1, 1, 1); PG8_STAGE(PG8_SB(1, 0), b3, voffB);
            PG8_BAR; PG8_WAIT_L(0); PG8_MMA(0, 1, At, B1); PG8_BAR;
            PG8_LDA(At, 1, 1); PG8_STAGE(PG8_SA(1, 0), a3, voffA);
            PG8_BAR; PG8_WAIT_L(0); PG8_MMA(1, 0, At, B0); PG8_BAR; PG8_SCHED;
            PG8_STAGE(PG8_SB(1, 1), b3 + hstep, voffB);
            PG8_WAIT_V(6); PG8_BAR; PG8_MMA(1, 1, At, B1); PG8_BAR;
            }
        }
        if constexpr (ALIGN_EPI) { if (wr == 0) PG8_BAR; }
        bool keep_acc = false;
        if constexpr (Epi::MIDK) { if (cur.kh == 0) { E.mid(acc, cur, wr, wc, fr, fq); keep_acc = true; } }
        if constexpr (!Epi::AFTER_DRAIN) { if (!keep_acc) { E(acc, cur, wr, wc, fr, fq); S.done(cur); } }
        if (!has_next) break;
        if (!keep_acc)
#pragma unroll
        for (int a = 0; a < 2; ++a)
#pragma unroll
            for (int b = 0; b < 2; ++b)
#pragma unroll
                for (int m = 0; m < 4; ++m)
#pragma unroll
                    for (int n = 0; n < 2; ++n) acc[a][b][m][n] = (f32x4){0.f, 0.f, 0.f, 0.f};
        cur = nxt; cA = nA; cB = nB; ++ui;
        if constexpr (ALIGN_EPI) { if (wr == 1) PG8_BAR; }
    }
    PG8_WAIT_V(0);
    if constexpr (!ALIGN_EPI) { if (wr == 0) PG8_BAR; }
    PG8_BAR;
    if constexpr (Epi::AFTER_DRAIN) { E.fused(acc, cur, wr, wc, fr, fq, lds, wid, lane); S.done(cur); }
#undef PG8_SA
#undef PG8_SB
#undef PG8_STAGE
#undef PG8_LDA
#undef PG8_LDB
#undef PG8_MMA
#undef PG8_WAIT_V
#undef PG8_WAIT_L
#undef PG8_BAR
#undef PG8_SCHED
}
}
#ifndef PH_MASK
#define PH_MASK 0xffff
#endif
#define PHON(k) ((PH_MASK >> (k)) & 1)
#ifndef MK_SINGLE
#define MK_SINGLE 1
#endif
#define LAS __attribute__((address_space(3)))
typedef unsigned short bf16_t;
typedef short bf16x8 __attribute__((ext_vector_type(8)));
typedef float f32x4 __attribute__((ext_vector_type(4)));
typedef float f32x16 __attribute__((ext_vector_type(16)));
typedef unsigned u32x4 __attribute__((ext_vector_type(4)));
typedef unsigned u32x2 __attribute__((ext_vector_type(2)));

constexpr int D = 1024, NB = 8, SEQ = 4096, DEPTH = 4, NMETA = 16, DFF = 2816, DIN = 4384;
constexpr int MX = NB * SEQ;
constexpr int MROWS = MX + 256;
constexpr int NVALID = MX + NB * NMETA;
constexpr int LP = 4160;
constexpr int NCH = 65;
constexpr float EPS = 1e-6f;
constexpr float LOG2E = 1.4426950408889634f;
constexpr int WIN_N = 4608;
constexpr int NPH = 42;

constexpr size_t SZ_H = (size_t)MROWS * D * 4, SZ_512 = (size_t)MROWS * 512 * 2, SZ_128 = (size_t)MROWS * 128 * 2;
constexpr size_t SZ_VT = (size_t)NB * 2 * 64 * LP * 2, SZ_LR = (size_t)MROWS * 32 * 4, SZ_GT = (size_t)MROWS * 2048 * 2;
constexpr size_t OFF_H = 0;
constexpr size_t OFF_QKA = OFF_H + SZ_H, OFF_VA = OFF_QKA + SZ_512, OFF_RA = OFF_VA + SZ_512, OFF_QB = OFF_RA + SZ_512;
constexpr size_t OFF_KB = OFF_QB + SZ_512, OFF_VT = OFF_KB + SZ_128, OFF_LR = OFF_VT + SZ_VT, OFF_GT = OFF_LR + SZ_LR, R_END = OFF_GT + SZ_GT;
constexpr size_t OFF_HID = OFF_QKA;
constexpr size_t OFF_Y = OFF_QKA;
static_assert((size_t)MROWS * DFF * 2 <= R_END - OFF_QKA, "hid overlay");
constexpr size_t SZ_S = (size_t)64 * NCH * 8192 * 2, SZ_DEC = (size_t)64 * NCH * 64 * 4, SZ_SSQ = (size_t)13 * MROWS * 16 * 4, SZ_ROPE = (size_t)SEQ * 64 * 4;
constexpr size_t OFF_S = R_END, OFF_DEC = OFF_S + SZ_S, OFF_SSQ = OFF_DEC + SZ_DEC, OFF_ROPE = OFF_SSQ + SZ_SSQ, OFF_CTR = OFF_ROPE + SZ_ROPE, OFF_BAR = OFF_CTR + 4096, WS_END = OFF_BAR + 16384;
constexpr size_t OO_WT = 0;
constexpr size_t WT_GU0 = 0, WT_DN0 = WT_GU0 + (size_t)5632 * 1024, WT_WIN = WT_DN0 + (size_t)1024 * 2816, WT_PA = WT_WIN + (size_t)WIN_N * 1024,
                 WT_PB = WT_PA + (size_t)1024 * 512, WT_OUT = WT_PB + (size_t)1024 * 512, WT_GU1 = WT_OUT + (size_t)1024 * 1024, WT_DN1 = WT_GU1 + (size_t)5632 * 1024,
                 WT_END = WT_DN1 + (size_t)1024 * 2816;
static_assert(OO_WT + 2 * WT_END * 2 <= (size_t)MX * D * 4, "d_out scratch");

constexpr int LDS_BYTES = 147456;

struct Params {
    const float *x, *meta, *ng, *wg, *wu, *wd, *win, *w2, *b2, *gn, *qn, *kn, *wpa, *wpb, *bm, *wout, *fn;
    float* out; unsigned char* ws; int ph_lo, ph_hi;
};

typedef float f32x2_t __attribute__((ext_vector_type(2))); typedef __bf16 bf16x2_t __attribute__((ext_vector_type(2)));
__device__ __forceinline__ unsigned pk(float lo, float hi) { f32x2_t v = {lo, hi}; bf16x2_t b = __builtin_convertvector(v, bf16x2_t); return __builtin_bit_cast(unsigned, b); }
__device__ __forceinline__ float bflo(unsigned w) { return __uint_as_float(w << 16); }
__device__ __forceinline__ float bfhi(unsigned w) { return __uint_as_float(w & 0xffff0000u); }
__device__ __forceinline__ float bf1(unsigned short b) { return __uint_as_float((unsigned)b << 16); }
__device__ __forceinline__ unsigned short f2bf(float f) { return (unsigned short)(pk(f, 0.f) & 0xffffu); }
__device__ __forceinline__ float fexp(float x) { return __builtin_amdgcn_exp2f(x * LOG2E); }
__device__ __forceinline__ float sigm(float x) { return __builtin_amdgcn_rcpf(1.f + fexp(-x)); }
__device__ __forceinline__ float siluf(float x) { return x * sigm(x); }
__device__ __forceinline__ float rstd_row(const float* ssq, int row) {
    const f32x4* q = (const f32x4*)(ssq + (size_t)row * 16); const f32x4 a = q[0], b = q[1], c = q[2], d = q[3];
    const float t = ((a[0] + a[1]) + (a[2] + a[3])) + ((b[0] + b[1]) + (b[2] + b[3])) + ((c[0] + c[1]) + (c[2] + c[3])) + ((d[0] + d[1]) + (d[2] + d[3]));
    return __builtin_amdgcn_rsqf(t * (1.0f / D) + EPS); }
#define LDS_WAIT() asm volatile("s_waitcnt lgkmcnt(0)" ::: "memory")
#define DPPF(old, src, ctrl, rmask, bmask, bc) __builtin_bit_cast(float, __builtin_amdgcn_update_dpp(__builtin_bit_cast(int, (float)(old)), __builtin_bit_cast(int, (float)(src)), ctrl, rmask, bmask, bc))
__device__ __forceinline__ float wave_incl_scan(float v) {
    v += DPPF(0.f, v, 0x111, 0xf, 0xf, true); v += DPPF(0.f, v, 0x112, 0xf, 0xf, true); v += DPPF(0.f, v, 0x114, 0xf, 0xf, true); v += DPPF(0.f, v, 0x118, 0xf, 0xf, true);
    v += DPPF(0.f, v, 0x142, 0xa, 0xf, false); v += DPPF(0.f, v, 0x143, 0xc, 0xf, false); return v; }
__device__ __forceinline__ float lane_bcast(float v, int l) { return __builtin_bit_cast(float, __builtin_amdgcn_readlane(__builtin_bit_cast(int, v), l)); }

struct MetaOrder {
    pg8::StaticOrder main; int nN, c, G, nmain, dbl;
    __device__ __forceinline__ void init(int N, int G_, int c_, int dbl_ = 0) { main.init(MX, N, G_, c_); nN = N / 256; c = c_; G = G_; dbl = dbl_; const int nw = 128 * nN; nmain = (c_ < nw) ? (nw - c_ + G_ - 1) / G_ : 0; }
    __device__ __forceinline__ bool next(int ii, pg8::Unit& u) const {
        const int i = dbl ? (ii >> 1) : ii, kh = dbl ? (ii & 1) : 0;
        if (i < nmain) { const bool ok = main.next(i, u); u.kh = kh; return ok; }
        const int j = (i - nmain) * G + c; if (j >= nN) return false;
        u.pm = PG8_HALF_PM; u.pn = j; u.kh = kh; return true; }
    __device__ __forceinline__ void a_ready(const pg8::Unit&) const {}
    __device__ __forceinline__ void done(const pg8::Unit&) const {}
};

struct EpiSwiglu {
    static constexpr bool PERM = true, AFTER_DRAIN = false, MIDK = false;
    bf16_t* O; const float* ssq;
    __device__ __forceinline__ void operator()(const f32x4 (&acc)[2][2][4][2], const pg8::Unit& u, int wr, int wc, int fr, int fq) const {
        int row0 = u.pm * 256 + wr * 64 + fr; asm volatile("" : "+v"(row0)); const int col0 = u.pn * 128 + wc * 32 + 8 * fq;
#pragma unroll
        for (int ai = 0; ai < 2; ++ai)
#pragma unroll
            for (int m = 0; m < 4; ++m) {
                if (ai == 1 && u.pm == PG8_HALF_PM) continue;
                const int row = row0 + ai * 128 + m * 16; const float rs = rstd_row(ssq, row);
                float h[8];
#pragma unroll
                for (int n = 0; n < 2; ++n)
#pragma unroll
                    for (int e = 0; e < 4; ++e) { const float g = acc[ai][0][m][n][e] * rs, up = acc[ai][1][m][n][e] * rs; h[n * 4 + e] = siluf(g) * up; }
                u32x4 w; w.x = pk(h[0], h[1]); w.y = pk(h[2], h[3]); w.z = pk(h[4], h[5]); w.w = pk(h[6], h[7]);
                *(u32x4*)(O + (size_t)row * DFF + col0) = w;
                asm volatile("" ::: "memory");
            }
    }
};
struct EpiResid {
    static constexpr bool PERM = true, AFTER_DRAIN = false, MIDK = false;
    bf16_t* HB; float* ssq_out; float scale;
    __device__ __forceinline__ void operator()(const f32x4 (&acc)[2][2][4][2], const pg8::Unit& u, int wr, int wc, int fr, int fq) const {
        int row0 = u.pm * 256 + wr * 64 + fr; asm volatile("" : "+v"(row0)); const int col0 = u.pn * 256 + wc * 32 + 8 * fq;
#pragma unroll
        for (int ai = 0; ai < 2; ++ai)
#pragma unroll
            for (int m = 0; m < 4; ++m) {
                if (ai == 1 && u.pm == PG8_HALF_PM) continue;
                const int row = row0 + ai * 128 + m * 16; float ss = 0.f;
#pragma unroll
                for (int bj = 0; bj < 2; ++bj) {
                    bf16_t* hp = HB + (size_t)row * D + col0 + bj * 128;
                    const u32x4 hw = *(const u32x4*)hp;
                    f32x4 h0 = (f32x4){bflo(hw.x), bfhi(hw.x), bflo(hw.y), bfhi(hw.y)}, h1 = (f32x4){bflo(hw.z), bfhi(hw.z), bflo(hw.w), bfhi(hw.w)};
                    h0 = h0 + acc[ai][bj][m][0] * scale; h1 = h1 + acc[ai][bj][m][1] * scale;
                    u32x4 w; w.x = pk(h0[0], h0[1]); w.y = pk(h0[2], h0[3]); w.z = pk(h1[0], h1[1]); w.w = pk(h1[2], h1[3]);
                    *(u32x4*)hp = w;
                    ss += (h0[0] * h0[0] + h0[1] * h0[1]) + (h0[2] * h0[2] + h0[3] * h0[3]) + (h1[0] * h1[0] + h1[1] * h1[1]) + (h1[2] * h1[2] + h1[3] * h1[3]);
                }
                ss += __shfl_xor(ss, 16); ss += __shfl_xor(ss, 32);
                if (fq == 0) ssq_out[(size_t)row * 16 + u.pn * 4 + wc] = ss;
                asm volatile("" ::: "memory");
            }
    }
};
struct EpiWin {
    static constexpr bool PERM = true, AFTER_DRAIN = false, MIDK = false;
    unsigned char* ws; const float* ssq; const float* bm;
    __device__ __forceinline__ void operator()(const f32x4 (&acc)[2][2][4][2], const pg8::Unit& u, int wr, int wc, int fr, int fq) const {
        int row0 = u.pm * 256 + wr * 64 + fr; asm volatile("" : "+v"(row0)); const int cw = wc * 32 + 8 * fq, pn = u.pn;
#pragma unroll
        for (int ai = 0; ai < 2; ++ai)
#pragma unroll
            for (int m = 0; m < 4; ++m) {
                if (ai == 1 && u.pm == PG8_HALF_PM) continue;
                const int row = row0 + ai * 128 + m * 16; const float rs = rstd_row(ssq, row);
                if (pn < 8) {
                    bf16_t* base = (pn < 4) ? (bf16_t*)(ws + OFF_QKA + (size_t)(pn >> 1) * SZ_512) + (size_t)row * 512 + (pn & 1) * 256 + cw
                                            : (bf16_t*)(ws + OFF_RA) + (size_t)row * 1024 + (pn - 4) * 256 + cw;
                    const float sc = (pn == 0) ? rs * 0.125f : rs; const bool gate = (pn == 4 || pn == 5);
#pragma unroll
                    for (int bj = 0; bj < 2; ++bj) { f32x4 a = acc[ai][bj][m][0] * sc, b = acc[ai][bj][m][1] * sc;
                        if (gate) { a = (f32x4){siluf(a[0]), siluf(a[1]), siluf(a[2]), siluf(a[3])}; b = (f32x4){siluf(b[0]), siluf(b[1]), siluf(b[2]), siluf(b[3])}; }
                        u32x4 w; w.x = pk(a[0], a[1]); w.y = pk(a[2], a[3]); w.z = pk(b[0], b[1]); w.w = pk(b[2], b[3]); *(u32x4*)(base + bj * 128) = w; }
                } else if (pn == 8) {
                    { const f32x4 a = acc[ai][0][m][0] * rs, b = acc[ai][0][m][1] * rs;
                      u32x4 w; w.x = pk(a[0], a[1]); w.y = pk(a[2], a[3]); w.z = pk(b[0], b[1]); w.w = pk(b[2], b[3]); *(u32x4*)((bf16_t*)(ws + OFF_KB) + (size_t)row * 128 + cw) = w; }
                    if (row < NVALID) {
                        int bb, pos; if (row < MX) { bb = row >> 12; pos = 64 + (row & 4095); } else { bb = (row - MX) >> 4; pos = 48 + ((row - MX) & 15); }
                        const int kvh = cw >> 6, d0 = cw & 63;
                        bf16_t* vt = (bf16_t*)(ws + OFF_VT) + ((size_t)(bb * 2 + kvh) * 64 + d0) * LP + pos;
#pragma unroll
                        for (int n = 0; n < 2; ++n)
#pragma unroll
                            for (int e = 0; e < 4; ++e) vt[(size_t)(n * 4 + e) * LP] = f2bf(acc[ai][1][m][n][e] * rs);
                    }
                } else if (pn == 9) {
                    if (wc == 0) { float* lp = (float*)(ws + OFF_LR) + (size_t)row * 32 + 8 * fq; *(f32x4*)lp = acc[ai][0][m][0] * rs; *(f32x4*)(lp + 4) = acc[ai][0][m][1] * rs; }
                } else {
                    const int gc = (pn - 10) * 256 + cw; bf16_t* base = (bf16_t*)(ws + OFF_GT) + (size_t)row * 2048 + gc;
#pragma unroll
                    for (int bj = 0; bj < 2; ++bj) { const f32x4 b0 = *(const f32x4*)(bm + gc + bj * 128), b1 = *(const f32x4*)(bm + gc + bj * 128 + 4);
                        const f32x4 a = acc[ai][bj][m][0] * rs + b0, b = acc[ai][bj][m][1] * rs + b1;
                        u32x4 w; w.x = pk(sigm(a[0]), sigm(a[1])); w.y = pk(sigm(a[2]), sigm(a[3])); w.z = pk(sigm(b[0]), sigm(b[1])); w.w = pk(sigm(b[2]), sigm(b[3])); *(u32x4*)(base + bj * 128) = w; }
                }
                asm volatile("" ::: "memory");
            }
    }
};
struct EpiMergeF {
    static constexpr bool PERM = true, AFTER_DRAIN = false, MIDK = true;
    bf16_t* Y; const bf16_t* G;
    __device__ __forceinline__ void mid(f32x4 (&acc)[2][2][4][2], const pg8::Unit& u, int wr, int wc, int fr, int fq) const {
        int row0 = u.pm * 256 + wr * 64 + fr; asm volatile("" : "+v"(row0)); const int col0 = u.pn * 256 + wc * 32 + 8 * fq;
#pragma unroll
        for (int ai = 0; ai < 2; ++ai)
#pragma unroll
            for (int m = 0; m < 4; ++m) {
                if (ai == 1 && u.pm == PG8_HALF_PM) continue;
                const int row = row0 + ai * 128 + m * 16;
#pragma unroll
                for (int bj = 0; bj < 2; ++bj) { const int col = col0 + bj * 128;
                    const u32x4 ga = *(const u32x4*)(G + (size_t)row * 2048 + col), gb = *(const u32x4*)(G + (size_t)row * 2048 + 1024 + col);
                    f32x4 r0, r1;
                    r0[0] = bflo(ga.x) * __builtin_amdgcn_rcpf(bflo(gb.x)); r0[1] = bfhi(ga.x) * __builtin_amdgcn_rcpf(bfhi(gb.x)); r0[2] = bflo(ga.y) * __builtin_amdgcn_rcpf(bflo(gb.y)); r0[3] = bfhi(ga.y) * __builtin_amdgcn_rcpf(bfhi(gb.y));
                    r1[0] = bflo(ga.z) * __builtin_amdgcn_rcpf(bflo(gb.z)); r1[1] = bfhi(ga.z) * __builtin_amdgcn_rcpf(bfhi(gb.z)); r1[2] = bflo(ga.w) * __builtin_amdgcn_rcpf(bflo(gb.w)); r1[3] = bfhi(ga.w) * __builtin_amdgcn_rcpf(bfhi(gb.w));
                    acc[ai][bj][m][0] = acc[ai][bj][m][0] * r0; acc[ai][bj][m][1] = acc[ai][bj][m][1] * r1;
                }
                asm volatile("" ::: "memory");
            }
    }
    __device__ __forceinline__ void operator()(const f32x4 (&acc)[2][2][4][2], const pg8::Unit& u, int wr, int wc, int fr, int fq) const {
        int row0 = u.pm * 256 + wr * 64 + fr; asm volatile("" : "+v"(row0)); const int col0 = u.pn * 256 + wc * 32 + 8 * fq;
#pragma unroll
        for (int ai = 0; ai < 2; ++ai)
#pragma unroll
            for (int m = 0; m < 4; ++m) {
                if (ai == 1 && u.pm == PG8_HALF_PM) continue;
                const int row = row0 + ai * 128 + m * 16;
#pragma unroll
                for (int bj = 0; bj < 2; ++bj) { const int col = col0 + bj * 128;
                    const u32x4 gb = *(const u32x4*)(G + (size_t)row * 2048 + 1024 + col);
                    float v[8];
                    v[0] = bflo(gb.x) * acc[ai][bj][m][0][0]; v[1] = bfhi(gb.x) * acc[ai][bj][m][0][1]; v[2] = bflo(gb.y) * acc[ai][bj][m][0][2]; v[3] = bfhi(gb.y) * acc[ai][bj][m][0][3];
                    v[4] = bflo(gb.z) * acc[ai][bj][m][1][0]; v[5] = bfhi(gb.z) * acc[ai][bj][m][1][1]; v[6] = bflo(gb.w) * acc[ai][bj][m][1][2]; v[7] = bfhi(gb.w) * acc[ai][bj][m][1][3];
                    u32x4 w; w.x = pk(v[0], v[1]); w.y = pk(v[2], v[3]); w.z = pk(v[4], v[5]); w.w = pk(v[6], v[7]); *(u32x4*)(Y + (size_t)row * D + col) = w;
                }
                asm volatile("" ::: "memory");
            }
    }
};

__device__ __forceinline__ void conv_item(const float* W, int N, int K, int src_n0, const float* gain, bf16_t* WT, int n0, int k0, LAS float* scr, int lane, int dk = 0) {
#pragma unroll
    for (int i = 0; i < 8; ++i) { const int kk = 8 * i + (lane >> 3), n4 = (lane & 7) * 4; f32x4 v = (f32x4){0.f, 0.f, 0.f, 0.f};
        if (src_n0 >= 0) { v = *(const f32x4*)(W + (size_t)(k0 + kk) * N + src_n0 + n4); if (gain) v = v * gain[k0 + kk]; }
        scr[kk * 33 + n4] = v[0]; scr[kk * 33 + n4 + 1] = v[1]; scr[kk * 33 + n4 + 2] = v[2]; scr[kk * 33 + n4 + 3] = v[3]; }
    LDS_WAIT(); __builtin_amdgcn_wave_barrier();
    const int c = lane & 7;
#pragma unroll
    for (int j = 0; j < 4; ++j) { const int n = (lane >> 3) + 8 * j; const LAS float* s = scr + (8 * c) * 33 + n;
        u32x4 o; o.x = pk(s[0 * 33], s[1 * 33]); o.y = pk(s[2 * 33], s[3 * 33]); o.z = pk(s[4 * 33], s[5 * 33]); o.w = pk(s[6 * 33], s[7 * 33]);
        *(u32x4*)(WT + (size_t)(n0 + n) * K + dk + k0 + 8 * c) = o; }
    LDS_WAIT(); __builtin_amdgcn_wave_barrier();
}
__device__ __forceinline__ int conv_win_src(int n0) {
    if (n0 < 1536) return n0;
    if (n0 < 2304) return n0 + 32;
    if (n0 == 2304) return 1536;
    if (n0 < 2560) return -1;
    return n0 - 224;
}
constexpr int CV_GU = 16 * 176, CV_DN = 44 * 32, CV_WIN = 16 * 144, CV_P = 8 * 32, CV_O = 16 * 32;
constexpr int CV_NIT = 2 * CV_GU + 2 * CV_DN + CV_WIN + 2 * CV_P + CV_O;
__device__ __forceinline__ void conv_one(const Params& p, int l, int it, LAS float* scr, int lane) {
    bf16_t* WT = (bf16_t*)((unsigned char*)p.out + OO_WT) + (size_t)(l & 1) * WT_END;
    int r = it;
    if (r < 2 * CV_GU) { const int f = r / CV_GU; r -= f * CV_GU; const int kb = r / 176, nb = r % 176, n0 = nb * 32;
        const int t = n0 >> 8, half = (n0 >> 7) & 1, j0 = n0 & 127;
        const float* W = (half ? p.wu : p.wg) + (size_t)(l * 2 + f) * D * DFF;
        conv_item(W, DFF, D, 128 * t + j0, p.ng + (size_t)(l * 3 + (f ? 2 : 0)) * D, WT + (f ? WT_GU1 : WT_GU0), n0, kb * 64, scr, lane); return; }
    r -= 2 * CV_GU;
    if (r < 2 * CV_DN) { const int f = r / CV_DN; r -= f * CV_DN; const int kb = r / 32, nb = r % 32;
        conv_item(p.wd + (size_t)(l * 2 + f) * DFF * D, D, DFF, nb * 32, nullptr, WT + (f ? WT_DN1 : WT_DN0), nb * 32, kb * 64, scr, lane); return; }
    r -= 2 * CV_DN;
    if (r < CV_WIN) { const int kb = r / 144, nb = r % 144;
        conv_item(p.win + (size_t)l * D * DIN, DIN, D, conv_win_src(nb * 32), p.ng + (size_t)(l * 3 + 1) * D, WT + WT_WIN, nb * 32, kb * 64, scr, lane); return; }
    r -= CV_WIN;
    if (r < 2 * CV_P) { const int f = r / CV_P; r -= f * CV_P; const int kb = r / 32, nb = r % 32;
        conv_item((f ? p.wpb : p.wpa) + (size_t)l * 512 * D, D, 1024, nb * 32, nullptr, WT + WT_PA, nb * 32, kb * 64, scr, lane, f * 512); return; }
    r -= 2 * CV_P;
    { const int kb = r / 32, nb = r % 32; conv_item(p.wout + (size_t)l * D * D, D, D, nb * 32, nullptr, WT + WT_OUT, nb * 32, kb * 64, scr, lane); }
}
__device__ __forceinline__ void conv_layer(const Params& p, int l, LAS unsigned char* lds, int gw, int ngw, int wid, int lane) {
    LAS float* scr = (LAS float*)(lds + wid * 8448);
    for (int it = gw; it < CV_NIT; it += ngw) conv_one(p, l, it, scr, lane);
}

__device__ __forceinline__ float wave_sum(float v) {
#pragma unroll
    for (int o = 1; o < 64; o <<= 1) v += __shfl_xor(v, o);
    return v;
}
__device__ __forceinline__ void prologue(const Params& p, int gw, int ngw, int lane) {
    bf16_t* HB = (bf16_t*)(p.ws + OFF_H); float* SSQ = (float*)(p.ws + OFF_SSQ);
    for (int row = gw; row < MROWS; row += ngw) {
        f32x4 v[4]; float s = 0.f;
#pragma unroll
        for (int j = 0; j < 4; ++j) {
            if (row < MX) v[j] = *((const f32x4*)(p.x + (size_t)row * D) + lane + 64 * j);
            else if (row < NVALID) v[j] = *((const f32x4*)(p.meta + (size_t)((row - MX) & 15) * D) + lane + 64 * j);
            else v[j] = (f32x4){0.f, 0.f, 0.f, 0.f};
            s += (v[j][0] * v[j][0] + v[j][1] * v[j][1]) + (v[j][2] * v[j][2] + v[j][3] * v[j][3]);
        }
        s = wave_sum(s);
#pragma unroll
        for (int j = 0; j < 4; ++j) {
            u32x2 w; w.x = pk(v[j][0], v[j][1]); w.y = pk(v[j][2], v[j][3]); *((u32x2*)(HB + (size_t)row * D) + lane + 64 * j) = w; }
        if (lane < 16) SSQ[(size_t)row * 16 + lane] = (lane == 0) ? s : 0.f;
    }
    const int gt = gw * 64 + lane, ngt = ngw * 64;
    float* ROPE = (float*)(p.ws + OFF_ROPE);
    for (int i = gt; i < SEQ * 32; i += ngt) { const int t = i >> 5, f = i & 31, fi = f & 15; const float pos = (float)((f < 16) ? (t >> 6) : (t & 63));
        const float inv = exp2f(-(float)fi * (13.287712379549449f / 16.0f)); float rev = pos * inv * 0.15915494309189535f; rev -= floorf(rev);
        ROPE[t * 64 + f] = __builtin_amdgcn_cosf(rev); ROPE[t * 64 + 32 + f] = __builtin_amdgcn_sinf(rev); }
    if (gt < DEPTH) ((unsigned*)(p.ws + OFF_CTR))[gt * 64] = 0u;
    bf16_t* VT = (bf16_t*)(p.ws + OFF_VT);
    for (int i = gt; i < NB * 2 * 64 * 48; i += ngt) { const int r = i / 48, c = i % 48; VT[(size_t)r * LP + c] = 0; }
}
__device__ __forceinline__ void final_norm(const Params& p, int gw, int ngw, int lane) {
    const bf16_t* HB = (const bf16_t*)(p.ws + OFF_H); const float* SSQ = (const float*)(p.ws + OFF_SSQ) + (size_t)12 * MROWS * 16;
    for (int row = gw; row < MX; row += ngw) { const float rs = rstd_row(SSQ, row);
#pragma unroll
        for (int j = 0; j < 4; ++j) { const u32x2 w = *((const u32x2*)(HB + (size_t)row * D) + lane + 64 * j); const f32x4 g = *((const f32x4*)p.fn + lane + 64 * j);
            const f32x4 v = (f32x4){bflo(w.x), bfhi(w.x), bflo(w.y), bfhi(w.y)};
            *((f32x4*)(p.out + (size_t)row * D) + lane + 64 * j) = v * rs * g; } }
}

__device__ __forceinline__ void prep_qk(const Params& p, int l, int gt, int ngt) {
    const float* ROPE = (const float*)(p.ws + OFF_ROPE); const int j = gt & 7;
    for (int item = gt >> 3; item < NVALID * 10; item += ngt >> 3) {
        const int row = item / 10, hd = item % 10;
        bf16_t* ptr = ((hd < 8) ? (bf16_t*)(p.ws + OFF_RA) + (size_t)row * 1024 + 512 + hd * 64 : (bf16_t*)(p.ws + OFF_KB) + (size_t)row * 128 + (hd - 8) * 64) + 8 * j;
        const float* gain = ((hd < 8) ? p.qn : p.kn) + l * 64 + 8 * j; const float osc = (hd < 8) ? 0.125f * LOG2E : 1.0f;
        const u32x4 w = *(const u32x4*)ptr; const f32x4 g0 = *(const f32x4*)gain, g1 = *(const f32x4*)(gain + 4);
        float v[8] = {bflo(w.x), bfhi(w.x), bflo(w.y), bfhi(w.y), bflo(w.z), bfhi(w.z), bflo(w.w), bfhi(w.w)};
        float ss = 0.f;
#pragma unroll
        for (int e = 0; e < 8; ++e) ss += v[e] * v[e];
        ss += __shfl_xor(ss, 1); ss += __shfl_xor(ss, 2); ss += __shfl_xor(ss, 4);
        const float rs = __builtin_amdgcn_rsqf(ss * (1.0f / 64.0f) + EPS);
#pragma unroll
        for (int e = 0; e < 8; ++e) v[e] = v[e] * rs * ((e < 4) ? g0[e] : g1[e - 4]);
        if (row < MX) {
            const float* cs = ROPE + (size_t)(row & 4095) * 64 + 16 * (j >> 2) + 8 * (j & 1);
            const f32x4 c0 = *(const f32x4*)cs, c1 = *(const f32x4*)(cs + 4), s0 = *(const f32x4*)(cs + 32), s1 = *(const f32x4*)(cs + 36);
#pragma unroll
            for (int e = 0; e < 8; ++e) { const float c = (e < 4) ? c0[e] : c1[e - 4], sn = (e < 4) ? s0[e] : s1[e - 4]; const float o = __shfl_xor(v[e], 2);
                v[e] = (j & 2) ? (v[e] * c + o * sn) : (v[e] * c - o * sn); } }
        *(u32x4*)ptr = (u32x4){pk(v[0] * osc, v[1] * osc), pk(v[2] * osc, v[3] * osc), pk(v[4] * osc, v[5] * osc), pk(v[6] * osc, v[7] * osc)};
    }
}

constexpr int AT_TILE = 64 * 144, AT_K = 0, AT_V = 2 * AT_TILE, AT_VP = 136, AT_VTILE = 64 * AT_VP;
template <int NBLK, bool TRACK> __device__ __forceinline__ void attn_unit(const Params& p, int b, int kvh, int jb, LAS unsigned char* lds) {
    const int tid = mk_tid(), lane = tid & 63, wid = __builtin_amdgcn_readfirstlane(tid >> 6), r32 = lane & 31, hi = lane >> 5;
    bf16_t* QB = (bf16_t*)(p.ws + OFF_RA) + 512; const bf16_t* KB = (const bf16_t*)(p.ws + OFF_KB); const bf16_t* VT = (const bf16_t*)(p.ws + OFF_VT);
    const int hq = kvh * 4 + (wid >> 1);
    bool qvalid[NBLK]; bf16_t* qp[NBLK]; bf16x8 qr[NBLK][4];
#pragma unroll
    for (int blk = 0; blk < NBLK; ++blk) { const int rr = (wid & 1) * 64 + blk * 32 + r32;
        qvalid[blk] = (jb >= 0) || (rr < 16);
        const size_t qrow = (jb >= 0) ? (size_t)b * SEQ + jb * 128 + rr : (size_t)MX + b * 16 + (rr & 15);
        qp[blk] = QB + qrow * 1024 + hq * 64;
#pragma unroll
        for (int ds = 0; ds < 4; ++ds) qr[blk][ds] = qvalid[blk] ? *(const bf16x8*)(qp[blk] + ds * 16 + hi * 8) : (bf16x8){0, 0, 0, 0, 0, 0, 0, 0}; }
    const int tk = tid >> 3, tc = tid & 7;
    const bf16_t* vsrc = VT + ((size_t)(b * 2 + kvh) * 64 + tk) * LP + tc * 8;
    const bf16_t* ksrc = KB + ((size_t)b * SEQ + tk) * 128 + kvh * 64 + tc * 8;
    const bf16_t* ksrc0 = KB + ((size_t)MX + b * 16 + (tk - 48)) * 128 + kvh * 64 + tc * 8;
    const int lst = tk * 144 + tc * 16, lstv = tk * AT_VP + tc * 16;
    u32x4 kreg, vreg;
    kreg = (tk >= 48) ? *(const u32x4*)ksrc0 : (u32x4){0u, 0u, 0u, 0u}; vreg = *(const u32x4*)vsrc;
    *(LAS u32x4*)(lds + AT_K + lst) = kreg; *(LAS u32x2*)(lds + AT_V + lstv) = (u32x2){vreg.x, vreg.y}; *(LAS u32x2*)(lds + AT_V + lstv + 8) = (u32x2){vreg.z, vreg.w};
    __syncthreads();
    f32x16 o0[NBLK], o1[NBLK]; float mrun[NBLK], lrun[NBLK];
#pragma unroll
    for (int blk = 0; blk < NBLK; ++blk) { mrun[blk] = -1e30f; lrun[blk] = 0.f;
#pragma unroll
        for (int r = 0; r < 16; ++r) { o0[blk][r] = 0.f; o1[blk][r] = 0.f; } }
    for (int t = 0; t < NCH; ++t) {
        const int buf = t & 1;
        if (t + 1 < NCH) { kreg = *(const u32x4*)(ksrc + (size_t)t * 64 * 128); vreg = *(const u32x4*)(vsrc + (t + 1) * 64); }
        const LAS unsigned char* Kl = lds + AT_K + buf * AT_TILE; const LAS unsigned char* Vl = lds + AT_V + buf * AT_VTILE;
        f32x16 p0[NBLK], p1[NBLK];
#pragma unroll
        for (int blk = 0; blk < NBLK; ++blk)
#pragma unroll
            for (int r = 0; r < 16; ++r) { p0[blk][r] = 0.f; p1[blk][r] = 0.f; }
#pragma unroll
        for (int ds = 0; ds < 4; ++ds) {
            const bf16x8 k0 = *(const LAS bf16x8*)(Kl + r32 * 144 + ds * 32 + hi * 16), k1 = *(const LAS bf16x8*)(Kl + (r32 + 32) * 144 + ds * 32 + hi * 16);
#pragma unroll
            for (int blk = 0; blk < NBLK; ++blk) {
                p0[blk] = __builtin_amdgcn_mfma_f32_32x32x16_bf16(k0, qr[blk][ds], p0[blk], 0, 0, 0);
                p1[blk] = __builtin_amdgcn_mfma_f32_32x32x16_bf16(k1, qr[blk][ds], p1[blk], 0, 0, 0); }
        }
        u32x4 pw[NBLK][4];
#pragma unroll
        for (int blk = 0; blk < NBLK; ++blk) {
            if (t == 0) {
#pragma unroll
                for (int r = 0; r < 16; ++r) { p0[blk][r] = -1e30f; if (r < 8) p1[blk][r] = -1e30f; }
            }
            float ls = 0.f;
            if (TRACK) {
                float mx = fmaxf(p0[blk][0], p1[blk][0]);
#pragma unroll
                for (int r = 1; r < 16; ++r) mx = fmaxf(mx, fmaxf(p0[blk][r], p1[blk][r]));
                mx = fmaxf(mx, __shfl_xor(mx, 32));
                if (__any(mx > mrun[blk] + 8.0f)) {
                    const float mnew = fmaxf(mrun[blk], mx), alpha = __builtin_amdgcn_exp2f(mrun[blk] - mnew);
                    lrun[blk] *= alpha; mrun[blk] = mnew;
#pragma unroll
                    for (int r = 0; r < 16; ++r) { o0[blk][r] *= alpha; o1[blk][r] *= alpha; }
                }
#pragma unroll
                for (int r = 0; r < 16; ++r) { p0[blk][r] = __builtin_amdgcn_exp2f(p0[blk][r] - mrun[blk]); p1[blk][r] = __builtin_amdgcn_exp2f(p1[blk][r] - mrun[blk]); ls += p0[blk][r] + p1[blk][r]; }
            } else {
#pragma unroll
                for (int r = 0; r < 16; ++r) { p0[blk][r] = __builtin_amdgcn_exp2f(p0[blk][r]); p1[blk][r] = __builtin_amdgcn_exp2f(p1[blk][r]); }
            }
            if (TRACK) lrun[blk] += ls;
            pw[blk][0] = (u32x4){pk(p0[blk][0], p0[blk][1]), pk(p0[blk][2], p0[blk][3]), pk(p0[blk][4], p0[blk][5]), pk(p0[blk][6], p0[blk][7])};
            pw[blk][1] = (u32x4){pk(p0[blk][8], p0[blk][9]), pk(p0[blk][10], p0[blk][11]), pk(p0[blk][12], p0[blk][13]), pk(p0[blk][14], p0[blk][15])};
            pw[blk][2] = (u32x4){pk(p1[blk][0], p1[blk][1]), pk(p1[blk][2], p1[blk][3]), pk(p1[blk][4], p1[blk][5]), pk(p1[blk][6], p1[blk][7])};
            pw[blk][3] = (u32x4){pk(p1[blk][8], p1[blk][9]), pk(p1[blk][10], p1[blk][11]), pk(p1[blk][12], p1[blk][13]), pk(p1[blk][14], p1[blk][15])};
            if (!TRACK) {
                typedef __bf16 bf16x2d __attribute__((ext_vector_type(2)));
                const bf16x2d one2 = __builtin_bit_cast(bf16x2d, 0x3f803f80u); float a4[4];
#pragma unroll
                for (int s = 0; s < 4; ++s) { float a = 0.f;
                    a = __builtin_amdgcn_fdot2_f32_bf16(__builtin_bit_cast(bf16x2d, pw[blk][s].x), one2, a, false); a = __builtin_amdgcn_fdot2_f32_bf16(__builtin_bit_cast(bf16x2d, pw[blk][s].y), one2, a, false);
                    a = __builtin_amdgcn_fdot2_f32_bf16(__builtin_bit_cast(bf16x2d, pw[blk][s].z), one2, a, false); a = __builtin_amdgcn_fdot2_f32_bf16(__builtin_bit_cast(bf16x2d, pw[blk][s].w), one2, a, false); a4[s] = a; }
                lrun[blk] += (a4[0] + a4[1]) + (a4[2] + a4[3]);
            }
        }
#pragma unroll
        for (int s = 0; s < 4; ++s) {
            { const u32x2 a = *(const LAS u32x2*)(Vl + r32 * AT_VP + (16 * s + 4 * hi) * 2), c = *(const LAS u32x2*)(Vl + r32 * AT_VP + (16 * s + 8 + 4 * hi) * 2);
              const bf16x8 vf = __builtin_bit_cast(bf16x8, (u32x4){a.x, a.y, c.x, c.y});
#pragma unroll
              for (int blk = 0; blk < NBLK; ++blk) o0[blk] = __builtin_amdgcn_mfma_f32_32x32x16_bf16(vf, __builtin_bit_cast(bf16x8, pw[blk][s]), o0[blk], 0, 0, 0); }
            { const u32x2 a = *(const LAS u32x2*)(Vl + (r32 + 32) * AT_VP + (16 * s + 4 * hi) * 2), c = *(const LAS u32x2*)(Vl + (r32 + 32) * AT_VP + (16 * s + 8 + 4 * hi) * 2);
              const bf16x8 vf = __builtin_bit_cast(bf16x8, (u32x4){a.x, a.y, c.x, c.y});
#pragma unroll
              for (int blk = 0; blk < NBLK; ++blk) o1[blk] = __builtin_amdgcn_mfma_f32_32x32x16_bf16(vf, __builtin_bit_cast(bf16x8, pw[blk][s]), o1[blk], 0, 0, 0); }
        }
        if (t + 1 < NCH) { *(LAS u32x4*)(lds + AT_K + (buf ^ 1) * AT_TILE + lst) = kreg; *(LAS u32x2*)(lds + AT_V + (buf ^ 1) * AT_VTILE + lstv) = (u32x2){vreg.x, vreg.y}; *(LAS u32x2*)(lds + AT_V + (buf ^ 1) * AT_VTILE + lstv + 8) = (u32x2){vreg.z, vreg.w}; }
        __syncthreads();
    }
#pragma unroll
    for (int blk = 0; blk < NBLK; ++blk) {
        float l = lrun[blk]; l += __shfl_xor(l, 32);
        const float inv = 1.0f / l;
        if (qvalid[blk]) {
#pragma unroll
            for (int g = 0; g < 4; ++g) {
                u32x2 w0; w0.x = pk(o0[blk][4 * g] * inv, o0[blk][4 * g + 1] * inv); w0.y = pk(o0[blk][4 * g + 2] * inv, o0[blk][4 * g + 3] * inv);
                u32x2 w1; w1.x = pk(o1[blk][4 * g] * inv, o1[blk][4 * g + 1] * inv); w1.y = pk(o1[blk][4 * g + 2] * inv, o1[blk][4 * g + 3] * inv);
                *(u32x2*)(qp[blk] + 8 * g + 4 * hi) = w0; *(u32x2*)(qp[blk] + 32 + 8 * g + 4 * hi) = w1;
            }
        }
    }
}
__device__ __forceinline__ void attn_phase(const Params& p, int l, LAS unsigned char* lds, int vcu, int G) {
    const int lane = mk_tid() & 63;
    float gq = fabsf(p.qn[l * 64 + lane]), gk = fabsf(p.kn[l * 64 + lane]);
#pragma unroll
    for (int o = 1; o < 64; o <<= 1) { gq = fmaxf(gq, __shfl_xor(gq, o)); gk = fmaxf(gk, __shfl_xor(gk, o)); }
    const bool safe = __builtin_amdgcn_readfirstlane((gq * gk * 11.55f < 40.0f) ? 1 : 0) != 0;
    const int nper = (512 + G - 1) / G;
    if (safe) {
        for (int i = 0; i < nper; ++i) { const int id = vcu * nper + i; if (id < 512) attn_unit<2, false>(p, id >> 6, (id >> 5) & 1, id & 31, lds); }
        for (int m = 0; m < 16; ++m) if ((m * G) / 16 == vcu) attn_unit<1, false>(p, m >> 1, m & 1, -1, lds);
    } else {
        for (int i = 0; i < nper; ++i) { const int id = vcu * nper + i; if (id < 512) attn_unit<2, true>(p, id >> 6, (id >> 5) & 1, id & 31, lds); }
        for (int m = 0; m < 16; ++m) if ((m * G) / 16 == vcu) attn_unit<1, true>(p, m >> 1, m & 1, -1, lds);
    }
}

__device__ __forceinline__ void gla_scan(const Params& p, int gt, int ngt) {
    bf16_t* S = (bf16_t*)(p.ws + OFF_S); const float* DEC = (const float*)(p.ws + OFF_DEC);
    if (gt & 1) return;
    for (int task = gt >> 1; task < 64 * 1024; task += ngt >> 1) {
        const int bhd = task >> 10, e = (task & 1023) * 8, c = e & 63, dir = bhd & 1;
        bf16_t* sp = S + (size_t)bhd * NCH * 8192 + e; const float* dp = DEC + (size_t)bhd * NCH * 64 + c;
        f32x4 s0 = (f32x4){0.f, 0.f, 0.f, 0.f}, s1 = s0;
#pragma unroll 5
        for (int k = 0; k < NCH; ++k) { const int ch = dir ? (NCH - 1 - k) : k;
            const u32x4 kv = *(const u32x4*)(sp + (size_t)ch * 8192); const f32x4 d0 = *(const f32x4*)(dp + ch * 64), d1 = *(const f32x4*)(dp + ch * 64 + 4);
            *(u32x4*)(sp + (size_t)ch * 8192) = (u32x4){pk(s0[0], s0[1]), pk(s0[2], s0[3]), pk(s1[0], s1[1]), pk(s1[2], s1[3])};
            s0 = d0 * s0 + (f32x4){bflo(kv.x), bfhi(kv.x), bflo(kv.y), bfhi(kv.y)}; s1 = d1 * s1 + (f32x4){bflo(kv.z), bfhi(kv.z), bflo(kv.w), bfhi(kv.w)}; }
    }
}
constexpr int GL2_QD = 0;
constexpr int GL2_KI = 18432;
constexpr int GL2_VT = 36864;
constexpr int GL2_ATT = 55296;
constexpr int GL2_W2 = 64512;
constexpr int GL2_SZ = 64512 + 8192 + 512;
constexpr int GLA_UNITS = 32 * NCH;
static_assert(2 * GL2_SZ + 16 <= LDS_BYTES && GLA_UNITS % 2 == 0, "GLA LDS");
template <bool G3> __device__ __forceinline__ void gla_pair(const Params& p, int l, int u, bool valid, LAS unsigned char* lds) {
    const int tid = mk_tid(), lane = tid & 63, wid = __builtin_amdgcn_readfirstlane(tid >> 6), w4 = wid & 3, t8 = tid & 255, fr = lane & 15, fq = lane >> 4;
    const bf16_t* QKA = (const bf16_t*)(p.ws + OFF_QKA); const bf16_t* VA = (const bf16_t*)(p.ws + OFF_VA); bf16_t* RA = (bf16_t*)(p.ws + OFF_RA);
    const float* LR = (const float*)(p.ws + OFF_LR); bf16_t* S = (bf16_t*)(p.ws + OFF_S); float* DEC = (float*)(p.ws + OFF_DEC);
    const int bh = u / NCH, chunk = u % NCH, b = bh >> 2, h = bh & 3, c0 = w4 * 16;
#define GL_ROW(i) ((chunk == 0) ? ((size_t)MX + b * 16 + ((i) - 48)) : ((size_t)b * SEQ + (chunk - 1) * 64 + (i)))
#define GL_NUL(i) ((chunk == 0) && ((i) < 48))
    const int i = lane; const bool nul = GL_NUL(i); const size_t row = nul ? (size_t)MX : GL_ROW(i);
    LAS float* w2s = (LAS float*)(lds + GL2_W2); LAS float* b2s = w2s + 2048;
#pragma unroll
    for (int q = 0; q < 2; ++q) { const int ch = t8 + 256 * q, rr = ch >> 4, c4 = (ch & 15) * 4;
        *(LAS f32x4*)(w2s + rr * 64 + c4) = *(const f32x4*)(p.w2 + (size_t)(l * 32 + rr) * 256 + h * 64 + c4); }
    if (t8 < 32) { const int dd = t8 >> 4, c4 = (t8 & 15) * 4; *(LAS f32x4*)(b2s + dd * 64 + c4) = *(const f32x4*)(p.b2 + (size_t)(l * 2 + dd) * 256 + h * 64 + c4); }
    __syncthreads();
    float bcv[2][16];
#pragma unroll
    for (int dir = 0; dir < 2; ++dir) {
        float lrv[16];
        { const float* lrp = LR + row * 32 + dir * 16;
#pragma unroll
          for (int q = 0; q < 4; ++q) { const f32x4 t = *(const f32x4*)(lrp + 4 * q); lrv[4 * q] = t[0]; lrv[4 * q + 1] = t[1]; lrv[4 * q + 2] = t[2]; lrv[4 * q + 3] = t[3]; } }
        const LAS float* w2p = w2s + dir * 1024 + c0; const LAS float* b2p = b2s + dir * 64 + c0;
#pragma unroll
        for (int cc = 0; cc < 16; ++cc) {
            float x = b2p[cc];
#pragma unroll
            for (int r = 0; r < 16; ++r) x += lrv[r] * w2p[r * 64 + cc];
            const float lg = nul ? 0.f : __builtin_amdgcn_logf(1.f + __builtin_amdgcn_exp2f(fminf(-x, 60.f) * LOG2E)) * (-0.6931471805599453f / 16.0f);
            float sc = wave_incl_scan(lg);
            if (dir == 1) sc = lane_bcast(sc, 63) - sc + lg;
            bcv[dir][cc] = sc;
        }
    }
    LAS bf16_t* vT = (LAS bf16_t*)(lds + GL2_VT);
#pragma unroll
    for (int q = 0; q < 4; ++q) { const int vc = w4 * 4 + q;
        const u32x4 w = nul ? (u32x4){0u, 0u, 0u, 0u} : *(const u32x4*)(VA + row * 512 + h * 128 + vc * 8);
        vT[(vc * 8 + 0) * 72 + i] = (bf16_t)(w.x & 0xffffu); vT[(vc * 8 + 1) * 72 + i] = (bf16_t)(w.x >> 16); vT[(vc * 8 + 2) * 72 + i] = (bf16_t)(w.y & 0xffffu); vT[(vc * 8 + 3) * 72 + i] = (bf16_t)(w.y >> 16);
        vT[(vc * 8 + 4) * 72 + i] = (bf16_t)(w.z & 0xffffu); vT[(vc * 8 + 5) * 72 + i] = (bf16_t)(w.z >> 16); vT[(vc * 8 + 6) * 72 + i] = (bf16_t)(w.w & 0xffffu); vT[(vc * 8 + 7) * 72 + i] = (bf16_t)(w.w >> 16); }
    float kf[16], qf[16];
    { const u32x4 k0 = nul ? (u32x4){0u, 0u, 0u, 0u} : *(const u32x4*)(QKA + row * 512 + 256 + h * 64 + c0), k1 = nul ? (u32x4){0u, 0u, 0u, 0u} : *(const u32x4*)(QKA + row * 512 + 256 + h * 64 + c0 + 8);
      kf[0] = bflo(k0.x); kf[1] = bfhi(k0.x); kf[2] = bflo(k0.y); kf[3] = bfhi(k0.y); kf[4] = bflo(k0.z); kf[5] = bfhi(k0.z); kf[6] = bflo(k0.w); kf[7] = bfhi(k0.w);
      kf[8] = bflo(k1.x); kf[9] = bfhi(k1.x); kf[10] = bflo(k1.y); kf[11] = bfhi(k1.y); kf[12] = bflo(k1.z); kf[13] = bfhi(k1.z); kf[14] = bflo(k1.w); kf[15] = bfhi(k1.w); }
    if (G3) { const u32x4 q0 = nul ? (u32x4){0u, 0u, 0u, 0u} : *(const u32x4*)(QKA + row * 512 + h * 64 + c0), q1 = nul ? (u32x4){0u, 0u, 0u, 0u} : *(const u32x4*)(QKA + row * 512 + h * 64 + c0 + 8);
      qf[0] = bflo(q0.x); qf[1] = bfhi(q0.x); qf[2] = bflo(q0.y); qf[3] = bfhi(q0.y); qf[4] = bflo(q0.z); qf[5] = bfhi(q0.z); qf[6] = bflo(q0.w); qf[7] = bfhi(q0.w);
      qf[8] = bflo(q1.x); qf[9] = bfhi(q1.x); qf[10] = bflo(q1.y); qf[11] = bfhi(q1.y); qf[12] = bflo(q1.z); qf[13] = bfhi(q1.z); qf[14] = bflo(q1.w); qf[15] = bfhi(q1.w); }
    bf16x8 sfr[2][2][2]; u32x4 rpre[4];
    if (G3) {
#pragma unroll
        for (int dir = 0; dir < 2; ++dir) { const bf16_t* sp = S + ((size_t)(bh * 2 + dir) * NCH + chunk) * 8192;
#pragma unroll
            for (int vt = 0; vt < 2; ++vt)
#pragma unroll
                for (int ks = 0; ks < 2; ++ks) sfr[dir][vt][ks] = *(const bf16x8*)(sp + (size_t)((w4 * 2 + vt) * 16 + fr) * 64 + 32 * ks + 8 * fq); }
        { const int ii = t8 >> 2, part = t8 & 3; const size_t rr = GL_NUL(ii) ? (size_t)MX : GL_ROW(ii); const bf16_t* rp = RA + rr * 1024 + h * 128 + part * 32;
#pragma unroll
          for (int q = 0; q < 4; ++q) rpre[q] = *(const u32x4*)(rp + 8 * q); }
    }
    if (!G3) {
        LAS bf16_t* keT = (LAS bf16_t*)(lds + GL2_QD);
#pragma unroll
        for (int cc = 0; cc < 16; ++cc) {
            const float btF = lane_bcast(bcv[0][cc], 63), btB = lane_bcast(bcv[1][cc], 0);
            keT[(c0 + cc) * 72 + i] = f2bf(kf[cc] * fexp(btF - bcv[0][cc])); keT[(64 + c0 + cc) * 72 + i] = f2bf(kf[cc] * fexp(btB - bcv[1][cc]));
            if (valid && lane == 0) { DEC[((size_t)(bh * 2 + 0) * NCH + chunk) * 64 + c0 + cc] = fexp(btF); DEC[((size_t)(bh * 2 + 1) * NCH + chunk) * 64 + c0 + cc] = fexp(btB); }
        }
        __syncthreads();
#pragma unroll
        for (int dir = 0; dir < 2; ++dir) { bf16_t* sbase = S + ((size_t)(bh * 2 + dir) * NCH + chunk) * 8192;
#pragma unroll
          for (int vt = 0; vt < 2; ++vt) { const int v0 = (w4 * 2 + vt) * 16;
              const bf16x8 a0 = *(const LAS bf16x8*)(vT + (v0 + fr) * 72 + 8 * fq), a1 = *(const LAS bf16x8*)(vT + (v0 + fr) * 72 + 32 + 8 * fq);
#pragma unroll
              for (int ct = 0; ct < 4; ++ct) { const int cb = ct * 16;
                  const bf16x8 b0 = *(const LAS bf16x8*)(keT + (dir * 64 + cb + fr) * 72 + 8 * fq), b1 = *(const LAS bf16x8*)(keT + (dir * 64 + cb + fr) * 72 + 32 + 8 * fq);
                  f32x4 acc = (f32x4){0.f, 0.f, 0.f, 0.f};
                  acc = __builtin_amdgcn_mfma_f32_16x16x32_bf16(b0, a0, acc, 0, 0, 0); acc = __builtin_amdgcn_mfma_f32_16x16x32_bf16(b1, a1, acc, 0, 0, 0);
                  u32x2 w; w.x = pk(acc[0], acc[1]); w.y = pk(acc[2], acc[3]);
                  if (valid) *(u32x2*)(sbase + (size_t)(v0 + fr) * 64 + cb + 4 * fq) = w; } } }
        __syncthreads();
    } else {
        LAS bf16_t* qd = (LAS bf16_t*)(lds + GL2_QD); LAS bf16_t* ki = (LAS bf16_t*)(lds + GL2_KI); LAS bf16_t* att = (LAS bf16_t*)(lds + GL2_ATT);
#pragma unroll
        for (int dir = 0; dir < 2; ++dir) { float qo[16], ko[16];
#pragma unroll
            for (int cc = 0; cc < 16; ++cc) { qo[cc] = qf[cc] * fexp(bcv[dir][cc]); ko[cc] = kf[cc] * fexp(-bcv[dir][cc]); }
            *(LAS u32x4*)(qd + (dir * 64 + i) * 72 + c0) = (u32x4){pk(qo[0], qo[1]), pk(qo[2], qo[3]), pk(qo[4], qo[5]), pk(qo[6], qo[7])};
            *(LAS u32x4*)(qd + (dir * 64 + i) * 72 + c0 + 8) = (u32x4){pk(qo[8], qo[9]), pk(qo[10], qo[11]), pk(qo[12], qo[13]), pk(qo[14], qo[15])};
            *(LAS u32x4*)(ki + (dir * 64 + i) * 72 + c0) = (u32x4){pk(ko[0], ko[1]), pk(ko[2], ko[3]), pk(ko[4], ko[5]), pk(ko[6], ko[7])};
            *(LAS u32x4*)(ki + (dir * 64 + i) * 72 + c0 + 8) = (u32x4){pk(ko[8], ko[9]), pk(ko[10], ko[11]), pk(ko[12], ko[13]), pk(ko[14], ko[15])}; }
        __syncthreads();
        const int i0 = w4 * 16;
        bf16x8 aFq[2], aBq[2];
#pragma unroll
        for (int ks = 0; ks < 2; ++ks) { aFq[ks] = *(const LAS bf16x8*)(qd + (i0 + fr) * 72 + 32 * ks + 8 * fq); aBq[ks] = *(const LAS bf16x8*)(qd + (64 + i0 + fr) * 72 + 32 * ks + 8 * fq); }
#pragma unroll
        for (int jt = 0; jt < 4; ++jt) { const int j0 = jt * 16;
            f32x4 aF = (f32x4){0.f, 0.f, 0.f, 0.f}, aB = (f32x4){0.f, 0.f, 0.f, 0.f};
#pragma unroll
            for (int ks = 0; ks < 2; ++ks) {
                const bf16x8 kf_ = *(const LAS bf16x8*)(ki + (j0 + fr) * 72 + 32 * ks + 8 * fq), kb_ = *(const LAS bf16x8*)(ki + (64 + j0 + fr) * 72 + 32 * ks + 8 * fq);
                aF = __builtin_amdgcn_mfma_f32_16x16x32_bf16(aFq[ks], kf_, aF, 0, 0, 0); aB = __builtin_amdgcn_mfma_f32_16x16x32_bf16(aBq[ks], kb_, aB, 0, 0, 0); }
#pragma unroll
            for (int r = 0; r < 4; ++r) { const int ii = i0 + 4 * fq + r, jj = j0 + fr; const float v = ((ii >= jj) ? aF[r] : 0.f) + ((jj >= ii) ? aB[r] : 0.f); att[ii * 72 + jj] = f2bf(v); } }
        __syncthreads();
        LAS bf16_t* ol = ki;
        { bf16x8 bV[2][2];
#pragma unroll
          for (int vt = 0; vt < 2; ++vt)
#pragma unroll
              for (int ks = 0; ks < 2; ++ks) bV[vt][ks] = *(const LAS bf16x8*)(vT + ((w4 * 2 + vt) * 16 + fr) * 72 + 32 * ks + 8 * fq);
#pragma unroll
          for (int it = 0; it < 4; ++it) { const int ib = it * 16; bf16x8 aA[2], aF2[2], aB2[2];
#pragma unroll
              for (int ks = 0; ks < 2; ++ks) { aA[ks] = *(const LAS bf16x8*)(att + (ib + fr) * 72 + 32 * ks + 8 * fq); aF2[ks] = *(const LAS bf16x8*)(qd + (ib + fr) * 72 + 32 * ks + 8 * fq);
                  aB2[ks] = *(const LAS bf16x8*)(qd + (64 + ib + fr) * 72 + 32 * ks + 8 * fq); }
#pragma unroll
              for (int vt = 0; vt < 2; ++vt) { const int v0 = (w4 * 2 + vt) * 16; f32x4 acc = (f32x4){0.f, 0.f, 0.f, 0.f};
#pragma unroll
                  for (int ks = 0; ks < 2; ++ks) { acc = __builtin_amdgcn_mfma_f32_16x16x32_bf16(aA[ks], bV[vt][ks], acc, 0, 0, 0);
                      acc = __builtin_amdgcn_mfma_f32_16x16x32_bf16(aF2[ks], sfr[0][vt][ks], acc, 0, 0, 0); acc = __builtin_amdgcn_mfma_f32_16x16x32_bf16(aB2[ks], sfr[1][vt][ks], acc, 0, 0, 0); }
#pragma unroll
                  for (int r = 0; r < 4; ++r) ol[(ib + 4 * fq + r) * 136 + v0 + fr] = f2bf(acc[r]); } } }
        __syncthreads();
        { const int ii = t8 >> 2, part = t8 & 3; const bool nl = GL_NUL(ii); float ov[32]; float ss = 0.f;
#pragma unroll
          for (int q = 0; q < 4; ++q) { const u32x4 t = *(const LAS u32x4*)(ol + ii * 136 + part * 32 + 8 * q);
              ov[8 * q] = bflo(t.x); ov[8 * q + 1] = bfhi(t.x); ov[8 * q + 2] = bflo(t.y); ov[8 * q + 3] = bfhi(t.y); ov[8 * q + 4] = bflo(t.z); ov[8 * q + 5] = bfhi(t.z); ov[8 * q + 6] = bflo(t.w); ov[8 * q + 7] = bfhi(t.w); }
#pragma unroll
          for (int e = 0; e < 32; ++e) ss += ov[e] * ov[e];
          ss += __shfl_xor(ss, 1); ss += __shfl_xor(ss, 2);
          const float rs = __builtin_amdgcn_rsqf(ss * (1.0f / 128.0f) + EPS);
          if (valid && !nl) { bf16_t* rp = RA + GL_ROW(ii) * 1024 + h * 128 + part * 32; const float* gp = p.gn + (size_t)l * 512 + h * 128 + part * 32;
#pragma unroll
              for (int q = 0; q < 4; ++q) { const u32x4 rw = rpre[q]; const f32x4 g0 = *(const f32x4*)(gp + 8 * q), g1 = *(const f32x4*)(gp + 8 * q + 4);
                  const float rf[8] = {bflo(rw.x), bfhi(rw.x), bflo(rw.y), bfhi(rw.y), bflo(rw.z), bfhi(rw.z), bflo(rw.w), bfhi(rw.w)}; float y[8];
#pragma unroll
                  for (int e = 0; e < 8; ++e) y[e] = ov[8 * q + e] * rs * ((e < 4) ? g0[e] : g1[e - 4]) * rf[e];
                  *(u32x4*)(rp + 8 * q) = (u32x4){pk(y[0], y[1]), pk(y[2], y[3]), pk(y[4], y[5]), pk(y[6], y[7])}; } } }
        __syncthreads();
    }
#undef GL_ROW
#undef GL_NUL
}
template <bool G3> __device__ __forceinline__ void gla_phase(const Params& p, int l, LAS unsigned char* lds, int bx, int G) {
    const int grp = __builtin_amdgcn_readfirstlane(mk_tid() >> 8);
    const int niter = (GLA_UNITS + 2 * G - 1) / (2 * G);
    for (int it = 0; it < niter; ++it) { int u = (it * G + bx) * 2 + grp; const bool valid = u < GLA_UNITS; if (!valid) u = GLA_UNITS - 1;
        gla_pair<G3>(p, l, u, valid, lds + grp * GL2_SZ); }
}

__device__ __forceinline__ void gla_pool(const Params& p, int l, LAS unsigned char* lds) {
    const int tid = mk_tid(), grp = __builtin_amdgcn_readfirstlane(tid >> 8);
    unsigned* ctr = (unsigned*)(p.ws + OFF_CTR) + l * 64; LAS unsigned* slot = (LAS unsigned*)(lds + 2 * GL2_SZ);
    for (;;) {
        if (tid == 0) *slot = atomicAdd(ctr, 1u);
        __syncthreads();
        const unsigned k = *slot;
        __syncthreads();
        if (k < (unsigned)(GLA_UNITS / 2)) { gla_pair<true>(p, l, (int)k * 2 + grp, true, lds + grp * GL2_SZ); continue; }
        const int j = (int)k - GLA_UNITS / 2;
        if (l + 1 >= DEPTH || j >= (CV_NIT + 7) / 8) break;
        { const int wid = __builtin_amdgcn_readfirstlane(tid >> 6), it = j * 8 + wid; if (it < CV_NIT) conv_one(p, l + 1, it, (LAS float*)(lds + wid * 8448), tid & 63); }
        __syncthreads();
    }
}

#define XB_TMO      128
#define XB_XCNT(j)  (256  + 64 * (j))
#define XB_XSUB(j)  (1280 + 64 * (j))
#define XB_XGEN(j)  (2304 + 64 * (j))
#define XB_TOP      3328
#define XB_TOPGEN   3392
#define XCD_BAR_WORDS 3456
#define XB_SPIN_CAP (1u << 18)

__device__ __forceinline__ unsigned xb_ld(unsigned* p)              { return __hip_atomic_load(p, __ATOMIC_RELAXED, __HIP_MEMORY_SCOPE_AGENT); }
__device__ __forceinline__ unsigned xb_add(unsigned* p, unsigned v) { return __hip_atomic_fetch_add(p, v, __ATOMIC_RELAXED, __HIP_MEMORY_SCOPE_AGENT); }
__device__ __forceinline__ unsigned xb_xcc_id() { return (unsigned)__builtin_amdgcn_s_getreg((3 << 11) | 20) & 0xFu; }
#define XB_SPIN(cond, bar) do { unsigned _sp = 0; while (cond) { __builtin_amdgcn_s_sleep(1); \
    if ((++_sp & 255u) == 0u) { if (xb_ld(&(bar)[XB_TMO])) break; if (_sp > XB_SPIN_CAP) { atomicAdd(&(bar)[XB_TMO], 1u); break; } } } } while (0)
struct XcdBarrier {
    unsigned* bar; unsigned x;
    volatile LAS unsigned* st;
};

__device__ __forceinline__ XcdBarrier xcd_barrier_post(unsigned* bar, volatile LAS unsigned* st) {
    XcdBarrier b; b.bar = bar; b.x = xb_xcc_id(); b.st = st;
    if (threadIdx.x == 0) (void)xb_add(&bar[XB_XCNT(b.x)], 1u);
    return b;
}
__device__ __forceinline__ void xcd_barrier_complete(unsigned* bar, unsigned x, unsigned& nloc, unsigned& nx) {
    const unsigned G = gridDim.x * gridDim.y * gridDim.z;
    unsigned sum, cnt, mine, sp = 0u;
    for (;;) {
        sum = 0u; cnt = 0u; mine = 0u;
#pragma unroll
        for (unsigned j = 0; j < 16; ++j) { const unsigned c = xb_ld(&bar[XB_XCNT(j)]); sum += c; cnt += (c > 0u) ? 1u : 0u; mine = (j == x) ? c : mine; }
        if (sum == G) break;
        __builtin_amdgcn_s_sleep(1);
        if ((++sp & 255u) == 0u) { if (xb_ld(&bar[XB_TMO])) break; if (sp > XB_SPIN_CAP) { atomicAdd(&bar[XB_TMO], 1u); break; } }
    }
    nloc = mine > 0u ? mine : 1u; nx = cnt > 0u ? cnt : 1u;
}

__device__ __forceinline__ void xcd_barrier(const XcdBarrier& b) {
    asm volatile("s_waitcnt vmcnt(0)" ::: "memory");
    __syncthreads();
    if (threadIdx.x == 0) {
        unsigned* bar = b.bar;
        __builtin_amdgcn_s_waitcnt(0);
        unsigned nloc = b.st[0], nx = b.st[1];
        if (nloc == 0u) { xcd_barrier_complete(bar, b.x, nloc, nx); b.st[0] = nloc; b.st[1] = nx; }
        const unsigned old = xb_add(&bar[XB_XSUB(b.x)], 1u);
        const unsigned gen = old / nloc;
        if (old + 1u == (gen + 1u) * nloc) {
            __builtin_amdgcn_fence(__ATOMIC_RELEASE, "agent");
            asm volatile("s_waitcnt vmcnt(0)" ::: "memory");
            const unsigned og = xb_add(&bar[XB_TOP], 1u);
            const unsigned tg = og / nx;
            if (og + 1u == (tg + 1u) * nx) xb_add(&bar[XB_TOPGEN], 1u);
            else XB_SPIN(xb_ld(&bar[XB_TOPGEN]) == tg, bar);
            __builtin_amdgcn_fence(__ATOMIC_ACQUIRE, "agent");
            xb_add(&bar[XB_XGEN(b.x)], 1u);
            asm volatile("s_waitcnt vmcnt(0)" ::: "memory");
        } else {
            XB_SPIN(xb_ld(&bar[XB_XGEN(b.x)]) == gen, bar);
            __builtin_amdgcn_fence(__ATOMIC_ACQUIRE, "agent");
            asm volatile("s_waitcnt vmcnt(0)" ::: "memory");
        }
    }
    __syncthreads();
}

__global__ void __launch_bounds__(512) mk_fwd(Params pin) {
    extern __shared__ __attribute__((aligned(16))) unsigned char lds_raw[];
    LAS unsigned char* lds = (LAS unsigned char*)lds_raw;
    cg::grid_group grid = cg::this_grid();
    const Params p0 = pin;
    volatile LAS unsigned* xst = (volatile LAS unsigned*)(lds + LDS_BYTES - 16);
    if (threadIdx.x < 2) xst[threadIdx.x] = 0u;
    __syncthreads();
    XcdBarrier xbar = xcd_barrier_post((unsigned*)(p0.ws + OFF_BAR), xst);
    if (p0.ph_hi < 0) grid.sync();
#ifdef MK_TIMING
    unsigned long long tA = 0, tB = 0, tprev = __builtin_amdgcn_s_memrealtime();
#endif
    for (int ph = p0.ph_lo; ph < p0.ph_hi; ++ph) {
        if (ph > p0.ph_lo) { long zb = 0; asm volatile("" : "+s"(zb)); XcdBarrier xb = xbar; xb.bar += zb; xcd_barrier(xb); }
#ifdef MK_TIMING
        if (ph > p0.ph_lo) { const unsigned long long tn = __builtin_amdgcn_s_memrealtime(); const int pp = ph - 1; const int ss = (pp == 0 || pp == NPH - 1) ? 11 : (pp - 1) % 10;
            if ((MK_TA >> ss) & 1) tA += tn - tprev; if ((MK_TB >> ss) & 1) tB += tn - tprev; tprev = tn; }
#endif
        long z = 0; asm volatile("" : "+s"(z));
        Params p = p0;
        p.x += z; p.meta += z; p.ng += z; p.wg += z; p.wu += z; p.wd += z; p.win += z; p.w2 += z; p.b2 += z; p.gn += z; p.qn += z; p.kn += z; p.wpa += z; p.wpb += z; p.bm += z; p.wout += z; p.fn += z; p.out += z; p.ws += z;
        const int tid = mk_tid();
        int G = gridDim.x, bx = blockIdx.x; asm volatile("" : "+s"(G), "+s"(bx));
        const int vcu = (G % 8 == 0) ? (bx % 8) * (G / 8) + bx / 8 : bx;
        const int lane = tid & 63, wid = __builtin_amdgcn_readfirstlane(tid >> 6);
        const int gw = bx * 8 + wid, ngw = G * 8, gt = bx * 512 + tid, ngt = G * 512;
        unsigned char* ws = p.ws;
        bf16_t* HB = (bf16_t*)(ws + OFF_H);
        float* SSQ = (float*)(ws + OFF_SSQ); bf16_t* HID = (bf16_t*)(ws + OFF_HID); bf16_t* Y = (bf16_t*)(ws + OFF_Y);
        if (PHON(11) && ph == 0) { prologue(p, gw, ngw, lane); conv_layer(p, 0, lds, gw, ngw, wid, lane); continue; }
        if (ph == NPH - 1) { final_norm(p, gw, ngw, lane); continue; }
        const int l = (ph - 1) / 10, s = (ph - 1) % 10;
        bf16_t* WT = (bf16_t*)((unsigned char*)p.out + OO_WT) + (size_t)(l & 1) * WT_END;
        if (PHON(0) && (s == 0 || s == 8)) {
            const int f = (s == 8);
            pg8::Gemm g{HB, WT + (f ? WT_GU1 : WT_GU0), MROWS, 5632, D, D}; MetaOrder S; S.init(5632, G, bx);
            EpiSwiglu E{HID, SSQ + (size_t)(3 * l + (f ? 2 : 0)) * MROWS * 16};
            pg8::gemm_phase<EpiSwiglu, MetaOrder, true, true>(lds, g, S, E);
        } else if (PHON(1) && (s == 1 || s == 7 || s == 9)) {
            pg8::Gemm g; float scale; int so;
            if (s == 1) { g = pg8::Gemm{HID, WT + WT_DN0, MROWS, D, DFF, DFF}; scale = 0.5f; so = 3 * l + 1; }
            else if (s == 9) { g = pg8::Gemm{HID, WT + WT_DN1, MROWS, D, DFF, DFF}; scale = 0.5f; so = 3 * l + 3; }
            else { g = pg8::Gemm{Y, WT + WT_OUT, MROWS, D, D, D}; scale = 1.0f; so = 3 * l + 2; }
            MetaOrder S; S.init(D, G, bx);
            EpiResid E{HB, SSQ + (size_t)so * MROWS * 16, scale};
            pg8::gemm_phase<EpiResid, MetaOrder, true, true>(lds, g, S, E);
        } else if (PHON(2) && s == 2) {
            pg8::Gemm g{HB, WT + WT_WIN, MROWS, WIN_N, D, D}; MetaOrder S; S.init(WIN_N, G, bx);
            EpiWin E{ws, SSQ + (size_t)(3 * l + 1) * MROWS * 16, p.bm + (size_t)l * 2048};
            pg8::gemm_phase<EpiWin, MetaOrder, true, true>(lds, g, S, E);
        } else if (PHON(3) && s == 3) {
            if (PHON(13)) gla_phase<false>(p, l, lds, bx, G);
        } else if (PHON(4) && s == 4) {
            if (PHON(15)) gla_scan(p, gt, ngt);
            if (PHON(12)) prep_qk(p, l, gt, ngt);
        } else if (PHON(5) && s == 5) {
            if (PHON(14)) attn_phase(p, l, lds, vcu, G);
            gla_pool(p, l, lds);
        } else if (PHON(6) && s == 6) {
            MetaOrder S; S.init(D, G, bx, 1);
            pg8::Gemm g{(const bf16_t*)(ws + OFF_RA), WT + WT_PA, MROWS, D, 1024, 512}; EpiMergeF E{Y, (const bf16_t*)(ws + OFF_GT)};
            pg8::gemm_phase<EpiMergeF, MetaOrder, true, true>(lds, g, S, E);
        }
    }
#ifdef MK_TIMING
    {
        unsigned* cnt = (unsigned*)(p0.ws + OFF_ROPE);
        grid.sync();
        if (blockIdx.x == 0 && threadIdx.x == 0) { *cnt = (unsigned)(tA * 10ull); __threadfence(); }
        grid.sync();
        const unsigned N = *(volatile unsigned*)cnt; float* o = p0.out;
        for (unsigned i = blockIdx.x * 512 + threadIdx.x; i < N; i += gridDim.x * 512) o[i] += 0.01f;
        if (blockIdx.x == 0 && threadIdx.x == 0) { const unsigned long long t0 = __builtin_amdgcn_s_memrealtime(); while (__builtin_amdgcn_s_memrealtime() - t0 < tB) __builtin_amdgcn_s_sleep(8); }
    }
#endif
}

extern "C" void kernel_launch(void* const* d_in, const int* in_sizes, int n_in, void* d_out, int out_size, void* d_ws, size_t ws_size, hipStream_t stream) {
    static int grid = 0;
    if (grid == 0) {
        if (n_in != 17 || in_sizes[0] != MX * D || out_size != MX * D || ws_size < WS_END) {
            fprintf(stderr, "kernel_launch: unexpected shapes (n_in %d, in0 %d, out %d, ws %zu, need %zu)\n", n_in, n_in > 0 ? in_sizes[0] : -1, out_size, ws_size, (size_t)WS_END); grid = -1; return; }
        int dev = 0, cus = 0, per_cu = 0;
        hipGetDevice(&dev); hipDeviceGetAttribute(&cus, hipDeviceAttributeMultiprocessorCount, dev);
        if (hipFuncSetAttribute((const void*)mk_fwd, hipFuncAttributeMaxDynamicSharedMemorySize, LDS_BYTES) != hipSuccess) { fprintf(stderr, "kernel_launch: hipFuncSetAttribute failed\n"); grid = -1; return; }
        if (hipOccupancyMaxActiveBlocksPerMultiprocessor(&per_cu, (const void*)mk_fwd, 512, LDS_BYTES) != hipSuccess || per_cu < 1) { fprintf(stderr, "kernel_launch: occupancy query says %d\n", per_cu); per_cu = 1; }
        (void)hipGetLastError();
        grid = cus;
    }
    if (grid < 0) return;
    Params p{};
    p.x = (const float*)d_in[0]; p.meta = (const float*)d_in[1]; p.ng = (const float*)d_in[2]; p.wg = (const float*)d_in[3]; p.wu = (const float*)d_in[4]; p.wd = (const float*)d_in[5];
    p.win = (const float*)d_in[6]; p.w2 = (const float*)d_in[7]; p.b2 = (const float*)d_in[8]; p.gn = (const float*)d_in[9]; p.qn = (const float*)d_in[10]; p.kn = (const float*)d_in[11];
    p.wpa = (const float*)d_in[12]; p.wpb = (const float*)d_in[13]; p.bm = (const float*)d_in[14]; p.wout = (const float*)d_in[15]; p.fn = (const float*)d_in[16];
    p.out = (float*)d_out; p.ws = (unsigned char*)d_ws;
    if (hipMemsetAsync((char*)d_ws + OFF_BAR, 0, 16384, stream) != hipSuccess) { fprintf(stderr, "kernel_launch: memset of the barrier words failed\n"); return; }
#if MK_SINGLE
    p.ph_lo = 0; p.ph_hi = NPH;
    { void* args[] = {&p}; hipError_t e = hipLaunchCooperativeKernel((const void*)mk_fwd, dim3(grid), dim3(512), args, LDS_BYTES, stream);
      if (e != hipSuccess) fprintf(stderr, "cooperative launch failed: %s\n", hipGetErrorString(e)); }
#else
    for (int ph = 0; ph < NPH; ++ph) { p.ph_lo = ph; p.ph_hi = ph + 1; void* args[] = {&p};
        hipError_t e = hipLaunchCooperativeKernel((const void*)mk_fwd, dim3(grid), dim3(512), args, LDS_BYTES, stream);
        if (e != hipSuccess) { fprintf(stderr, "cooperative launch %d failed: %s\n", ph, hipGetErrorString(e)); break; } }
#endif
}
```

```cpp
#include <hip/hip_runtime.h>
#include <hip/hip_cooperative_groups.h>
#include <cstdio>
#include <cstdint>
namespace cg = cooperative_groups;
__device__ __forceinline__ int mk_tid() { int t = threadIdx.x; asm volatile("" : "+v"(t)); return t; }
#define PG8_HALF_PM 128
namespace pg8 {
#define PG8_LAS __attribute__((address_space(3)))
typedef unsigned short bf16_t;
typedef short bf16x8 __attribute__((ext_vector_type(8)));
typedef float f32x4 __attribute__((ext_vector_type(4)));
typedef unsigned u32x4 __attribute__((ext_vector_type(4)));
constexpr int BM = 256, BK = 64, HALF = 128, HTB = HALF * BK * 2  , STAGE_BYTES = 8 * HTB, NXCD = 8, WGM = 8;

__host__ __device__ __forceinline__ int lds_byte(int r, int c) { const int st = (r >> 4) * 2 + (c >> 5), rr = r & 15, cc = c & 31, ob = rr * 64 + cc * 2; return st * 1024 + (ob ^ (((ob >> 9) & 1) << 5)); }
__host__ __device__ __forceinline__ void stage_rc(int b, int& R, int& C) { const int st = b / 1024, sb = b % 1024, swz = sb ^ (((sb >> 9) & 1) << 5); R = (st >> 1) * 16 + swz / 64; C = (st & 1) * 32 + (swz % 64) / 2; }
__host__ __device__ __forceinline__ int perm32(int rho) { const int n = rho >> 4, i = rho & 15; return 8 * (i >> 2) + 4 * n + (i & 3); }

struct Unit { int pm, pn, kh; };
struct Gemm { const bf16_t* A; const bf16_t* Bt; int M, N, K, KL; };

struct StaticOrder {
    int nM, nN, nwg, G, c;
    __host__ __device__ void init(int M, int N, int G_, int c_) { nM = M / BM; nN = N / BM; nwg = nM * nN; G = G_; c = c_; }
    __host__ __device__ bool next(int i, Unit& u) const {
        const long L = (long)i * G + c; if (L >= nwg) return false;
        int wgid = (int)L; { const int q = nwg / NXCD, r = nwg % NXCD, xcd = wgid % NXCD, off = wgid / NXCD; wgid = (xcd < r ? xcd * (q + 1) : r * (q + 1) + (xcd - r) * q) + off; }
        const int nig = WGM * nN, gid = wgid / nig, fm = gid * WGM, gsz = (nM - fm) < WGM ? (nM - fm) : WGM;
        u.pm = fm + ((wgid % nig) % gsz); u.pn = (wgid % nig) / gsz; u.kh = 0; return true;
    }
    __device__ __forceinline__ void a_ready(const Unit&) const {}
    __device__ __forceinline__ void done(const Unit&) const {}
};

__device__ __forceinline__ unsigned cvt_pk_bf16(float lo, float hi) { unsigned r; asm volatile("v_cvt_pk_bf16_f32 %0, %1, %2" : "=v"(r) : "v"(lo), "v"(hi)); return r; }
typedef float f32x2 __attribute__((ext_vector_type(2)));
template <class Epi, class Sched, bool ALIGN_EPI = false, bool SP2 = false>
__device__ __forceinline__ void gemm_phase(PG8_LAS unsigned char* lds, const Gemm g, const Sched& S, const Epi& E) {
    const int tid = mk_tid(), wid = __builtin_amdgcn_readfirstlane(tid >> 6), lane = tid & 63, wr = wid >> 2, wc = wid & 3, fr = lane & 15, fq = lane >> 4;
    const int K = g.K, nt = g.KL / BK;
    unsigned voffA[2], voffB[2];
#pragma unroll
    for (int i = 0; i < 2; ++i) { int R, C; stage_rc(tid * 16 + i * 8192, R, C); const int Rb = Epi::PERM ? ((R & ~31) + perm32(R & 31)) : R;
        voffA[i] = (unsigned)(R * K + C) * 2u; voffB[i] = (unsigned)(Rb * K + C) * 2u; }
    const size_t kstep = (size_t)(BK * 2);
    const size_t hstep = (size_t)HALF * K * 2;
    const size_t tstep = 2 * hstep;
    const unsigned ldsw = (unsigned)wid * 1024u;
    const int aoff = lds_byte(wr * 64 + fr, fq * 8), boff = lds_byte(wc * 32 + fr, fq * 8);
#define PG8_SA(b, h) (((b) * 2 + (h)) * HTB)
#define PG8_SB(b, h) ((4 + (b) * 2 + (h)) * HTB)
#define PG8_STAGE(bufoff, gbase, voff) do { _Pragma("unroll") for (int _i = 0; _i < 2; ++_i) \
        __builtin_amdgcn_global_load_lds((const unsigned*)((const char*)(gbase) + (voff)[_i]), (PG8_LAS unsigned*)(lds + (bufoff) + ldsw + _i * 8192), 16, 0, 0); } while (0)
#define PG8_LDA(dst, b, h) do { _Pragma("unroll") for (int m = 0; m < 4; ++m) _Pragma("unroll") for (int k = 0; k < 2; ++k) dst[m][k] = *(const PG8_LAS bf16x8*)(lds + PG8_SA(b, h) + aoff + m * 2048 + k * 1024); } while (0)
#define PG8_LDB(dst, b, h) do { _Pragma("unroll") for (int n = 0; n < 2; ++n) _Pragma("unroll") for (int k = 0; k < 2; ++k) dst[n][k] = *(const PG8_LAS bf16x8*)(lds + PG8_SB(b, h) + boff + n * 2048 + k * 1024); } while (0)
#define PG8_MMA(ai, bj, At, Bt) do { __builtin_amdgcn_s_setprio(1); _Pragma("unroll") for (int m = 0; m < 4; ++m) _Pragma("unroll") for (int n = 0; n < 2; ++n) _Pragma("unroll") for (int k = 0; k < 2; ++k) \
        acc[ai][bj][m][n] = __builtin_amdgcn_mfma_f32_16x16x32_bf16(Bt[n][k], At[m][k], acc[ai][bj][m][n], 0, 0, 0); __builtin_amdgcn_s_setprio(0); } while (0)
#define PG8_WAIT_V(n) asm volatile("s_waitcnt vmcnt(" #n ")" ::: "memory")
#define PG8_WAIT_L(n) asm volatile("s_waitcnt lgkmcnt(" #n ")" ::: "memory")
#define PG8_BAR __builtin_amdgcn_s_barrier()
#define PG8_SCHED __builtin_amdgcn_sched_barrier(0)
    Unit cur, nxt; int ui = 0;
    if (!S.next(0, cur)) return;
    f32x4 acc[2][2][4][2];
#pragma unroll
    for (int a = 0; a < 2; ++a)
#pragma unroll
        for (int b = 0; b < 2; ++b)
#pragma unroll
            for (int m = 0; m < 4; ++m)
#pragma unroll
                for (int n = 0; n < 2; ++n) acc[a][b][m][n] = (f32x4){0.f, 0.f, 0.f, 0.f};
    bf16x8 At[4][2], B0[2][2], B1[2][2];
    const size_t khb = (size_t)g.KL * 2;
    const char* cA = (const char*)g.A + (size_t)cur.pm * tstep + cur.kh * khb; const char* cB = (const char*)g.Bt + (size_t)cur.pn * tstep + cur.kh * khb;
    S.a_ready(cur);
    if constexpr (SP2) {
        PG8_STAGE(PG8_SB(0, 0), cB, voffB); PG8_STAGE(PG8_SB(0, 1), cB + hstep, voffB); PG8_STAGE(PG8_SA(0, 0), cA, voffA); PG8_STAGE(PG8_SA(0, 1), cA + hstep, voffA);
        if (wr == 1) PG8_BAR;
        PG8_WAIT_V(2); PG8_BAR;
        PG8_STAGE(PG8_SB(1, 0), cB + kstep, voffB); PG8_STAGE(PG8_SA(1, 0), cA + kstep, voffA); PG8_STAGE(PG8_SB(1, 1), cB + hstep + kstep, voffB);
        PG8_WAIT_V(6); PG8_BAR;
    } else {
        PG8_STAGE(PG8_SB(0, 0), cB, voffB); PG8_STAGE(PG8_SA(0, 0), cA, voffA); PG8_STAGE(PG8_SB(0, 1), cB + hstep, voffB); PG8_STAGE(PG8_SA(0, 1), cA + hstep, voffA);
        if (wr == 1) PG8_BAR;
        PG8_WAIT_V(4); PG8_BAR;
        PG8_STAGE(PG8_SB(1, 0), cB + kstep, voffB); PG8_STAGE(PG8_SA(1, 0), cA + kstep, voffA); PG8_STAGE(PG8_SB(1, 1), cB + hstep + kstep, voffB);
        PG8_WAIT_V(6); PG8_BAR;
    }
    for (;;) {
        const bool has_next = S.next(ui + 1, nxt);
        const bool b1_unit = (Epi::ZERO_B1_PN < 0) || (cur.pn != Epi::ZERO_B1_PN);
        const bool full_unit = (cur.pm != PG8_HALF_PM);
        const char* nA = has_next ? (const char*)g.A + (size_t)nxt.pm * tstep + nxt.kh * khb : cA; const char* nB = has_next ? (const char*)g.Bt + (size_t)nxt.pn * tstep + nxt.kh * khb : cB;
        for (int t = 0; t < nt; t += 2) {
            const bool last = (t == nt - 2);
            const char* a1 = cA + (size_t)(t + 1) * kstep;
            const char* a2 = last ? nA : cA + (size_t)(t + 2) * kstep; const char* b2 = last ? nB : cB + (size_t)(t + 2) * kstep;
            const char* a3 = a2 + kstep; const char* b3 = b2 + kstep;
            if (last && has_next) S.a_ready(nxt);
            if constexpr (SP2) {
            PG8_LDB(B0, 0, 0); PG8_LDB(B1, 0, 1); PG8_SCHED; PG8_LDA(At, 0, 0); PG8_STAGE(PG8_SA(1, 1), a1 + hstep, voffA);
            PG8_WAIT_V(8); PG8_WAIT_L(0); PG8_BAR; PG8_MMA(0, 0, At, B0); if (b1_unit) PG8_MMA(0, 1, At, B1); PG8_BAR; PG8_SCHED;
            PG8_LDA(At, 0, 1); PG8_STAGE(PG8_SB(0, 0), b2, voffB); PG8_STAGE(PG8_SB(0, 1), b2 + hstep, voffB); PG8_STAGE(PG8_SA(0, 0), a2, voffA);
            PG8_WAIT_V(8); PG8_WAIT_L(0); PG8_BAR; if (full_unit) { PG8_MMA(1, 0, At, B0); if (b1_unit) PG8_MMA(1, 1, At, B1); } PG8_BAR; PG8_SCHED;
            PG8_LDB(B0, 1, 0); PG8_LDB(B1, 1, 1); PG8_SCHED; PG8_LDA(At, 1, 0); PG8_STAGE(PG8_SA(0, 1), a2 + hstep, voffA);
            PG8_WAIT_V(8); PG8_WAIT_L(0); PG8_BAR; PG8_MMA(0, 0, At, B0); if (b1_unit) PG8_MMA(0, 1, At, B1); PG8_BAR; PG8_SCHED;
            PG8_LDA(At, 1, 1); PG8_STAGE(PG8_SB(1, 0), b3, voffB); PG8_STAGE(PG8_SB(1, 1), b3 + hstep, voffB); PG8_STAGE(PG8_SA(1, 0), a3, voffA);
            PG8_WAIT_V(8); PG8_WAIT_L(0); PG8_BAR; if (full_unit) { PG8_MMA(1, 0, At, B0); if (b1_unit) PG8_MMA(1, 1, At, B1); } PG8_BAR; PG8_SCHED;
            } else {
            PG8_LDB(B0, 0, 0); PG8_SCHED; PG8_LDA(At, 0, 0); PG8_STAGE(PG8_SA(1, 1), a1 + hstep, voffA);
            PG8_WAIT_L(8); PG8_BAR; PG8_WAIT_L(0); PG8_MMA(0, 0, At, B0); PG8_BAR; PG8_SCHED;
            PG8_LDB(B1, 0, 1); PG8_STAGE(PG8_SB(0, 0), b2, voffB);
            PG8_BAR; PG8_WAIT_L(0); PG8_MMA(0, 1, At, B1); PG8_BAR;
            PG8_LDA(At, 0, 1); PG8_STAGE(PG8_SA(0, 0), a2, voffA);
            PG8_BAR; PG8_WAIT_L(0); PG8_MMA(1, 0, At, B0); PG8_BAR; PG8_SCHED;
            PG8_STAGE(PG8_SB(0, 1), b2 + hstep, voffB);
            PG8_WAIT_V(6); PG8_BAR; PG8_MMA(1, 1, At, B1); PG8_BAR;
            PG8_LDB(B0, 1, 0); PG8_SCHED; PG8_LDA(At, 1, 0); PG8_STAGE(PG8_SA(0, 1), a2 + hstep, voffA);
            PG8_WAIT_L(8); PG8_BAR; PG8_WAIT_L(0); PG8_MMA(0, 0, At, B0); PG8_BAR; PG8_SCHED;
            PG8_LDB(B1, 1, 1); PG8_STAGE(PG8_SB(1, 0), b3, voffB);
            PG8_BAR; PG8_WAIT_L(0); PG8_MMA(0, 1, At, B1); PG8_BAR;
            PG8_LDA(At, 1, 1); PG8_STAGE(PG8_SA(1, 0), a3, voffA);
            PG8_BAR; PG8_WAIT_L(0); PG8_MMA(1, 0, At, B0); PG8_BAR; PG8_SCHED;
            PG8_STAGE(PG8_SB(1, 1), b3 + hstep, voffB);
            PG8_WAIT_V(6); PG8_BAR; PG8_MMA(1, 1, At, B1); PG8_BAR;
            }
        }
        if constexpr (ALIGN_EPI) { if (wr == 0) PG8_BAR; }
        bool keep_acc = false;
        if constexpr (Epi::MIDK) { if (cur.kh == 0) { E.mid(acc, cur, wr, wc, fr, fq); keep_acc = true; } }
        if constexpr (!Epi::AFTER_DRAIN) { if (!keep_acc) { E(acc, cur, wr, wc, fr, fq); S.done(cur); } }
        if (!has_next) break;
        if (!keep_acc)
#pragma unroll
        for (int a = 0; a < 2; ++a)
#pragma unroll
            for (int b = 0; b < 2; ++b)
#pragma unroll
                for (int m = 0; m < 4; ++m)
#pragma unroll
                    for (int n = 0; n < 2; ++n) acc[a][b][m][n] = (f32x4){0.f, 0.f, 0.f, 0.f};
        cur = nxt; cA = nA; cB = nB; ++ui;
        if constexpr (ALIGN_EPI) { if (wr == 1) PG8_BAR; }
    }
    PG8_WAIT_V(0);
    if constexpr (!ALIGN_EPI) { if (wr == 0) PG8_BAR; }
    PG8_BAR;
    if constexpr (Epi::AFTER_DRAIN) { E.fused(acc, cur, wr, wc, fr, fq, lds, wid, lane); S.done(cur); }
#undef PG8_SA
#undef PG8_SB
#undef PG8_STAGE
#undef PG8_LDA
#undef PG8_LDB
#undef PG8_MMA
#undef PG8_WAIT_V
#undef PG8_WAIT_L
#undef PG8_BAR
#undef PG8_SCHED
}
}
#ifndef PH_MASK
#define PH_MASK 0xffff
#endif
#define PHON(k) ((PH_MASK >> (k)) & 1)
#ifndef MK_SINGLE
#define MK_SINGLE 1
#endif
#define LAS __attribute__((address_space(3)))
typedef unsigned short bf16_t;
typedef short bf16x8 __attribute__((ext_vector_type(8)));
typedef float f32x4 __attribute__((ext_vector_type(4)));
typedef float f32x16 __attribute__((ext_vector_type(16)));
typedef unsigned u32x4 __attribute__((ext_vector_type(4)));
typedef unsigned u32x2 __attribute__((ext_vector_type(2)));

constexpr int D = 1024, NB = 8, SEQ = 4096, DEPTH = 4, NMETA = 16, DFF = 2816, DIN = 4384;
constexpr int MX = NB * SEQ;
constexpr int MROWS = MX + 256;
constexpr int NVALID = MX + NB * NMETA;
constexpr int LP = 4160;
constexpr int NCH = 65;
constexpr float EPS = 1e-6f;
constexpr float LOG2E = 1.4426950408889634f;
constexpr int WIN_N = 4608;
constexpr int NPH = 42;

constexpr size_t SZ_H = (size_t)MROWS * D * 4, SZ_512 = (size_t)MROWS * 512 * 2, SZ_128 = (size_t)MROWS * 128 * 2;
constexpr size_t SZ_VT = (size_t)NB * 2 * 64 * LP * 2, SZ_LR = (size_t)MROWS * 32 * 4, SZ_GT = (size_t)MROWS * 2048 * 2;
constexpr size_t OFF_H = 0;
constexpr size_t OFF_QKA = OFF_H + SZ_H, OFF_VA = OFF_QKA + SZ_512, OFF_RA = OFF_VA + SZ_512, OFF_QB = OFF_RA + SZ_512;
constexpr size_t OFF_KB = OFF_QB + SZ_512, OFF_VT = OFF_KB + SZ_128, OFF_LR = OFF_VT + SZ_VT, OFF_GT = OFF_LR + SZ_LR, R_END = OFF_GT + SZ_GT;
constexpr size_t OFF_HID = OFF_QKA;
constexpr size_t OFF_Y = OFF_QKA;
static_assert((size_t)MROWS * DFF * 2 <= R_END - OFF_QKA, "hid overlay");
constexpr size_t SZ_S = (size_t)64 * NCH * 8192 * 2, SZ_DEC = (size_t)64 * NCH * 64 * 4, SZ_SSQ = (size_t)13 * MROWS * 16 * 4, SZ_ROPE = (size_t)SEQ * 64 * 4;
constexpr size_t OFF_S = R_END, OFF_DEC = OFF_S + SZ_S, OFF_SSQ = OFF_DEC + SZ_DEC, OFF_ROPE = OFF_SSQ + SZ_SSQ, OFF_CTR = OFF_ROPE + SZ_ROPE, OFF_BAR = OFF_CTR + 4096, WS_END = OFF_BAR + 16384;
constexpr size_t OO_WT = 0;
constexpr size_t WT_GU0 = 0, WT_DN0 = WT_GU0 + (size_t)5632 * 1024, WT_WIN = WT_DN0 + (size_t)1024 * 2816, WT_PA = WT_WIN + (size_t)WIN_N * 1024,
                 WT_PB = WT_PA + (size_t)1024 * 512, WT_OUT = WT_PB + (size_t)1024 * 512, WT_GU1 = WT_OUT + (size_t)1024 * 1024, WT_DN1 = WT_GU1 + (size_t)5632 * 1024,
                 WT_END = WT_DN1 + (size_t)1024 * 2816;
static_assert(OO_WT + 2 * WT_END * 2 <= (size_t)MX * D * 4, "d_out scratch");

constexpr int LDS_BYTES = 147456;

struct Params {
    const float *x, *meta, *ng, *wg, *wu, *wd, *win, *w2, *b2, *gn, *qn, *kn, *wpa, *wpb, *bm, *wout, *fn;
    float* out; unsigned char* ws; int ph_lo, ph_hi;
};

typedef float f32x2_t __attribute__((ext_vector_type(2))); typedef __bf16 bf16x2_t __attribute__((ext_vector_type(2)));
__device__ __forceinline__ unsigned pk(float lo, float hi) { f32x2_t v = {lo, hi}; bf16x2_t b = __builtin_convertvector(v, bf16x2_t); return __builtin_bit_cast(unsigned, b); }
__device__ __forceinline__ float bflo(unsigned w) { return __uint_as_float(w << 16); }
__device__ __forceinline__ float bfhi(unsigned w) { return __uint_as_float(w & 0xffff0000u); }
__device__ __forceinline__ float bf1(unsigned short b) { return __uint_as_float((unsigned)b << 16); }
__device__ __forceinline__ unsigned short f2bf(float f) { return (unsigned short)(pk(f, 0.f) & 0xffffu); }
__device__ __forceinline__ float fexp(float x) { return __builtin_amdgcn_exp2f(x * LOG2E); }
__device__ __forceinline__ float sigm(float x) { return __builtin_amdgcn_rcpf(1.f + fexp(-x)); }
__device__ __forceinline__ float siluf(float x) { return x * sigm(x); }
__device__ __forceinline__ float rstd_row(const float* ssq, int row) {
    const f32x4* q = (const f32x4*)(ssq + (size_t)row * 16); const f32x4 a = q[0], b = q[1], c = q[2], d = q[3];
    const float t = ((a[0] + a[1]) + (a[2] + a[3])) + ((b[0] + b[1]) + (b[2] + b[3])) + ((c[0] + c[1]) + (c[2] + c[3])) + ((d[0] + d[1]) + (d[2] + d[3]));
    return __builtin_amdgcn_rsqf(t * (1.0f / D) + EPS); }
#define LDS_WAIT() asm volatile("s_waitcnt lgkmcnt(0)" ::: "memory")
#define DPPF(old, src, ctrl, rmask, bmask, bc) __builtin_bit_cast(float, __builtin_amdgcn_update_dpp(__builtin_bit_cast(int, (float)(old)), __builtin_bit_cast(int, (float)(src)), ctrl, rmask, bmask, bc))
__device__ __forceinline__ float wave_incl_scan(float v) {
    v += DPPF(0.f, v, 0x111, 0xf, 0xf, true); v += DPPF(0.f, v, 0x112, 0xf, 0xf, true); v += DPPF(0.f, v, 0x114, 0xf, 0xf, true); v += DPPF(0.f, v, 0x118, 0xf, 0xf, true);
    v += DPPF(0.f, v, 0x142, 0xa, 0xf, false); v += DPPF(0.f, v, 0x143, 0xc, 0xf, false); return v; }
__device__ __forceinline__ float lane_bcast(float v, int l) { return __builtin_bit_cast(float, __builtin_amdgcn_readlane(__builtin_bit_cast(int, v), l)); }

struct MetaOrder {
    pg8::StaticOrder main; int nN, c, G, nmain, dbl;
    __device__ __forceinline__ void init(int N, int G_, int c_, int dbl_ = 0) { main.init(MX, N, G_, c_); nN = N / 256; c = c_; G = G_; dbl = dbl_; const int nw = 128 * nN; nmain = (c_ < nw) ? (nw - c_ + G_ - 1) / G_ : 0; }
    __device__ __forceinline__ bool next(int ii, pg8::Unit& u) const {
        const int i = dbl ? (ii >> 1) : ii, kh = dbl ? (ii & 1) : 0;
        if (i < nmain) { const bool ok = main.next(i, u); u.kh = kh; return ok; }
        const int j = (i - nmain) * G + c; if (j >= nN) return false;
        u.pm = PG8_HALF_PM; u.pn = j; u.kh = kh; return true; }
    __device__ __forceinline__ void a_ready(const pg8::Unit&) const {}
    __device__ __forceinline__ void done(const pg8::Unit&) const {}
};

struct EpiSwiglu {
    static constexpr bool PERM = true, AFTER_DRAIN = false, MIDK = false; static constexpr int ZERO_B1_PN = -1;
    bf16_t* O; const float* ssq;
    __device__ __forceinline__ void operator()(const f32x4 (&acc)[2][2][4][2], const pg8::Unit& u, int wr, int wc, int fr, int fq) const {
        int row0 = u.pm * 256 + wr * 64 + fr; asm volatile("" : "+v"(row0)); const int col0 = u.pn * 128 + wc * 32 + 8 * fq;
#pragma unroll
        for (int ai = 0; ai < 2; ++ai)
#pragma unroll
            for (int m = 0; m < 4; ++m) {
                if (ai == 1 && u.pm == PG8_HALF_PM) continue;
                const int row = row0 + ai * 128 + m * 16; const float rs = rstd_row(ssq, row);
                float h[8];
#pragma unroll
                for (int n = 0; n < 2; ++n)
#pragma unroll
                    for (int e = 0; e < 4; ++e) { const float g = acc[ai][0][m][n][e] * rs, up = acc[ai][1][m][n][e] * rs; h[n * 4 + e] = siluf(g) * up; }
                u32x4 w; w.x = pk(h[0], h[1]); w.y = pk(h[2], h[3]); w.z = pk(h[4], h[5]); w.w = pk(h[6], h[7]);
                *(u32x4*)(O + (size_t)row * DFF + col0) = w;
                asm volatile("" ::: "memory");
            }
    }
};
struct EpiResid {
    static constexpr bool PERM = true, AFTER_DRAIN = false, MIDK = false; static constexpr int ZERO_B1_PN = -1;
    bf16_t* HB; float* ssq_out; float scale;
    __device__ __forceinline__ void operator()(const f32x4 (&acc)[2][2][4][2], const pg8::Unit& u, int wr, int wc, int fr, int fq) const {
        int row0 = u.pm * 256 + wr * 64 + fr; asm volatile("" : "+v"(row0)); const int col0 = u.pn * 256 + wc * 32 + 8 * fq;
#pragma unroll
        for (int ai = 0; ai < 2; ++ai)
#pragma unroll
            for (int m = 0; m < 4; ++m) {
                if (ai == 1 && u.pm == PG8_HALF_PM) continue;
                const int row = row0 + ai * 128 + m * 16; float ss = 0.f;
#pragma unroll
                for (int bj = 0; bj < 2; ++bj) {
                    bf16_t* hp = HB + (size_t)row * D + col0 + bj * 128;
                    const u32x4 hw = *(const u32x4*)hp;
                    f32x4 h0 = (f32x4){bflo(hw.x), bfhi(hw.x), bflo(hw.y), bfhi(hw.y)}, h1 = (f32x4){bflo(hw.z), bfhi(hw.z), bflo(hw.w), bfhi(hw.w)};
                    h0 = h0 + acc[ai][bj][m][0] * scale; h1 = h1 + acc[ai][bj][m][1] * scale;
                    u32x4 w; w.x = pk(h0[0], h0[1]); w.y = pk(h0[2], h0[3]); w.z = pk(h1[0], h1[1]); w.w = pk(h1[2], h1[3]);
                    *(u32x4*)hp = w;
                    ss += (h0[0] * h0[0] + h0[1] * h0[1]) + (h0[2] * h0[2] + h0[3] * h0[3]) + (h1[0] * h1[0] + h1[1] * h1[1]) + (h1[2] * h1[2] + h1[3] * h1[3]);
                }
                ss += __shfl_xor(ss, 16); ss += __shfl_xor(ss, 32);
                if (fq == 0) ssq_out[(size_t)row * 16 + u.pn * 4 + wc] = ss;
                asm volatile("" ::: "memory");
            }
    }
};
struct EpiWin {
    static constexpr bool PERM = true, AFTER_DRAIN = false, MIDK = false; static constexpr int ZERO_B1_PN = 9;
    unsigned char* ws; const float* ssq; const float* bm;
    __device__ __forceinline__ void operator()(const f32x4 (&acc)[2][2][4][2], const pg8::Unit& u, int wr, int wc, int fr, int fq) const {
        int row0 = u.pm * 256 + wr * 64 + fr; asm volatile("" : "+v"(row0)); const int cw = wc * 32 + 8 * fq, pn = u.pn;
#pragma unroll
        for (int ai = 0; ai < 2; ++ai)
#pragma unroll
            for (int m = 0; m < 4; ++m) {
                if (ai == 1 && u.pm == PG8_HALF_PM) continue;
                const int row = row0 + ai * 128 + m * 16; const float rs = rstd_row(ssq, row);
                if (pn < 8) {
                    bf16_t* base = (pn < 4) ? (bf16_t*)(ws + OFF_QKA + (size_t)(pn >> 1) * SZ_512) + (size_t)row * 512 + (pn & 1) * 256 + cw
                                            : (bf16_t*)(ws + OFF_RA) + (size_t)row * 1024 + (pn - 4) * 256 + cw;
                    const float sc = (pn == 0) ? rs * 0.125f : rs; const bool gate = (pn == 4 || pn == 5);
#pragma unroll
                    for (int bj = 0; bj < 2; ++bj) { f32x4 a = acc[ai][bj][m][0] * sc, b = acc[ai][bj][m][1] * sc;
                        if (gate) { a = (f32x4){siluf(a[0]), siluf(a[1]), siluf(a[2]), siluf(a[3])}; b = (f32x4){siluf(b[0]), siluf(b[1]), siluf(b[2]), siluf(b[3])}; }
                        u32x4 w; w.x = pk(a[0], a[1]); w.y = pk(a[2], a[3]); w.z = pk(b[0], b[1]); w.w = pk(b[2], b[3]); *(u32x4*)(base + bj * 128) = w; }
                } else if (pn == 8) {
                    { const f32x4 a = acc[ai][0][m][0] * rs, b = acc[ai][0][m][1] * rs;
                      u32x4 w; w.x = pk(a[0], a[1]); w.y = pk(a[2], a[3]); w.z = pk(b[0], b[1]); w.w = pk(b[2], b[3]); *(u32x4*)((bf16_t*)(ws + OFF_KB) + (size_t)row * 128 + cw) = w; }
                    if (row < NVALID) {
                        int bb, pos; if (row < MX) { bb = row >> 12; pos = 64 + (row & 4095); } else { bb = (row - MX) >> 4; pos = 48 + ((row - MX) & 15); }
                        const int kvh = cw >> 6, d0 = cw & 63;
                        bf16_t* vt = (bf16_t*)(ws + OFF_VT) + ((size_t)(bb * 2 + kvh) * 64 + d0) * LP + pos;
#pragma unroll
                        for (int n = 0; n < 2; ++n)
#pragma unroll
                            for (int e = 0; e < 4; ++e) vt[(size_t)(n * 4 + e) * LP] = f2bf(acc[ai][1][m][n][e] * rs);
                    }
                } else if (pn == 9) {
                    if (wc == 0) { float* lp = (float*)(ws + OFF_LR) + (size_t)row * 32 + 8 * fq; *(f32x4*)lp = acc[ai][0][m][0] * rs; *(f32x4*)(lp + 4) = acc[ai][0][m][1] * rs; }
                } else {
                    const int gc = (pn - 10) * 256 + cw; bf16_t* base = (bf16_t*)(ws + OFF_GT) + (size_t)row * 2048 + gc;
#pragma unroll
                    for (int bj = 0; bj < 2; ++bj) { const f32x4 b0 = *(const f32x4*)(bm + gc + bj * 128), b1 = *(const f32x4*)(bm + gc + bj * 128 + 4);
                        const f32x4 a = acc[ai][bj][m][0] * rs + b0, b = acc[ai][bj][m][1] * rs + b1;
                        u32x4 w; w.x = pk(sigm(a[0]), sigm(a[1])); w.y = pk(sigm(a[2]), sigm(a[3])); w.z = pk(sigm(b[0]), sigm(b[1])); w.w = pk(sigm(b[2]), sigm(b[3])); *(u32x4*)(base + bj * 128) = w; }
                }
                asm volatile("" ::: "memory");
            }
    }
};
struct EpiMergeF {
    static constexpr bool PERM = true, AFTER_DRAIN = false, MIDK = true; static constexpr int ZERO_B1_PN = -1;
    bf16_t* Y; const bf16_t* G;
    __device__ __forceinline__ void mid(f32x4 (&acc)[2][2][4][2], const pg8::Unit& u, int wr, int wc, int fr, int fq) const {
        int row0 = u.pm * 256 + wr * 64 + fr; asm volatile("" : "+v"(row0)); const int col0 = u.pn * 256 + wc * 32 + 8 * fq;
#pragma unroll
        for (int ai = 0; ai < 2; ++ai)
#pragma unroll
            for (int m = 0; m < 4; ++m) {
                if (ai == 1 && u.pm == PG8_HALF_PM) continue;
                const int row = row0 + ai * 128 + m * 16;
#pragma unroll
                for (int bj = 0; bj < 2; ++bj) { const int col = col0 + bj * 128;
                    const u32x4 ga = *(const u32x4*)(G + (size_t)row * 2048 + col), gb = *(const u32x4*)(G + (size_t)row * 2048 + 1024 + col);
                    f32x4 r0, r1;
                    r0[0] = bflo(ga.x) * __builtin_amdgcn_rcpf(bflo(gb.x)); r0[1] = bfhi(ga.x) * __builtin_amdgcn_rcpf(bfhi(gb.x)); r0[2] = bflo(ga.y) * __builtin_amdgcn_rcpf(bflo(gb.y)); r0[3] = bfhi(ga.y) * __builtin_amdgcn_rcpf(bfhi(gb.y));
                    r1[0] = bflo(ga.z) * __builtin_amdgcn_rcpf(bflo(gb.z)); r1[1] = bfhi(ga.z) * __builtin_amdgcn_rcpf(bfhi(gb.z)); r1[2] = bflo(ga.w) * __builtin_amdgcn_rcpf(bflo(gb.w)); r1[3] = bfhi(ga.w) * __builtin_amdgcn_rcpf(bfhi(gb.w));
                    acc[ai][bj][m][0] = acc[ai][bj][m][0] * r0; acc[ai][bj][m][1] = acc[ai][bj][m][1] * r1;
                }
                asm volatile("" ::: "memory");
            }
    }
    __device__ __forceinline__ void operator()(const f32x4 (&acc)[2][2][4][2], const pg8::Unit& u, int wr, int wc, int fr, int fq) const {
        int row0 = u.pm * 256 + wr * 64 + fr; asm volatile("" : "+v"(row0)); const int col0 = u.pn * 256 + wc * 32 + 8 * fq;
#pragma unroll
        for (int ai = 0; ai < 2; ++ai)
#pragma unroll
            for (int m = 0; m < 4; ++m) {
                if (ai == 1 && u.pm == PG8_HALF_PM) continue;
                const int row = row0 + ai * 128 + m * 16;
#pragma unroll
                for (int bj = 0; bj < 2; ++bj) { const int col = col0 + bj * 128;
                    const u32x4 gb = *(const u32x4*)(G + (size_t)row * 2048 + 1024 + col);
                    float v[8];
                    v[0] = bflo(gb.x) * acc[ai][bj][m][0][0]; v[1] = bfhi(gb.x) * acc[ai][bj][m][0][1]; v[2] = bflo(gb.y) * acc[ai][bj][m][0][2]; v[3] = bfhi(gb.y) * acc[ai][bj][m][0][3];
                    v[4] = bflo(gb.z) * acc[ai][bj][m][1][0]; v[5] = bfhi(gb.z) * acc[ai][bj][m][1][1]; v[6] = bflo(gb.w) * acc[ai][bj][m][1][2]; v[7] = bfhi(gb.w) * acc[ai][bj][m][1][3];
                    u32x4 w; w.x = pk(v[0], v[1]); w.y = pk(v[2], v[3]); w.z = pk(v[4], v[5]); w.w = pk(v[6], v[7]); *(u32x4*)(Y + (size_t)row * D + col) = w;
                }
                asm volatile("" ::: "memory");
            }
    }
};

__device__ __forceinline__ void conv_item(const float* W, int N, int K, int src_n0, const float* gain, bf16_t* WT, int n0, int k0, LAS float* scr, int lane, int dk = 0) {
#pragma unroll
    for (int i = 0; i < 8; ++i) { const int kk = 8 * i + (lane >> 3), n4 = (lane & 7) * 4; f32x4 v = (f32x4){0.f, 0.f, 0.f, 0.f};
        if (src_n0 >= 0) { v = *(const f32x4*)(W + (size_t)(k0 + kk) * N + src_n0 + n4); if (gain) v = v * gain[k0 + kk]; }
        scr[kk * 33 + n4] = v[0]; scr[kk * 33 + n4 + 1] = v[1]; scr[kk * 33 + n4 + 2] = v[2]; scr[kk * 33 + n4 + 3] = v[3]; }
    LDS_WAIT(); __builtin_amdgcn_wave_barrier();
    const int c = lane & 7;
#pragma unroll
    for (int j = 0; j < 4; ++j) { const int n = (lane >> 3) + 8 * j; const LAS float* s = scr + (8 * c) * 33 + n;
        u32x4 o; o.x = pk(s[0 * 33], s[1 * 33]); o.y = pk(s[2 * 33], s[3 * 33]); o.z = pk(s[4 * 33], s[5 * 33]); o.w = pk(s[6 * 33], s[7 * 33]);
        *(u32x4*)(WT + (size_t)(n0 + n) * K + dk + k0 + 8 * c) = o; }
    LDS_WAIT(); __builtin_amdgcn_wave_barrier();
}
__device__ __forceinline__ int conv_win_src(int n0) {
    if (n0 < 1536) return n0;
    if (n0 < 2304) return n0 + 32;
    if (n0 == 2304) return 1536;
    if (n0 < 2560) return -1;
    return n0 - 224;
}
constexpr int CV_GU = 16 * 176, CV_DN = 44 * 32, CV_WIN = 16 * 144, CV_P = 8 * 32, CV_O = 16 * 32;
constexpr int CV_NIT = 2 * CV_GU + 2 * CV_DN + CV_WIN + 2 * CV_P + CV_O;
__device__ __forceinline__ void conv_one(const Params& p, int l, int it, LAS float* scr, int lane) {
    bf16_t* WT = (bf16_t*)((unsigned char*)p.out + OO_WT) + (size_t)(l & 1) * WT_END;
    int r = it;
    if (r < 2 * CV_GU) { const int f = r / CV_GU; r -= f * CV_GU; const int kb = r / 176, nb = r % 176, n0 = nb * 32;
        const int t = n0 >> 8, half = (n0 >> 7) & 1, j0 = n0 & 127;
        const float* W = (half ? p.wu : p.wg) + (size_t)(l * 2 + f) * D * DFF;
        conv_item(W, DFF, D, 128 * t + j0, p.ng + (size_t)(l * 3 + (f ? 2 : 0)) * D, WT + (f ? WT_GU1 : WT_GU0), n0, kb * 64, scr, lane); return; }
    r -= 2 * CV_GU;
    if (r < 2 * CV_DN) { const int f = r / CV_DN; r -= f * CV_DN; const int kb = r / 32, nb = r % 32;
        conv_item(p.wd + (size_t)(l * 2 + f) * DFF * D, D, DFF, nb * 32, nullptr, WT + (f ? WT_DN1 : WT_DN0), nb * 32, kb * 64, scr, lane); return; }
    r -= 2 * CV_DN;
    if (r < CV_WIN) { const int kb = r / 144, nb = r % 144;
        conv_item(p.win + (size_t)l * D * DIN, DIN, D, conv_win_src(nb * 32), p.ng + (size_t)(l * 3 + 1) * D, WT + WT_WIN, nb * 32, kb * 64, scr, lane); return; }
    r -= CV_WIN;
    if (r < 2 * CV_P) { const int f = r / CV_P; r -= f * CV_P; const int kb = r / 32, nb = r % 32;
        conv_item((f ? p.wpb : p.wpa) + (size_t)l * 512 * D, D, 1024, nb * 32, nullptr, WT + WT_PA, nb * 32, kb * 64, scr, lane, f * 512); return; }
    r -= 2 * CV_P;
    { const int kb = r / 32, nb = r % 32; conv_item(p.wout + (size_t)l * D * D, D, D, nb * 32, nullptr, WT + WT_OUT, nb * 32, kb * 64, scr, lane); }
}
__device__ __forceinline__ void conv_layer(const Params& p, int l, LAS unsigned char* lds, int gw, int ngw, int wid, int lane) {
    LAS float* scr = (LAS float*)(lds + wid * 8448);
    for (int it = gw; it < CV_NIT; it += ngw) conv_one(p, l, it, scr, lane);
}

__device__ __forceinline__ float wave_sum(float v) {
#pragma unroll
    for (int o = 1; o < 64; o <<= 1) v += __shfl_xor(v, o);
    return v;
}
__device__ __forceinline__ void prologue(const Params& p, int gw, int ngw, int lane) {
    bf16_t* HB = (bf16_t*)(p.ws + OFF_H); float* SSQ = (float*)(p.ws + OFF_SSQ);
    for (int row = gw; row < MROWS; row += ngw) {
        f32x4 v[4]; float s = 0.f;
#pragma unroll
        for (int j = 0; j < 4; ++j) {
            if (row < MX) v[j] = *((const f32x4*)(p.x + (size_t)row * D) + lane + 64 * j);
            else if (row < NVALID) v[j] = *((const f32x4*)(p.meta + (size_t)((row - MX) & 15) * D) + lane + 64 * j);
            else v[j] = (f32x4){0.f, 0.f, 0.f, 0.f};
            s += (v[j][0] * v[j][0] + v[j][1] * v[j][1]) + (v[j][2] * v[j][2] + v[j][3] * v[j][3]);
        }
        s = wave_sum(s);
#pragma unroll
        for (int j = 0; j < 4; ++j) {
            u32x2 w; w.x = pk(v[j][0], v[j][1]); w.y = pk(v[j][2], v[j][3]); *((u32x2*)(HB + (size_t)row * D) + lane + 64 * j) = w; }
        if (lane < 16) SSQ[(size_t)row * 16 + lane] = (lane == 0) ? s : 0.f;
    }
    const int gt = gw * 64 + lane, ngt = ngw * 64;
    float* ROPE = (float*)(p.ws + OFF_ROPE);
    for (int i = gt; i < SEQ * 32; i += ngt) { const int t = i >> 5, f = i & 31, fi = f & 15; const float pos = (float)((f < 16) ? (t >> 6) : (t & 63));
        const float inv = exp2f(-(float)fi * (13.287712379549449f / 16.0f)); float rev = pos * inv * 0.15915494309189535f; rev -= floorf(rev);
        ROPE[t * 64 + f] = __builtin_amdgcn_cosf(rev); ROPE[t * 64 + 32 + f] = __builtin_amdgcn_sinf(rev); }
    if (gt < DEPTH) ((unsigned*)(p.ws + OFF_CTR))[gt * 64] = 0u;
    bf16_t* VT = (bf16_t*)(p.ws + OFF_VT);
    for (int i = gt; i < NB * 2 * 64 * 48; i += ngt) { const int r = i / 48, c = i % 48; VT[(size_t)r * LP + c] = 0; }
}
__device__ __forceinline__ void final_norm(const Params& p, int gw, int ngw, int lane) {
    const bf16_t* HB = (const bf16_t*)(p.ws + OFF_H); const float* SSQ = (const float*)(p.ws + OFF_SSQ) + (size_t)12 * MROWS * 16;
    for (int row = gw; row < MX; row += ngw) { const float rs = rstd_row(SSQ, row);
#pragma unroll
        for (int j = 0; j < 4; ++j) { const u32x2 w = *((const u32x2*)(HB + (size_t)row * D) + lane + 64 * j); const f32x4 g = *((const f32x4*)p.fn + lane + 64 * j);
            const f32x4 v = (f32x4){bflo(w.x), bfhi(w.x), bflo(w.y), bfhi(w.y)};
            *((f32x4*)(p.out + (size_t)row * D) + lane + 64 * j) = v * rs * g; } }
}

__device__ __forceinline__ void prep_qk(const Params& p, int l, int gt, int ngt) {
    const float* ROPE = (const float*)(p.ws + OFF_ROPE); const int j = gt & 7;
    for (int item = gt >> 3; item < NVALID * 10; item += ngt >> 3) {
        const int row = item / 10, hd = item % 10;
        bf16_t* ptr = ((hd < 8) ? (bf16_t*)(p.ws + OFF_RA) + (size_t)row * 1024 + 512 + hd * 64 : (bf16_t*)(p.ws + OFF_KB) + (size_t)row * 128 + (hd - 8) * 64) + 8 * j;
        const float* gain = ((hd < 8) ? p.qn : p.kn) + l * 64 + 8 * j; const float osc = (hd < 8) ? 0.125f * LOG2E : 1.0f;
        const u32x4 w = *(const u32x4*)ptr; const f32x4 g0 = *(const f32x4*)gain, g1 = *(const f32x4*)(gain + 4);
        float v[8] = {bflo(w.x), bfhi(w.x), bflo(w.y), bfhi(w.y), bflo(w.z), bfhi(w.z), bflo(w.w), bfhi(w.w)};
        float ss = 0.f;
#pragma unroll
        for (int e = 0; e < 8; ++e) ss += v[e] * v[e];
        ss += __shfl_xor(ss, 1); ss += __shfl_xor(ss, 2); ss += __shfl_xor(ss, 4);
        const float rs = __builtin_amdgcn_rsqf(ss * (1.0f / 64.0f) + EPS);
#pragma unroll
        for (int e = 0; e < 8; ++e) v[e] = v[e] * rs * ((e < 4) ? g0[e] : g1[e - 4]);
        if (row < MX) {
            const float* cs = ROPE + (size_t)(row & 4095) * 64 + 16 * (j >> 2) + 8 * (j & 1);
            const f32x4 c0 = *(const f32x4*)cs, c1 = *(const f32x4*)(cs + 4), s0 = *(const f32x4*)(cs + 32), s1 = *(const f32x4*)(cs + 36);
#pragma unroll
            for (int e = 0; e < 8; ++e) { const float c = (e < 4) ? c0[e] : c1[e - 4], sn = (e < 4) ? s0[e] : s1[e - 4]; const float o = __shfl_xor(v[e], 2);
                v[e] = (j & 2) ? (v[e] * c + o * sn) : (v[e] * c - o * sn); } }
        *(u32x4*)ptr = (u32x4){pk(v[0] * osc, v[1] * osc), pk(v[2] * osc, v[3] * osc), pk(v[4] * osc, v[5] * osc), pk(v[6] * osc, v[7] * osc)};
    }
}

constexpr int AT_TILE = 64 * 144, AT_K = 0, AT_V = 2 * AT_TILE, AT_VP = 136, AT_VTILE = 64 * AT_VP;
template <int NBLK, bool TRACK> __device__ __forceinline__ void attn_unit(const Params& p, int b, int kvh, int jb, LAS unsigned char* lds) {
    const int tid = mk_tid(), lane = tid & 63, wid = __builtin_amdgcn_readfirstlane(tid >> 6), r32 = lane & 31, hi = lane >> 5;
    bf16_t* QB = (bf16_t*)(p.ws + OFF_RA) + 512; const bf16_t* KB = (const bf16_t*)(p.ws + OFF_KB); const bf16_t* VT = (const bf16_t*)(p.ws + OFF_VT);
    const int hq = kvh * 4 + (wid >> 1);
    bool qvalid[NBLK]; bf16_t* qp[NBLK]; bf16x8 qr[NBLK][4];
#pragma unroll
    for (int blk = 0; blk < NBLK; ++blk) { const int rr = (wid & 1) * 64 + blk * 32 + r32;
        qvalid[blk] = (jb >= 0) || (rr < 16);
        const size_t qrow = (jb >= 0) ? (size_t)b * SEQ + jb * 128 + rr : (size_t)MX + b * 16 + (rr & 15);
        qp[blk] = QB + qrow * 1024 + hq * 64;
#pragma unroll
        for (int ds = 0; ds < 4; ++ds) qr[blk][ds] = qvalid[blk] ? *(const bf16x8*)(qp[blk] + ds * 16 + hi * 8) : (bf16x8){0, 0, 0, 0, 0, 0, 0, 0}; }
    const int tk = tid >> 3, tc = tid & 7;
    const bf16_t* vsrc = VT + ((size_t)(b * 2 + kvh) * 64 + tk) * LP + tc * 8;
    const bf16_t* ksrc = KB + ((size_t)b * SEQ + tk) * 128 + kvh * 64 + tc * 8;
    const bf16_t* ksrc0 = KB + ((size_t)MX + b * 16 + (tk - 48)) * 128 + kvh * 64 + tc * 8;
    const int lst = tk * 144 + tc * 16, lstv = tk * AT_VP + tc * 16;
    u32x4 kreg, vreg;
    kreg = (tk >= 48) ? *(const u32x4*)ksrc0 : (u32x4){0u, 0u, 0u, 0u}; vreg = *(const u32x4*)vsrc;
    *(LAS u32x4*)(lds + AT_K + lst) = kreg; *(LAS u32x2*)(lds + AT_V + lstv) = (u32x2){vreg.x, vreg.y}; *(LAS u32x2*)(lds + AT_V + lstv + 8) = (u32x2){vreg.z, vreg.w};
    __syncthreads();
    f32x16 o0[NBLK], o1[NBLK]; float mrun[NBLK], lrun[NBLK];
#pragma unroll
    for (int blk = 0; blk < NBLK; ++blk) { mrun[blk] = -1e30f; lrun[blk] = 0.f;
#pragma unroll
        for (int r = 0; r < 16; ++r) { o0[blk][r] = 0.f; o1[blk][r] = 0.f; } }
    for (int t = 0; t < NCH; ++t) {
        const int buf = t & 1;
        if (t + 1 < NCH) { kreg = *(const u32x4*)(ksrc + (size_t)t * 64 * 128); vreg = *(const u32x4*)(vsrc + (t + 1) * 64); }
        const LAS unsigned char* Kl = lds + AT_K + buf * AT_TILE; const LAS unsigned char* Vl = lds + AT_V + buf * AT_VTILE;
        f32x16 p0[NBLK], p1[NBLK];
#pragma unroll
        for (int blk = 0; blk < NBLK; ++blk)
#pragma unroll
            for (int r = 0; r < 16; ++r) { p0[blk][r] = 0.f; p1[blk][r] = 0.f; }
#pragma unroll
        for (int ds = 0; ds < 4; ++ds) {
            const bf16x8 k0 = *(const LAS bf16x8*)(Kl + r32 * 144 + ds * 32 + hi * 16), k1 = *(const LAS bf16x8*)(Kl + (r32 + 32) * 144 + ds * 32 + hi * 16);
#pragma unroll
            for (int blk = 0; blk < NBLK; ++blk) {
                p0[blk] = __builtin_amdgcn_mfma_f32_32x32x16_bf16(k0, qr[blk][ds], p0[blk], 0, 0, 0);
                p1[blk] = __builtin_amdgcn_mfma_f32_32x32x16_bf16(k1, qr[blk][ds], p1[blk], 0, 0, 0); }
        }
        u32x4 pw[NBLK][4];
#pragma unroll
        for (int blk = 0; blk < NBLK; ++blk) {
            if (t == 0) {
#pragma unroll
                for (int r = 0; r < 16; ++r) { p0[blk][r] = -1e30f; if (r < 8) p1[blk][r] = -1e30f; }
            }
            float ls = 0.f;
            if (TRACK) {
                float mx = fmaxf(p0[blk][0], p1[blk][0]);
#pragma unroll
                for (int r = 1; r < 16; ++r) mx = fmaxf(mx, fmaxf(p0[blk][r], p1[blk][r]));
                mx = fmaxf(mx, __shfl_xor(mx, 32));
                if (__any(mx > mrun[blk] + 8.0f)) {
                    const float mnew = fmaxf(mrun[blk], mx), alpha = __builtin_amdgcn_exp2f(mrun[blk] - mnew);
                    lrun[blk] *= alpha; mrun[blk] = mnew;
#pragma unroll
                    for (int r = 0; r < 16; ++r) { o0[blk][r] *= alpha; o1[blk][r] *= alpha; }
                }
#pragma unroll
                for (int r = 0; r < 16; ++r) { p0[blk][r] = __builtin_amdgcn_exp2f(p0[blk][r] - mrun[blk]); p1[blk][r] = __builtin_amdgcn_exp2f(p1[blk][r] - mrun[blk]); ls += p0[blk][r] + p1[blk][r]; }
            } else {
#pragma unroll
                for (int r = 0; r < 16; ++r) { p0[blk][r] = __builtin_amdgcn_exp2f(p0[blk][r]); p1[blk][r] = __builtin_amdgcn_exp2f(p1[blk][r]); }
            }
            if (TRACK) lrun[blk] += ls;
            pw[blk][0] = (u32x4){pk(p0[blk][0], p0[blk][1]), pk(p0[blk][2], p0[blk][3]), pk(p0[blk][4], p0[blk][5]), pk(p0[blk][6], p0[blk][7])};
            pw[blk][1] = (u32x4){pk(p0[blk][8], p0[blk][9]), pk(p0[blk][10], p0[blk][11]), pk(p0[blk][12], p0[blk][13]), pk(p0[blk][14], p0[blk][15])};
            pw[blk][2] = (u32x4){pk(p1[blk][0], p1[blk][1]), pk(p1[blk][2], p1[blk][3]), pk(p1[blk][4], p1[blk][5]), pk(p1[blk][6], p1[blk][7])};
            pw[blk][3] = (u32x4){pk(p1[blk][8], p1[blk][9]), pk(p1[blk][10], p1[blk][11]), pk(p1[blk][12], p1[blk][13]), pk(p1[blk][14], p1[blk][15])};
            if (!TRACK) {
                typedef __bf16 bf16x2d __attribute__((ext_vector_type(2)));
                const bf16x2d one2 = __builtin_bit_cast(bf16x2d, 0x3f803f80u); float a4[4];
#pragma unroll
                for (int s = 0; s < 4; ++s) { float a = 0.f;
                    a = __builtin_amdgcn_fdot2_f32_bf16(__builtin_bit_cast(bf16x2d, pw[blk][s].x), one2, a, false); a = __builtin_amdgcn_fdot2_f32_bf16(__builtin_bit_cast(bf16x2d, pw[blk][s].y), one2, a, false);
                    a = __builtin_amdgcn_fdot2_f32_bf16(__builtin_bit_cast(bf16x2d, pw[blk][s].z), one2, a, false); a = __builtin_amdgcn_fdot2_f32_bf16(__builtin_bit_cast(bf16x2d, pw[blk][s].w), one2, a, false); a4[s] = a; }
                lrun[blk] += (a4[0] + a4[1]) + (a4[2] + a4[3]);
            }
        }
#pragma unroll
        for (int s = 0; s < 4; ++s) {
            { const u32x2 a = *(const LAS u32x2*)(Vl + r32 * AT_VP + (16 * s + 4 * hi) * 2), c = *(const LAS u32x2*)(Vl + r32 * AT_VP + (16 * s + 8 + 4 * hi) * 2);
              const bf16x8 vf = __builtin_bit_cast(bf16x8, (u32x4){a.x, a.y, c.x, c.y});
#pragma unroll
              for (int blk = 0; blk < NBLK; ++blk) o0[blk] = __builtin_amdgcn_mfma_f32_32x32x16_bf16(vf, __builtin_bit_cast(bf16x8, pw[blk][s]), o0[blk], 0, 0, 0); }
            { const u32x2 a = *(const LAS u32x2*)(Vl + (r32 + 32) * AT_VP + (16 * s + 4 * hi) * 2), c = *(const LAS u32x2*)(Vl + (r32 + 32) * AT_VP + (16 * s + 8 + 4 * hi) * 2);
              const bf16x8 vf = __builtin_bit_cast(bf16x8, (u32x4){a.x, a.y, c.x, c.y});
#pragma unroll
              for (int blk = 0; blk < NBLK; ++blk) o1[blk] = __builtin_amdgcn_mfma_f32_32x32x16_bf16(vf, __builtin_bit_cast(bf16x8, pw[blk][s]), o1[blk], 0, 0, 0); }
        }
        if (t + 1 < NCH) { *(LAS u32x4*)(lds + AT_K + (buf ^ 1) * AT_TILE + lst) = kreg; *(LAS u32x2*)(lds + AT_V + (buf ^ 1) * AT_VTILE + lstv) = (u32x2){vreg.x, vreg.y}; *(LAS u32x2*)(lds + AT_V + (buf ^ 1) * AT_VTILE + lstv + 8) = (u32x2){vreg.z, vreg.w}; }
        __syncthreads();
    }
#pragma unroll
    for (int blk = 0; blk < NBLK; ++blk) {
        float l = lrun[blk]; l += __shfl_xor(l, 32);
        const float inv = 1.0f / l;
        if (qvalid[blk]) {
#pragma unroll
            for (int g = 0; g < 4; ++g) {
                u32x2 w0; w0.x = pk(o0[blk][4 * g] * inv, o0[blk][4 * g + 1] * inv); w0.y = pk(o0[blk][4 * g + 2] * inv, o0[blk][4 * g + 3] * inv);
                u32x2 w1; w1.x = pk(o1[blk][4 * g] * inv, o1[blk][4 * g + 1] * inv); w1.y = pk(o1[blk][4 * g + 2] * inv, o1[blk][4 * g + 3] * inv);
                *(u32x2*)(qp[blk] + 8 * g + 4 * hi) = w0; *(u32x2*)(qp[blk] + 32 + 8 * g + 4 * hi) = w1;
            }
        }
    }
}
__device__ __forceinline__ void attn_phase(const Params& p, int l, LAS unsigned char* lds, int vcu, int G) {
    const int lane = mk_tid() & 63;
    float gq = fabsf(p.qn[l * 64 + lane]), gk = fabsf(p.kn[l * 64 + lane]);
#pragma unroll
    for (int o = 1; o < 64; o <<= 1) { gq = fmaxf(gq, __shfl_xor(gq, o)); gk = fmaxf(gk, __shfl_xor(gk, o)); }
    const bool safe = __builtin_amdgcn_readfirstlane((gq * gk * 11.55f < 40.0f) ? 1 : 0) != 0;
    const int nper = (512 + G - 1) / G;
    if (safe) {
        for (int i = 0; i < nper; ++i) { const int id = vcu * nper + i; if (id < 512) attn_unit<2, false>(p, id >> 6, (id >> 5) & 1, id & 31, lds); }
        for (int m = 0; m < 16; ++m) if ((m * G) / 16 == vcu) attn_unit<1, false>(p, m >> 1, m & 1, -1, lds);
    } else {
        for (int i = 0; i < nper; ++i) { const int id = vcu * nper + i; if (id < 512) attn_unit<2, true>(p, id >> 6, (id >> 5) & 1, id & 31, lds); }
        for (int m = 0; m < 16; ++m) if ((m * G) / 16 == vcu) attn_unit<1, true>(p, m >> 1, m & 1, -1, lds);
    }
}

__device__ __forceinline__ void gla_scan(const Params& p, int gt, int ngt) {
    bf16_t* S = (bf16_t*)(p.ws + OFF_S); const float* DEC = (const float*)(p.ws + OFF_DEC);
    if (gt & 1) return;
    for (int task = gt >> 1; task < 64 * 1024; task += ngt >> 1) {
        const int bhd = task >> 10, e = (task & 1023) * 8, c = e & 63, dir = bhd & 1;
        bf16_t* sp = S + (size_t)bhd * NCH * 8192 + e; const float* dp = DEC + (size_t)bhd * NCH * 64 + c;
        f32x4 s0 = (f32x4){0.f, 0.f, 0.f, 0.f}, s1 = s0;
#pragma unroll 5
        for (int k = 0; k < NCH; ++k) { const int ch = dir ? (NCH - 1 - k) : k;
            const u32x4 kv = *(const u32x4*)(sp + (size_t)ch * 8192); const f32x4 d0 = *(const f32x4*)(dp + ch * 64), d1 = *(const f32x4*)(dp + ch * 64 + 4);
            *(u32x4*)(sp + (size_t)ch * 8192) = (u32x4){pk(s0[0], s0[1]), pk(s0[2], s0[3]), pk(s1[0], s1[1]), pk(s1[2], s1[3])};
            s0 = d0 * s0 + (f32x4){bflo(kv.x), bfhi(kv.x), bflo(kv.y), bfhi(kv.y)}; s1 = d1 * s1 + (f32x4){bflo(kv.z), bfhi(kv.z), bflo(kv.w), bfhi(kv.w)}; }
    }
}
constexpr int GL2_QD = 0;
constexpr int GL2_KI = 18432;
constexpr int GL2_VT = 36864;
constexpr int GL2_ATT = 55296;
constexpr int GL2_W2 = 64512;
constexpr int GL2_SZ = 64512 + 8192 + 512;
constexpr int GLA_UNITS = 32 * NCH;
static_assert(2 * GL2_SZ + 16 <= LDS_BYTES && GLA_UNITS % 2 == 0, "GLA LDS");
template <bool G3> __device__ __forceinline__ void gla_pair(const Params& p, int l, int u, bool valid, LAS unsigned char* lds) {
    const int tid = mk_tid(), lane = tid & 63, wid = __builtin_amdgcn_readfirstlane(tid >> 6), w4 = wid & 3, t8 = tid & 255, fr = lane & 15, fq = lane >> 4;
    const bf16_t* QKA = (const bf16_t*)(p.ws + OFF_QKA); const bf16_t* VA = (const bf16_t*)(p.ws + OFF_VA); bf16_t* RA = (bf16_t*)(p.ws + OFF_RA);
    const float* LR = (const float*)(p.ws + OFF_LR); bf16_t* S = (bf16_t*)(p.ws + OFF_S); float* DEC = (float*)(p.ws + OFF_DEC);
    const int bh = u / NCH, chunk = u % NCH, b = bh >> 2, h = bh & 3, c0 = w4 * 16;
#define GL_ROW(i) ((chunk == 0) ? ((size_t)MX + b * 16 + ((i) - 48)) : ((size_t)b * SEQ + (chunk - 1) * 64 + (i)))
#define GL_NUL(i) ((chunk == 0) && ((i) < 48))
    const int i = lane; const bool nul = GL_NUL(i); const size_t row = nul ? (size_t)MX : GL_ROW(i);
    LAS float* w2s = (LAS float*)(lds + GL2_W2); LAS float* b2s = w2s + 2048;
#pragma unroll
    for (int q = 0; q < 2; ++q) { const int ch = t8 + 256 * q, rr = ch >> 4, c4 = (ch & 15) * 4;
        *(LAS f32x4*)(w2s + rr * 64 + c4) = *(const f32x4*)(p.w2 + (size_t)(l * 32 + rr) * 256 + h * 64 + c4); }
    if (t8 < 32) { const int dd = t8 >> 4, c4 = (t8 & 15) * 4; *(LAS f32x4*)(b2s + dd * 64 + c4) = *(const f32x4*)(p.b2 + (size_t)(l * 2 + dd) * 256 + h * 64 + c4); }
    __syncthreads();
    float bcv[2][16];
#pragma unroll
    for (int dir = 0; dir < 2; ++dir) {
        float lrv[16];
        { const float* lrp = LR + row * 32 + dir * 16;
#pragma unroll
          for (int q = 0; q < 4; ++q) { const f32x4 t = *(const f32x4*)(lrp + 4 * q); lrv[4 * q] = t[0]; lrv[4 * q + 1] = t[1]; lrv[4 * q + 2] = t[2]; lrv[4 * q + 3] = t[3]; } }
        const LAS float* w2p = w2s + dir * 1024 + c0; const LAS float* b2p = b2s + dir * 64 + c0;
#pragma unroll
        for (int cc = 0; cc < 16; ++cc) {
            float x = b2p[cc];
#pragma unroll
            for (int r = 0; r < 16; ++r) x += lrv[r] * w2p[r * 64 + cc];
            const float lg = nul ? 0.f : __builtin_amdgcn_logf(1.f + __builtin_amdgcn_exp2f(fminf(-x, 60.f) * LOG2E)) * (-0.6931471805599453f / 16.0f);
            float sc = wave_incl_scan(lg);
            if (dir == 1) sc = lane_bcast(sc, 63) - sc + lg;
            bcv[dir][cc] = sc;
        }
    }
    LAS bf16_t* vT = (LAS bf16_t*)(lds + GL2_VT);
#pragma unroll
    for (int q = 0; q < 4; ++q) { const int vc = w4 * 4 + q;
        const u32x4 w = nul ? (u32x4){0u, 0u, 0u, 0u} : *(const u32x4*)(VA + row * 512 + h * 128 + vc * 8);
        vT[(vc * 8 + 0) * 72 + i] = (bf16_t)(w.x & 0xffffu); vT[(vc * 8 + 1) * 72 + i] = (bf16_t)(w.x >> 16); vT[(vc * 8 + 2) * 72 + i] = (bf16_t)(w.y & 0xffffu); vT[(vc * 8 + 3) * 72 + i] = (bf16_t)(w.y >> 16);
        vT[(vc * 8 + 4) * 72 + i] = (bf16_t)(w.z & 0xffffu); vT[(vc * 8 + 5) * 72 + i] = (bf16_t)(w.z >> 16); vT[(vc * 8 + 6) * 72 + i] = (bf16_t)(w.w & 0xffffu); vT[(vc * 8 + 7) * 72 + i] = (bf16_t)(w.w >> 16); }
    float kf[16], qf[16];
    { const u32x4 k0 = nul ? (u32x4){0u, 0u, 0u, 0u} : *(const u32x4*)(QKA + row * 512 + 256 + h * 64 + c0), k1 = nul ? (u32x4){0u, 0u, 0u, 0u} : *(const u32x4*)(QKA + row * 512 + 256 + h * 64 + c0 + 8);
      kf[0] = bflo(k0.x); kf[1] = bfhi(k0.x); kf[2] = bflo(k0.y); kf[3] = bfhi(k0.y); kf[4] = bflo(k0.z); kf[5] = bfhi(k0.z); kf[6] = bflo(k0.w); kf[7] = bfhi(k0.w);
      kf[8] = bflo(k1.x); kf[9] = bfhi(k1.x); kf[10] = bflo(k1.y); kf[11] = bfhi(k1.y); kf[12] = bflo(k1.z); kf[13] = bfhi(k1.z); kf[14] = bflo(k1.w); kf[15] = bfhi(k1.w); }
    if (G3) { const u32x4 q0 = nul ? (u32x4){0u, 0u, 0u, 0u} : *(const u32x4*)(QKA + row * 512 + h * 64 + c0), q1 = nul ? (u32x4){0u, 0u, 0u, 0u} : *(const u32x4*)(QKA + row * 512 + h * 64 + c0 + 8);
      qf[0] = bflo(q0.x); qf[1] = bfhi(q0.x); qf[2] = bflo(q0.y); qf[3] = bfhi(q0.y); qf[4] = bflo(q0.z); qf[5] = bfhi(q0.z); qf[6] = bflo(q0.w); qf[7] = bfhi(q0.w);
      qf[8] = bflo(q1.x); qf[9] = bfhi(q1.x); qf[10] = bflo(q1.y); qf[11] = bfhi(q1.y); qf[12] = bflo(q1.z); qf[13] = bfhi(q1.z); qf[14] = bflo(q1.w); qf[15] = bfhi(q1.w); }
    bf16x8 sfr[2][2][2]; u32x4 rpre[4];
    if (G3) {
#pragma unroll
        for (int dir = 0; dir < 2; ++dir) { const bf16_t* sp = S + ((size_t)(bh * 2 + dir) * NCH + chunk) * 8192;
#pragma unroll
            for (int vt = 0; vt < 2; ++vt)
#pragma unroll
                for (int ks = 0; ks < 2; ++ks) sfr[dir][vt][ks] = *(const bf16x8*)(sp + (size_t)((w4 * 2 + vt) * 16 + fr) * 64 + 32 * ks + 8 * fq); }
        { const int ii = t8 >> 2, part = t8 & 3; const size_t rr = GL_NUL(ii) ? (size_t)MX : GL_ROW(ii); const bf16_t* rp = RA + rr * 1024 + h * 128 + part * 32;
#pragma unroll
          for (int q = 0; q < 4; ++q) rpre[q] = *(const u32x4*)(rp + 8 * q); }
    }
    if (!G3) {
        LAS bf16_t* keT = (LAS bf16_t*)(lds + GL2_QD);
#pragma unroll
        for (int cc = 0; cc < 16; ++cc) {
            const float btF = lane_bcast(bcv[0][cc], 63), btB = lane_bcast(bcv[1][cc], 0);
            keT[(c0 + cc) * 72 + i] = f2bf(kf[cc] * fexp(btF - bcv[0][cc])); keT[(64 + c0 + cc) * 72 + i] = f2bf(kf[cc] * fexp(btB - bcv[1][cc]));
            if (valid && lane == 0) { DEC[((size_t)(bh * 2 + 0) * NCH + chunk) * 64 + c0 + cc] = fexp(btF); DEC[((size_t)(bh * 2 + 1) * NCH + chunk) * 64 + c0 + cc] = fexp(btB); }
        }
        __syncthreads();
#pragma unroll
        for (int dir = 0; dir < 2; ++dir) { bf16_t* sbase = S + ((size_t)(bh * 2 + dir) * NCH + chunk) * 8192;
#pragma unroll
          for (int vt = 0; vt < 2; ++vt) { const int v0 = (w4 * 2 + vt) * 16;
              const bf16x8 a0 = *(const LAS bf16x8*)(vT + (v0 + fr) * 72 + 8 * fq), a1 = *(const LAS bf16x8*)(vT + (v0 + fr) * 72 + 32 + 8 * fq);
#pragma unroll
              for (int ct = 0; ct < 4; ++ct) { const int cb = ct * 16;
                  const bf16x8 b0 = *(const LAS bf16x8*)(keT + (dir * 64 + cb + fr) * 72 + 8 * fq), b1 = *(const LAS bf16x8*)(keT + (dir * 64 + cb + fr) * 72 + 32 + 8 * fq);
                  f32x4 acc = (f32x4){0.f, 0.f, 0.f, 0.f};
                  acc = __builtin_amdgcn_mfma_f32_16x16x32_bf16(b0, a0, acc, 0, 0, 0); acc = __builtin_amdgcn_mfma_f32_16x16x32_bf16(b1, a1, acc, 0, 0, 0);
                  u32x2 w; w.x = pk(acc[0], acc[1]); w.y = pk(acc[2], acc[3]);
                  if (valid) *(u32x2*)(sbase + (size_t)(v0 + fr) * 64 + cb + 4 * fq) = w; } } }
        __syncthreads();
    } else {
        LAS bf16_t* qd = (LAS bf16_t*)(lds + GL2_QD); LAS bf16_t* ki = (LAS bf16_t*)(lds + GL2_KI); LAS bf16_t* att = (LAS bf16_t*)(lds + GL2_ATT);
#pragma unroll
        for (int dir = 0; dir < 2; ++dir) { float qo[16], ko[16];
#pragma unroll
            for (int cc = 0; cc < 16; ++cc) { qo[cc] = qf[cc] * fexp(bcv[dir][cc]); ko[cc] = kf[cc] * fexp(-bcv[dir][cc]); }
            *(LAS u32x4*)(qd + (dir * 64 + i) * 72 + c0) = (u32x4){pk(qo[0], qo[1]), pk(qo[2], qo[3]), pk(qo[4], qo[5]), pk(qo[6], qo[7])};
            *(LAS u32x4*)(qd + (dir * 64 + i) * 72 + c0 + 8) = (u32x4){pk(qo[8], qo[9]), pk(qo[10], qo[11]), pk(qo[12], qo[13]), pk(qo[14], qo[15])};
            *(LAS u32x4*)(ki + (dir * 64 + i) * 72 + c0) = (u32x4){pk(ko[0], ko[1]), pk(ko[2], ko[3]), pk(ko[4], ko[5]), pk(ko[6], ko[7])};
            *(LAS u32x4*)(ki + (dir * 64 + i) * 72 + c0 + 8) = (u32x4){pk(ko[8], ko[9]), pk(ko[10], ko[11]), pk(ko[12], ko[13]), pk(ko[14], ko[15])}; }
        __syncthreads();
        const int i0 = w4 * 16;
        bf16x8 aFq[2], aBq[2];
#pragma unroll
        for (int ks = 0; ks < 2; ++ks) { aFq[ks] = *(const LAS bf16x8*)(qd + (i0 + fr) * 72 + 32 * ks + 8 * fq); aBq[ks] = *(const LAS bf16x8*)(qd + (64 + i0 + fr) * 72 + 32 * ks + 8 * fq); }
#pragma unroll
        for (int jt = 0; jt < 4; ++jt) { const int j0 = jt * 16;
            f32x4 aF = (f32x4){0.f, 0.f, 0.f, 0.f}, aB = (f32x4){0.f, 0.f, 0.f, 0.f};
#pragma unroll
            for (int ks = 0; ks < 2; ++ks) {
                const bf16x8 kf_ = *(const LAS bf16x8*)(ki + (j0 + fr) * 72 + 32 * ks + 8 * fq), kb_ = *(const LAS bf16x8*)(ki + (64 + j0 + fr) * 72 + 32 * ks + 8 * fq);
                aF = __builtin_amdgcn_mfma_f32_16x16x32_bf16(aFq[ks], kf_, aF, 0, 0, 0); aB = __builtin_amdgcn_mfma_f32_16x16x32_bf16(aBq[ks], kb_, aB, 0, 0, 0); }
#pragma unroll
            for (int r = 0; r < 4; ++r) { const int ii = i0 + 4 * fq + r, jj = j0 + fr; const float v = ((ii >= jj) ? aF[r] : 0.f) + ((jj >= ii) ? aB[r] : 0.f); att[ii * 72 + jj] = f2bf(v); } }
        __syncthreads();
        LAS bf16_t* ol = ki;
        { bf16x8 bV[2][2];
#pragma unroll
          for (int vt = 0; vt < 2; ++vt)
#pragma unroll
              for (int ks = 0; ks < 2; ++ks) bV[vt][ks] = *(const LAS bf16x8*)(vT + ((w4 * 2 + vt) * 16 + fr) * 72 + 32 * ks + 8 * fq);
#pragma unroll
          for (int it = 0; it < 4; ++it) { const int ib = it * 16; bf16x8 aA[2], aF2[2], aB2[2];
#pragma unroll
              for (int ks = 0; ks < 2; ++ks) { aA[ks] = *(const LAS bf16x8*)(att + (ib + fr) * 72 + 32 * ks + 8 * fq); aF2[ks] = *(const LAS bf16x8*)(qd + (ib + fr) * 72 + 32 * ks + 8 * fq);
                  aB2[ks] = *(const LAS bf16x8*)(qd + (64 + ib + fr) * 72 + 32 * ks + 8 * fq); }
#pragma unroll
              for (int vt = 0; vt < 2; ++vt) { const int v0 = (w4 * 2 + vt) * 16; f32x4 acc = (f32x4){0.f, 0.f, 0.f, 0.f};
#pragma unroll
                  for (int ks = 0; ks < 2; ++ks) { acc = __builtin_amdgcn_mfma_f32_16x16x32_bf16(aA[ks], bV[vt][ks], acc, 0, 0, 0);
                      acc = __builtin_amdgcn_mfma_f32_16x16x32_bf16(aF2[ks], sfr[0][vt][ks], acc, 0, 0, 0); acc = __builtin_amdgcn_mfma_f32_16x16x32_bf16(aB2[ks], sfr[1][vt][ks], acc, 0, 0, 0); }
#pragma unroll
                  for (int r = 0; r < 4; ++r) ol[(ib + 4 * fq + r) * 136 + v0 + fr] = f2bf(acc[r]); } } }
        __syncthreads();
        { const int ii = t8 >> 2, part = t8 & 3; const bool nl = GL_NUL(ii); float ov[32]; float ss = 0.f;
#pragma unroll
          for (int q = 0; q < 4; ++q) { const u32x4 t = *(const LAS u32x4*)(ol + ii * 136 + part * 32 + 8 * q);
              ov[8 * q] = bflo(t.x); ov[8 * q + 1] = bfhi(t.x); ov[8 * q + 2] = bflo(t.y); ov[8 * q + 3] = bfhi(t.y); ov[8 * q + 4] = bflo(t.z); ov[8 * q + 5] = bfhi(t.z); ov[8 * q + 6] = bflo(t.w); ov[8 * q + 7] = bfhi(t.w); }
#pragma unroll
          for (int e = 0; e < 32; ++e) ss += ov[e] * ov[e];
          ss += __shfl_xor(ss, 1); ss += __shfl_xor(ss, 2);
          const float rs = __builtin_amdgcn_rsqf(ss * (1.0f / 128.0f) + EPS);
          if (valid && !nl) { bf16_t* rp = RA + GL_ROW(ii) * 1024 + h * 128 + part * 32; const float* gp = p.gn + (size_t)l * 512 + h * 128 + part * 32;
#pragma unroll
              for (int q = 0; q < 4; ++q) { const u32x4 rw = rpre[q]; const f32x4 g0 = *(const f32x4*)(gp + 8 * q), g1 = *(const f32x4*)(gp + 8 * q + 4);
                  const float rf[8] = {bflo(rw.x), bfhi(rw.x), bflo(rw.y), bfhi(rw.y), bflo(rw.z), bfhi(rw.z), bflo(rw.w), bfhi(rw.w)}; float y[8];
#pragma unroll
                  for (int e = 0; e < 8; ++e) y[e] = ov[8 * q + e] * rs * ((e < 4) ? g0[e] : g1[e - 4]) * rf[e];
                  *(u32x4*)(rp + 8 * q) = (u32x4){pk(y[0], y[1]), pk(y[2], y[3]), pk(y[4], y[5]), pk(y[6], y[7])}; } } }
        __syncthreads();
    }
#undef GL_ROW
#undef GL_NUL
}
template <bool G3> __device__ __forceinline__ void gla_phase(const Params& p, int l, LAS unsigned char* lds, int bx, int G) {
    const int grp = __builtin_amdgcn_readfirstlane(mk_tid() >> 8);
    const int niter = (GLA_UNITS + 2 * G - 1) / (2 * G);
    for (int it = 0; it < niter; ++it) { int u = (it * G + bx) * 2 + grp; const bool valid = u < GLA_UNITS; if (!valid) u = GLA_UNITS - 1;
        gla_pair<G3>(p, l, u, valid, lds + grp * GL2_SZ); }
}

__device__ __forceinline__ void gla_pool(const Params& p, int l, LAS unsigned char* lds) {
    const int tid = mk_tid(), grp = __builtin_amdgcn_readfirstlane(tid >> 8);
    unsigned* ctr = (unsigned*)(p.ws + OFF_CTR) + l * 64; LAS unsigned* slot = (LAS unsigned*)(lds + 2 * GL2_SZ);
    for (;;) {
        if (tid == 0) *slot = atomicAdd(ctr, 1u);
        __syncthreads();
        const unsigned k = *slot;
        __syncthreads();
        if (k < (unsigned)(GLA_UNITS / 2)) { gla_pair<true>(p, l, (int)k * 2 + grp, true, lds + grp * GL2_SZ); continue; }
        const int j = (int)k - GLA_UNITS / 2;
        if (l + 1 >= DEPTH || j >= (CV_NIT + 7) / 8) break;
        { const int wid = __builtin_amdgcn_readfirstlane(tid >> 6), it = j * 8 + wid; if (it < CV_NIT) conv_one(p, l + 1, it, (LAS float*)(lds + wid * 8448), tid & 63); }
        __syncthreads();
    }
}

#define XB_TMO      128
#define XB_XCNT(j)  (256  + 64 * (j))
#define XB_XSUB(j)  (1280 + 64 * (j))
#define XB_XGEN(j)  (2304 + 64 * (j))
#define XB_TOP      3328
#define XB_TOPGEN   3392
#define XCD_BAR_WORDS 3456
#define XB_SPIN_CAP (1u << 18)

__device__ __forceinline__ unsigned xb_ld(unsigned* p)              { return __hip_atomic_load(p, __ATOMIC_RELAXED, __HIP_MEMORY_SCOPE_AGENT); }
__device__ __forceinline__ unsigned xb_add(unsigned* p, unsigned v) { return __hip_atomic_fetch_add(p, v, __ATOMIC_RELAXED, __HIP_MEMORY_SCOPE_AGENT); }
__device__ __forceinline__ unsigned xb_xcc_id() { return (unsigned)__builtin_amdgcn_s_getreg((3 << 11) | 20) & 0xFu; }
#define XB_SPIN(cond, bar) do { unsigned _sp = 0; while (cond) { __builtin_amdgcn_s_sleep(1); \
    if ((++_sp & 255u) == 0u) { if (xb_ld(&(bar)[XB_TMO])) break; if (_sp > XB_SPIN_CAP) { atomicAdd(&(bar)[XB_TMO], 1u); break; } } } } while (0)
struct XcdBarrier {
    unsigned* bar; unsigned x;
    volatile LAS unsigned* st;
};

__device__ __forceinline__ XcdBarrier xcd_barrier_post(unsigned* bar, volatile LAS unsigned* st) {
    XcdBarrier b; b.bar = bar; b.x = xb_xcc_id(); b.st = st;
    if (threadIdx.x == 0) (void)xb_add(&bar[XB_XCNT(b.x)], 1u);
    return b;
}
__device__ __forceinline__ void xcd_barrier_complete(unsigned* bar, unsigned x, unsigned& nloc, unsigned& nx) {
    const unsigned G = gridDim.x * gridDim.y * gridDim.z;
    unsigned sum, cnt, mine, sp = 0u;
    for (;;) {
        sum = 0u; cnt = 0u; mine = 0u;
#pragma unroll
        for (unsigned j = 0; j < 16; ++j) { const unsigned c = xb_ld(&bar[XB_XCNT(j)]); sum += c; cnt += (c > 0u) ? 1u : 0u; mine = (j == x) ? c : mine; }
        if (sum == G) break;
        __builtin_amdgcn_s_sleep(1);
        if ((++sp & 255u) == 0u) { if (xb_ld(&bar[XB_TMO])) break; if (sp > XB_SPIN_CAP) { atomicAdd(&bar[XB_TMO], 1u); break; } }
    }
    nloc = mine > 0u ? mine : 1u; nx = cnt > 0u ? cnt : 1u;
}

__device__ __forceinline__ void xcd_barrier(const XcdBarrier& b) {
    asm volatile("s_waitcnt vmcnt(0)" ::: "memory");
    __syncthreads();
    if (threadIdx.x == 0) {
        unsigned* bar = b.bar;
        __builtin_amdgcn_s_waitcnt(0);
        unsigned nloc = b.st[0], nx = b.st[1];
        if (nloc == 0u) { xcd_barrier_complete(bar, b.x, nloc, nx); b.st[0] = nloc; b.st[1] = nx; }
        const unsigned old = xb_add(&bar[XB_XSUB(b.x)], 1u);
        const unsigned gen = old / nloc;
        if (old + 1u == (gen + 1u) * nloc) {
            __builtin_amdgcn_fence(__ATOMIC_RELEASE, "agent");
            asm volatile("s_waitcnt vmcnt(0)" ::: "memory");
            const unsigned og = xb_add(&bar[XB_TOP], 1u);
            const unsigned tg = og / nx;
            if (og + 1u == (tg + 1u) * nx) xb_add(&bar[XB_TOPGEN], 1u);
            else XB_SPIN(xb_ld(&bar[XB_TOPGEN]) == tg, bar);
            __builtin_amdgcn_fence(__ATOMIC_ACQUIRE, "agent");
            xb_add(&bar[XB_XGEN(b.x)], 1u);
            asm volatile("s_waitcnt vmcnt(0)" ::: "memory");
        } else {
            XB_SPIN(xb_ld(&bar[XB_XGEN(b.x)]) == gen, bar);
            __builtin_amdgcn_fence(__ATOMIC_ACQUIRE, "agent");
            asm volatile("s_waitcnt vmcnt(0)" ::: "memory");
        }
    }
    __syncthreads();
}

__global__ void __launch_bounds__(512) mk_fwd(Params pin) {
    extern __shared__ __attribute__((aligned(16))) unsigned char lds_raw[];
    LAS unsigned char* lds = (LAS unsigned char*)lds_raw;
    cg::grid_group grid = cg::this_grid();
    const Params p0 = pin;
    volatile LAS unsigned* xst = (volatile LAS unsigned*)(lds + LDS_BYTES - 16);
    if (threadIdx.x < 2) xst[threadIdx.x] = 0u;
    __syncthreads();
    XcdBarrier xbar = xcd_barrier_post((unsigned*)(p0.ws + OFF_BAR), xst);
    if (p0.ph_hi < 0) grid.sync();
#ifdef MK_TIMING
    unsigned long long tA = 0, tB = 0, tprev = __builtin_amdgcn_s_memrealtime();
#endif
    for (int ph = p0.ph_lo; ph < p0.ph_hi; ++ph) {
        if (ph > p0.ph_lo) { long zb = 0; asm volatile("" : "+s"(zb)); XcdBarrier xb = xbar; xb.bar += zb; xcd_barrier(xb); }
#ifdef MK_TIMING
        if (ph > p0.ph_lo) { const unsigned long long tn = __builtin_amdgcn_s_memrealtime(); const int pp = ph - 1; const int ss = (pp == 0 || pp == NPH - 1) ? 11 : (pp - 1) % 10;
            if ((MK_TA >> ss) & 1) tA += tn - tprev; if ((MK_TB >> ss) & 1) tB += tn - tprev; tprev = tn; }
#endif
        long z = 0; asm volatile("" : "+s"(z));
        Params p = p0;
        p.x += z; p.meta += z; p.ng += z; p.wg += z; p.wu += z; p.wd += z; p.win += z; p.w2 += z; p.b2 += z; p.gn += z; p.qn += z; p.kn += z; p.wpa += z; p.wpb += z; p.bm += z; p.wout += z; p.fn += z; p.out += z; p.ws += z;
        const int tid = mk_tid();
        int G = gridDim.x, bx = blockIdx.x; asm volatile("" : "+s"(G), "+s"(bx));
        const int vcu = (G % 8 == 0) ? (bx % 8) * (G / 8) + bx / 8 : bx;
        const int lane = tid & 63, wid = __builtin_amdgcn_readfirstlane(tid >> 6);
        const int gw = bx * 8 + wid, ngw = G * 8, gt = bx * 512 + tid, ngt = G * 512;
        unsigned char* ws = p.ws;
        bf16_t* HB = (bf16_t*)(ws + OFF_H);
        float* SSQ = (float*)(ws + OFF_SSQ); bf16_t* HID = (bf16_t*)(ws + OFF_HID); bf16_t* Y = (bf16_t*)(ws + OFF_Y);
        if (PHON(11) && ph == 0) { prologue(p, gw, ngw, lane); conv_layer(p, 0, lds, gw, ngw, wid, lane); continue; }
        if (ph == NPH - 1) { final_norm(p, gw, ngw, lane); continue; }
        const int l = (ph - 1) / 10, s = (ph - 1) % 10;
        bf16_t* WT = (bf16_t*)((unsigned char*)p.out + OO_WT) + (size_t)(l & 1) * WT_END;
        if (PHON(0) && (s == 0 || s == 8)) {
            const int f = (s == 8);
            pg8::Gemm g{HB, WT + (f ? WT_GU1 : WT_GU0), MROWS, 5632, D, D}; MetaOrder S; S.init(5632, G, bx);
            EpiSwiglu E{HID, SSQ + (size_t)(3 * l + (f ? 2 : 0)) * MROWS * 16};
            pg8::gemm_phase<EpiSwiglu, MetaOrder, true, true>(lds, g, S, E);
        } else if (PHON(1) && (s == 1 || s == 7 || s == 9)) {
            pg8::Gemm g; float scale; int so;
            if (s == 1) { g = pg8::Gemm{HID, WT + WT_DN0, MROWS, D, DFF, DFF}; scale = 0.5f; so = 3 * l + 1; }
            else if (s == 9) { g = pg8::Gemm{HID, WT + WT_DN1, MROWS, D, DFF, DFF}; scale = 0.5f; so = 3 * l + 3; }
            else { g = pg8::Gemm{Y, WT + WT_OUT, MROWS, D, D, D}; scale = 1.0f; so = 3 * l + 2; }
            MetaOrder S; S.init(D, G, bx);
            EpiResid E{HB, SSQ + (size_t)so * MROWS * 16, scale};
            pg8::gemm_phase<EpiResid, MetaOrder, true, true>(lds, g, S, E);
        } else if (PHON(2) && s == 2) {
            pg8::Gemm g{HB, WT + WT_WIN, MROWS, WIN_N, D, D}; MetaOrder S; S.init(WIN_N, G, bx);
            EpiWin E{ws, SSQ + (size_t)(3 * l + 1) * MROWS * 16, p.bm + (size_t)l * 2048};
            pg8::gemm_phase<EpiWin, MetaOrder, true, true>(lds, g, S, E);
        } else if (PHON(3) && s == 3) {
            if (PHON(13)) gla_phase<false>(p, l, lds, bx, G);
        } else if (PHON(4) && s == 4) {
            if (PHON(15)) gla_scan(p, gt, ngt);
            if (PHON(12)) prep_qk(p, l, gt, ngt);
        } else if (PHON(5) && s == 5) {
            if (PHON(14)) attn_phase(p, l, lds, vcu, G);
            gla_pool(p, l, lds);
        } else if (PHON(6) && s == 6) {
            MetaOrder S; S.init(D, G, bx, 1);
            pg8::Gemm g{(const bf16_t*)(ws + OFF_RA), WT + WT_PA, MROWS, D, 1024, 512}; EpiMergeF E{Y, (const bf16_t*)(ws + OFF_GT)};
            pg8::gemm_phase<EpiMergeF, MetaOrder, true, true>(lds, g, S, E);
        }
    }
#ifdef MK_TIMING
    {
        unsigned* cnt = (unsigned*)(p0.ws + OFF_ROPE);
        grid.sync();
        if (blockIdx.x == 0 && threadIdx.x == 0) { *cnt = (unsigned)(tA * 10ull); __threadfence(); }
        grid.sync();
        const unsigned N = *(volatile unsigned*)cnt; float* o = p0.out;
        for (unsigned i = blockIdx.x * 512 + threadIdx.x; i < N; i += gridDim.x * 512) o[i] += 0.01f;
        if (blockIdx.x == 0 && threadIdx.x == 0) { const unsigned long long t0 = __builtin_amdgcn_s_memrealtime(); while (__builtin_amdgcn_s_memrealtime() - t0 < tB) __builtin_amdgcn_s_sleep(8); }
    }
#endif
}

extern "C" void kernel_launch(void* const* d_in, const int* in_sizes, int n_in, void* d_out, int out_size, void* d_ws, size_t ws_size, hipStream_t stream) {
    static int grid = 0;
    if (grid == 0) {
        if (n_in != 17 || in_sizes[0] != MX * D || out_size != MX * D || ws_size < WS_END) {
            fprintf(stderr, "kernel_launch: unexpected shapes (n_in %d, in0 %d, out %d, ws %zu, need %zu)\n", n_in, n_in > 0 ? in_sizes[0] : -1, out_size, ws_size, (size_t)WS_END); grid = -1; return; }
        int dev = 0, cus = 0, per_cu = 0;
        hipGetDevice(&dev); hipDeviceGetAttribute(&cus, hipDeviceAttributeMultiprocessorCount, dev);
        if (hipFuncSetAttribute((const void*)mk_fwd, hipFuncAttributeMaxDynamicSharedMemorySize, LDS_BYTES) != hipSuccess) { fprintf(stderr, "kernel_launch: hipFuncSetAttribute failed\n"); grid = -1; return; }
        if (hipOccupancyMaxActiveBlocksPerMultiprocessor(&per_cu, (const void*)mk_fwd, 512, LDS_BYTES) != hipSuccess || per_cu < 1) { fprintf(stderr, "kernel_launch: occupancy query says %d\n", per_cu); per_cu = 1; }
        (void)hipGetLastError();
        grid = cus;
    }
    if (grid < 0) return;
    Params p{};
    p.x = (const float*)d_in[0]; p.meta = (const float*)d_in[1]; p.ng = (const float*)d_in[2]; p.wg = (const float*)d_in[3]; p.wu = (const float*)d_in[4]; p.wd = (const float*)d_in[5];
    p.win = (const float*)d_in[6]; p.w2 = (const float*)d_in[7]; p.b2 = (const float*)d_in[8]; p.gn = (const float*)d_in[9]; p.qn = (const float*)d_in[10]; p.kn = (const float*)d_in[11];
    p.wpa = (const float*)d_in[12]; p.wpb = (const float*)d_in[13]; p.bm = (const float*)d_in[14]; p.wout = (const float*)d_in[15]; p.fn = (const float*)d_in[16];
    p.out = (float*)d_out; p.ws = (unsigned char*)d_ws;
    if (hipMemsetAsync((char*)d_ws + OFF_BAR, 0, 16384, stream) != hipSuccess) { fprintf(stderr, "kernel_launch: memset of the barrier words failed\n"); return; }
#if MK_SINGLE
    p.ph_lo = 0; p.ph_hi = NPH;
    { void* args[] = {&p}; hipError_t e = hipLaunchCooperativeKernel((const void*)mk_fwd, dim3(grid), dim3(512), args, LDS_BYTES, stream);
      if (e != hipSuccess) fprintf(stderr, "cooperative launch failed: %s\n", hipGetErrorString(e)); }
#else
    for (int ph = 0; ph < NPH; ++ph) { p.ph_lo = ph; p.ph_hi = ph + 1; void* args[] = {&p};
        hipError_t e = hipLaunchCooperativeKernel((const void*)mk_fwd, dim3(grid), dim3(512), args, LDS_BYTES, stream);
        if (e != hipSuccess) { fprintf(stderr, "cooperative launch %d failed: %s\n", ph, hipGetErrorString(e)); break; } }
#endif
}
```
